# Optimizing an MI355X kernel written in HIP

```python
import math
import jax, jax.numpy as jnp
from jax import lax
import numpy as np

D_MODEL = 1024
BATCH = 16
SEQ = 4096
DEPTH = 4

MEM_LEN = 256
N_EVEN = (DEPTH + 1) // 2
N_ODD = DEPTH // 2
EPS = 1e-6
NEG_BIG = -1e30
TINY = 1e-30

HGRN_HEADS = 4
HGRN_DK = 128
HGRN_DV = 128
HGRN_WIDTH = HGRN_HEADS * HGRN_DK
HGRN_CHUNK = 64
CONV_CH = D_MODEL - HGRN_WIDTH
CONV_WIDTH = 31
EVEN_IN = 4 * HGRN_WIDTH + 2 * CONV_CH
DA_HEADS = 8
DA_HEAD_DIM = 64
DA_VDIM = 2 * DA_HEAD_DIM
ODD_IN = 3 * DA_HEADS * 2 * DA_HEAD_DIM
Q_BLOCK = 128
REL_BUCKETS = 32
REL_MAX_DIST = 128
XA_HEADS = 4
XA_HEAD_DIM = D_MODEL // XA_HEADS
N_GROUPS = 4
EXPERTS_PER_GROUP = 4
N_EXPERTS = N_GROUPS * EXPERTS_PER_GROUP
TOP_K = 2
EXPERT_FF = 512

kernel_name = "hybrid_hgrn2_conv_diffattn_hmoe"


def rms_norm(x, g):
    xf = x.astype(jnp.float32)
    y = xf * lax.rsqrt(jnp.mean(xf * xf, axis=-1, keepdims=True) + EPS)
    return (y * g.astype(jnp.float32)).astype(x.dtype)


def layer_norm(x, g, b):
    xf = x.astype(jnp.float32)
    mu = jnp.mean(xf, axis=-1, keepdims=True)
    var = jnp.mean(jnp.square(xf - mu), axis=-1, keepdims=True)
    y = (xf - mu) * lax.rsqrt(var + EPS)
    return (y * g.astype(jnp.float32) + b.astype(jnp.float32)).astype(x.dtype)


def hgrn2_chunk_scan(q, k, v, log_f):
    B, S, H, DK = q.shape
    DV = v.shape[-1]
    C = HGRN_CHUNK
    n = S // C

    def to_chunks(t):
        return t.astype(jnp.float32).reshape(B, n, C, H, t.shape[-1]).transpose(1, 0, 3, 2, 4)

    qc, kc, vc, gc = to_chunks(q), to_chunks(k), to_chunks(v), to_chunks(log_f)
    causal = jnp.tril(jnp.ones((C, C), dtype=bool))[:, :, None]

    def step(state, inp):
        qi, ki, vi, gi = inp
        b = jnp.cumsum(gi, axis=2)
        o_inter = jnp.einsum('bhtk,bhkv->bhtv', qi * jnp.exp(b), state)
        diff = b[:, :, :, None, :] - b[:, :, None, :, :]
        decay = jnp.where(causal, jnp.exp(jnp.where(causal, diff, 0.0)), 0.0)
        scores = jnp.einsum('bhtk,bhsk,bhtsk->bhts', qi, ki, decay)
        o_intra = jnp.einsum('bhts,bhsv->bhtv', scores, vi)
        b_last = b[:, :, -1:, :]
        new_state = (jnp.exp(b_last[:, :, 0, :])[..., None] * state
                     + jnp.einsum('bhsk,bhsv->bhkv', ki * jnp.exp(b_last - b), vi))
        return new_state, o_inter + o_intra

    state0 = jnp.zeros((B, H, DK, DV), jnp.float32)
    _, o = lax.scan(step, state0, (qc, kc, vc, gc))
    return o.transpose(1, 0, 3, 2, 4).reshape(B, S, H, DV)


def hgrn_conv_mixer(h, w_in, w_out, lb, hg_norm, dw, db, ln_g, ln_b):
    B, S, _ = h.shape
    proj = h @ w_in
    W = HGRN_WIDTH
    zq, zf, zi, zg, cu, cv = jnp.split(
        proj, [W, 2 * W, 3 * W, 4 * W, 4 * W + CONV_CH], axis=-1)
    f = lb + (1.0 - lb) * jax.nn.sigmoid(zf.astype(jnp.float32))
    log_f = jnp.log(jnp.maximum(f, TINY))
    k = 1.0 - f
    q = jax.nn.silu(zq.astype(jnp.float32))
    heads = lambda t: t.reshape(B, S, HGRN_HEADS, -1)
    o = hgrn2_chunk_scan(heads(q), heads(k), heads(zi), heads(log_f))
    o = rms_norm(o, hg_norm).reshape(B, S, HGRN_HEADS * HGRN_DV)
    o_hgrn = (o * jax.nn.sigmoid(zg.astype(jnp.float32))).astype(h.dtype)
    u = cu * jax.nn.sigmoid(cv)
    c = lax.conv_general_dilated(
        u, dw[:, None, :], window_strides=(1,), padding=[(CONV_WIDTH - 1, 0)],
        dimension_numbers=('NWC', 'WIO', 'NWC'), feature_group_count=CONV_CH) + db
    c = jax.nn.silu(layer_norm(c, ln_g, ln_b))
    return jnp.concatenate([o_hgrn, c.astype(h.dtype)], axis=-1) @ w_out


def t5_bucket(rel):
    n = jnp.maximum(rel, 0)
    max_exact = REL_BUCKETS // 2
    nf = jnp.maximum(n, 1).astype(jnp.float32)
    large = max_exact + (jnp.log(nf / max_exact) / math.log(REL_MAX_DIST / max_exact)
                         * (REL_BUCKETS - max_exact)).astype(jnp.int32)
    large = jnp.clip(large, 0, REL_BUCKETS - 1)
    return jnp.where(n < max_exact, n, large)


def diff_attention(h, w_qkv, w_out, lq1, lk1, lq2, lk2, subln_g, rel_bias, lam_init):
    B, S, _ = h.shape
    q, k, v = jnp.split(h @ w_qkv, 3, axis=-1)
    q = q.reshape(B, S, DA_HEADS, 2, DA_HEAD_DIM)
    k = k.reshape(B, S, DA_HEADS, 2, DA_HEAD_DIM)
    v = v.reshape(B, S, DA_HEADS, DA_VDIM)
    f32 = jnp.float32
    lam = (jnp.exp(jnp.sum(lq1.astype(f32) * lk1.astype(f32)))
           - jnp.exp(jnp.sum(lq2.astype(f32) * lk2.astype(f32))) + lam_init)
    nb = S // Q_BLOCK
    qb = q.reshape(B, nb, Q_BLOCK, DA_HEADS, 2, DA_HEAD_DIM).transpose(1, 0, 3, 4, 2, 5)
    kt = k.transpose(0, 2, 3, 1, 4)
    vt = v.transpose(0, 2, 1, 3)
    k_pos = jnp.arange(S)
    table = rel_bias.astype(f32)
    scale = DA_HEAD_DIM ** -0.5

    def block(args):
        qblk, start = args
        q_pos = start + jnp.arange(Q_BLOCK)
        rel = q_pos[:, None] - k_pos[None, :]
        bias = table[t5_bucket(rel)].transpose(2, 0, 1)
        s = jnp.einsum('bhmqd,bhmkd->bhmqk', qblk, kt).astype(f32) * scale + bias[None, :, None]
        s = jnp.where(rel >= 0, s, NEG_BIG)
        p = jax.nn.softmax(s, axis=-1)
        a = p[:, :, 0] - lam * p[:, :, 1]
        return jnp.einsum('bhqk,bhkv->bhqv', a.astype(vt.dtype), vt)

    o = lax.map(block, (qb, jnp.arange(nb) * Q_BLOCK))
    o = o.transpose(1, 0, 3, 2, 4).reshape(B, S, DA_HEADS, DA_VDIM)
    o = rms_norm(o, subln_g) * (1.0 - lam_init)
    return o.reshape(B, S, DA_HEADS * DA_VDIM) @ w_out


def memory_cross_attention(h, mem_n, wq, wkv, wo):
    B, S, _ = h.shape
    M = mem_n.shape[1]
    q = (h @ wq).reshape(B, S, XA_HEADS, XA_HEAD_DIM)
    k, v = jnp.split(mem_n @ wkv, 2, axis=-1)
    k = k.reshape(B, M, XA_HEADS, XA_HEAD_DIM)
    v = v.reshape(B, M, XA_HEADS, XA_HEAD_DIM)
    s = jnp.einsum('bshd,bmhd->bhsm', q, k).astype(jnp.float32) * (XA_HEAD_DIM ** -0.5)
    p = jax.nn.softmax(s, axis=-1)
    o = jnp.einsum('bhsm,bmhd->bshd', p.astype(v.dtype), v).reshape(B, S, D_MODEL)
    return o @ wo


def hierarchical_moe(h, w_grp, b_grp, w_exp, b_exp, w1, w3, w2):
    B, S, D = h.shape
    t = h.reshape(-1, D)
    f32 = jnp.float32
    grp_logits = (t @ w_grp).astype(f32) + b_grp.astype(f32)
    grp_prob = jax.nn.softmax(grp_logits, axis=-1)
    g_sel = jnp.argmax(grp_logits, axis=-1)
    g_w = jnp.take_along_axis(grp_prob, g_sel[:, None], axis=-1)
    exp_logits = ((t @ w_exp).astype(f32) + b_exp.astype(f32)).reshape(-1, N_GROUPS, EXPERTS_PER_GROUP)
    in_grp = jnp.take_along_axis(exp_logits, g_sel[:, None, None], axis=1)[:, 0]
    top_v, top_i = lax.top_k(in_grp, TOP_K)
    top_w = jax.nn.softmax(top_v, axis=-1) * g_w
    expert_id = g_sel[:, None] * EXPERTS_PER_GROUP + top_i
    gate = jnp.sum(jax.nn.one_hot(expert_id, N_EXPERTS, dtype=f32) * top_w[..., None], axis=1)
    gate = gate.astype(t.dtype)
    out = jnp.zeros_like(t)
    for e in range(N_EXPERTS):
        hid = jax.nn.silu(t @ w1[e]) * (t @ w3[e])
        out = out + gate[:, e:e + 1] * (hid @ w2[e])
    return out.reshape(B, S, D)


def setup_inputs(seed: int = 0) -> dict:
    key = jax.random.key(seed)
    ks = iter(jax.random.split(key, 40))
    nrm = lambda shape, scale: jax.random.normal(next(ks), shape, jnp.float32) * scale
    gain = lambda shape: 1.0 + nrm(shape, 0.05)
    D = D_MODEL
    return {
        "x": nrm((BATCH, SEQ, D), 1.0),
        "mem": nrm((BATCH, MEM_LEN, D), 1.0),
        "rel_bias": nrm((REL_BUCKETS, DA_HEADS), 0.5),
        "mem_norm_g": gain((D,)),
        "final_norm_g": gain((D,)),
        "hgrn_lb": nrm((N_EVEN, HGRN_WIDTH), 0.5),
        "norm_mix_g": gain((DEPTH, D)),
        "norm_xattn_g": gain((DEPTH, D)),
        "norm_ffn_g": gain((DEPTH, D)),
        "even_w_in": nrm((N_EVEN, D, EVEN_IN), D ** -0.5),
        "even_w_out": nrm((N_EVEN, HGRN_HEADS * HGRN_DV + CONV_CH, D), (HGRN_HEADS * HGRN_DV + CONV_CH) ** -0.5),
        "hgrn_norm_g": gain((N_EVEN, HGRN_DV)),
        "conv_dw": nrm((N_EVEN, CONV_WIDTH, CONV_CH), CONV_WIDTH ** -0.5),
        "conv_db": nrm((N_EVEN, CONV_CH), 0.02),
        "conv_ln_g": gain((N_EVEN, CONV_CH)),
        "conv_ln_b": nrm((N_EVEN, CONV_CH), 0.02),
        "odd_w_qkv": nrm((N_ODD, D, ODD_IN), D ** -0.5),
        "odd_w_out": nrm((N_ODD, DA_HEADS * DA_VDIM, D), (DA_HEADS * DA_VDIM) ** -0.5),
        "lam_q1": nrm((N_ODD, DA_HEAD_DIM), 0.1),
        "lam_k1": nrm((N_ODD, DA_HEAD_DIM), 0.1),
        "lam_q2": nrm((N_ODD, DA_HEAD_DIM), 0.1),
        "lam_k2": nrm((N_ODD, DA_HEAD_DIM), 0.1),
        "subln_g": gain((N_ODD, DA_VDIM)),
        "xa_wq": nrm((DEPTH, D, D), D ** -0.5),
        "xa_wkv": nrm((DEPTH, D, 2 * D), D ** -0.5),
        "xa_wo": nrm((DEPTH, D, D), D ** -0.5),
        "moe_w_grp": nrm((DEPTH, D, N_GROUPS), D ** -0.5),
        "moe_b_grp": nrm((DEPTH, N_GROUPS), 0.01),
        "moe_w_exp": nrm((DEPTH, D, N_EXPERTS), D ** -0.5),
        "moe_b_exp": nrm((DEPTH, N_EXPERTS), 0.01),
        "moe_w1": nrm((DEPTH, N_EXPERTS, D, EXPERT_FF), D ** -0.5),
        "moe_w3": nrm((DEPTH, N_EXPERTS, D, EXPERT_FF), D ** -0.5),
        "moe_w2": nrm((DEPTH, N_EXPERTS, EXPERT_FF, D), EXPERT_FF ** -0.5),
    }


def reference(x, mem, rel_bias, mem_norm_g, final_norm_g, hgrn_lb,
              norm_mix_g, norm_xattn_g, norm_ffn_g,
              even_w_in, even_w_out, hgrn_norm_g, conv_dw, conv_db, conv_ln_g, conv_ln_b,
              odd_w_qkv, odd_w_out, lam_q1, lam_k1, lam_q2, lam_k2, subln_g,
              xa_wq, xa_wkv, xa_wo,
              moe_w_grp, moe_b_grp, moe_w_exp, moe_b_exp, moe_w1, moe_w3, moe_w2):
    lb_p = jax.nn.softmax(hgrn_lb.astype(jnp.float32), axis=0)
    lower_bounds = jnp.cumsum(lb_p, axis=0) - lb_p[0]
    mem_n = rms_norm(mem, mem_norm_g)
    for i in range(DEPTH):
        h = rms_norm(x, norm_mix_g[i])
        if i % 2 == 0:
            j = i // 2
            y = hgrn_conv_mixer(h, even_w_in[j], even_w_out[j], lower_bounds[j], hgrn_norm_g[j],
                                conv_dw[j], conv_db[j], conv_ln_g[j], conv_ln_b[j])
        else:
            j = i // 2
            lam_init = 0.8 - 0.6 * math.exp(-0.3 * i)
            y = diff_attention(h, odd_w_qkv[j], odd_w_out[j], lam_q1[j], lam_k1[j], lam_q2[j],
                               lam_k2[j], subln_g[j], rel_bias, lam_init)
        x = x + y
        x = x + memory_cross_attention(rms_norm(x, norm_xattn_g[i]), mem_n, xa_wq[i], xa_wkv[i], xa_wo[i])
        x = x + hierarchical_moe(rms_norm(x, norm_ffn_g[i]), moe_w_grp[i], moe_b_grp[i], moe_w_exp[i],
                                 moe_b_exp[i], moe_w1[i], moe_w3[i], moe_w2[i])
    return rms_norm(x, final_norm_g)
```

```cpp
#include <hip/hip_runtime.h>
#include <cstdio>
#include <cstdint>
#include <cmath>
#include <cstring>
extern __shared__ __attribute__((aligned(16))) unsigned char lds_raw[];
constexpr int WAVE_TAB_OFF = 160 * 1024 - 1024;
__device__ __forceinline__ int hw_slot() { return (int)(__builtin_amdgcn_s_getreg((5 << 11) | 4) & 0x3f); }
__device__ __forceinline__ int otid() {
    const int wv = __builtin_amdgcn_readfirstlane(((const __attribute__((address_space(3))) int*)((const __attribute__((address_space(3))) unsigned char*)lds_raw + WAVE_TAB_OFF))[hw_slot()]);
    int t = wv * 64 + (int)__builtin_amdgcn_mbcnt_hi(~0u, __builtin_amdgcn_mbcnt_lo(~0u, 0u)); asm volatile("" : "+v"(t)); return t; }
#ifndef SHFL_SAFE
#define SHFL_SAFE 1
#endif
#if SHFL_SAFE
template <int M> __device__ __forceinline__ float xor_lt32(float v) { return __shfl_xor(v, M); }
__device__ __forceinline__ float sum_halves(float v) { return v + __shfl_xor(v, 32); }
__device__ __forceinline__ float max_halves(float v) { return __builtin_fmaxf(v, __shfl_xor(v, 32)); }
#else
template <int M> __device__ __forceinline__ float xor_lt32(float v) { return __builtin_bit_cast(float, __builtin_amdgcn_ds_swizzle(__builtin_bit_cast(int, v), 0x1f | (M << 10))); }
__device__ __forceinline__ float sum_halves(float v) { auto rr = __builtin_amdgcn_permlane32_swap(__builtin_bit_cast(unsigned, v), __builtin_bit_cast(unsigned, v), false, false); return __builtin_bit_cast(float, rr[0]) + __builtin_bit_cast(float, rr[1]); }
__device__ __forceinline__ float max_halves(float v) { auto rr = __builtin_amdgcn_permlane32_swap(__builtin_bit_cast(unsigned, v), __builtin_bit_cast(unsigned, v), false, false); return __builtin_fmaxf(__builtin_bit_cast(float, rr[0]), __builtin_bit_cast(float, rr[1])); }
#endif
namespace pg8 {
#define PG8_LAS __attribute__((address_space(3)))
#define PG8_GAS __attribute__((address_space(1)))
typedef unsigned short bf16_t;
typedef short bf16x8 __attribute__((ext_vector_type(8)));
typedef float f32x4 __attribute__((ext_vector_type(4)));
typedef float f32x2 __attribute__((ext_vector_type(2)));
typedef unsigned u32x4 __attribute__((ext_vector_type(4)));
typedef unsigned u32x2 __attribute__((ext_vector_type(2)));
constexpr int BM = 256, BK = 64, HALF = 128, HTB = HALF * BK * 2, STAGE_BYTES = 8 * HTB, NXCD = 8, WGM = 8;

__host__ __device__ __forceinline__ int lds_byte(int r, int c) { const int st = (r >> 4) * 2 + (c >> 5), rr = r & 15, cc = c & 31, ob = rr * 64 + cc * 2; return st * 1024 + (ob ^ (((ob >> 9) & 1) << 5)); }
__host__ __device__ __forceinline__ void stage_rc(int b, int& R, int& C) { const int st = b / 1024, sb = b % 1024, swz = sb ^ (((sb >> 9) & 1) << 5); R = (st >> 1) * 16 + swz / 64; C = (st & 1) * 32 + (swz % 64) / 2; }
__host__ __device__ __forceinline__ int perm32(int rho) { const int n = rho >> 4, i = rho & 15; return 8 * (i >> 2) + 4 * n + (i & 3); }

struct Unit { int pm, pn, x0, x1, x2, x3, ui; long bd; };
constexpr int RS_TAB_OFF = 131072 + 8192, RS_TAB_UNITS = 12;
struct Gemm { const bf16_t* A; const bf16_t* Bt; int K, lda, ldb; };

struct StaticOrder {
    static constexpr bool PRELOAD = false;
    int nM, nN, nwg, G, c;
    __device__ __forceinline__ void init(int M, int N, int G_, int c_) { nM = M / BM; nN = N / BM; nwg = nM * nN; G = G_; c = c_; }
    __device__ __forceinline__ bool next(int i, Unit& u) const {
        const long L = (long)i * G + c; if (L >= nwg) return false;
        int wgid = (int)L; { const int q = nwg / NXCD, r = nwg % NXCD, xcd = wgid % NXCD, off = wgid / NXCD; wgid = (xcd < r ? xcd * (q + 1) : r * (q + 1) + (xcd - r) * q) + off; }
        const int nig = WGM * nN, gid = wgid / nig, fm = gid * WGM, gsz = (nM - fm) < WGM ? (nM - fm) : WGM;
        u.pm = fm + ((wgid % nig) % gsz); u.pn = (wgid % nig) / gsz; u.x0 = u.pn; u.x1 = 0; u.x2 = 256; u.x3 = 0; u.bd = 0; return true;
    }
    __device__ __forceinline__ void preload(int) const {}
    __device__ __forceinline__ unsigned rowoff(int, int) const { return 0u; }
};

struct BatchOrder : StaticOrder {
    __device__ __forceinline__ bool next(int i, Unit& u) const { if (!StaticOrder::next(i, u)) return false; u.pn = (u.pm >> 4) * 4 + u.x0; return true; }
};
struct FoldOrder {
    static constexpr bool PRELOAD = false;
    int G, c, mode;
    __device__ __forceinline__ bool next(int i, Unit& u) const { const int L = i * G + c; if (L >= 256) return false; const int bh = L >> 2, q = L & 3, b = bh >> 2, h = bh & 3;
        if (mode == 0) { u.pm = b * 8 + h; u.pn = h * 4 + q; u.x0 = q; u.x1 = b * 4 + h; } else { u.pm = h * 4 + q; u.pn = b * 8 + 4 + h; u.x0 = h; u.x1 = b * 4 + q; }
        u.x2 = 256; u.x3 = 0; u.bd = 0; return true; }
    __device__ __forceinline__ void preload(int) const {}
    __device__ __forceinline__ unsigned rowoff(int, int) const { return 0u; }
};
struct MoeOrder {
    static constexpr bool PRELOAD = true;
    int G, c, t0, t1; const PG8_LAS int* tab; const int* lists; PG8_LAS unsigned short* tokl; int ncol;
    __device__ __forceinline__ PG8_LAS unsigned* uinfo() const { return (PG8_LAS unsigned*)(lds_raw + (160 * 1024 - 2048) + 1280); }
    __device__ __forceinline__ bool tile_of(int i, int& tile, int& col) const { const int L = i * G + c; const int sh = (ncol == 8) ? 3 : 2; tile = t0 + (L >> sh); col = L & (ncol - 1); return tile < t1; }
    __device__ __forceinline__ unsigned scan(int tile) const {
        int idx = 0;
        for (int j = 0; j < 32; ++j) { if (tab[j + 1] > tile) { idx = j; break; } }
        const int mt = tile - tab[idx]; int nv = tab[33 + idx] - mt * 256; nv = nv > 256 ? 256 : nv;
        return (unsigned)idx | ((unsigned)(nv - 1) << 8) | ((unsigned)mt << 16); }
    __device__ __forceinline__ bool next(int i, Unit& u) const {
        int tile, col; if (!tile_of(i, tile, col)) return false;
        const unsigned w = uinfo()[i]; const int idx = w & 31, nv = ((w >> 8) & 255) + 1, mt = w >> 16;
        const int gs = idx / 6, q = idx - gs * 6, lo = gs * 4 + ((0x211000 >> (4 * q)) & 15), hi = gs * 4 + ((0x332321 >> (4 * q)) & 15);
        u.pm = tile; u.x0 = idx; u.x1 = mt; u.x2 = nv; u.x3 = col;
        if (ncol == 8) { u.pn = ((col < 4) ? lo : hi) * 4 + (col & 3); u.bd = 0; }
        else { u.pn = lo * 4 + col; u.bd = (long)(hi - lo) * 4 * (256 * 512 * 2) - 8 * (BK * 2); }
        return true;
    }
    __device__ __forceinline__ void preload(int tid) const {
        { int tile, col; if (tid < 32 && tile_of(tid, tile, col)) uinfo()[tid] = scan(tile); }
        if (ncol != 8) return;
        const int half = tid >> 8, r = tid & 255;
#pragma unroll 1
        for (int i0 = 0; ; i0 += 4) { int tile, col; if (!tile_of(i0, tile, col)) break;
            unsigned w[2]; bool ok[2]; int tok[2];
#pragma unroll
            for (int j = 0; j < 2; ++j) { const int ii = i0 + 2 * j + half; ok[j] = tile_of(ii, tile, col); tok[j] = 0; w[j] = 0u;
                if (ok[j]) { w[j] = scan(tile); if (r <= (int)((w[j] >> 8) & 255)) tok[j] = ((const PG8_GAS int*)lists)[(size_t)(w[j] & 31) * 65536 + (w[j] >> 16) * 256 + r]; } }
#pragma unroll
            for (int j = 0; j < 2; ++j) { const int ii = i0 + 2 * j + half; if (ok[j]) tokl[ii * 256 + r] = (unsigned short)tok[j]; }
        } }
    __device__ __forceinline__ unsigned rowoff(int ui, int row) const { return (unsigned)tokl[ui * 256 + row]; }
};

__device__ __forceinline__ unsigned cvt_pk_bf16(float lo, float hi) { unsigned r; asm volatile("v_cvt_pk_bf16_f32 %0, %1, %2" : "=v"(r) : "v"(lo), "v"(hi)); return r; }

__device__ __forceinline__ float row_rs(const float* ss, int row) {
    const PG8_GAS f32x4* sp = (const PG8_GAS f32x4*)(ss + (size_t)row * 16); const f32x4 a = sp[0], b = sp[1], c = sp[2], d = sp[3];
    const float s = ((a[0] + a[1]) + (a[2] + a[3])) + ((b[0] + b[1]) + (b[2] + b[3])) + ((c[0] + c[1]) + (c[2] + c[3])) + ((d[0] + d[1]) + (d[2] + d[3]));
    return __builtin_amdgcn_rsqf(s * (1.0f / 1024.0f) + 1e-6f);
}
__device__ __forceinline__ void rows8_rs(const float* ss, int row0, float (&rr)[8]) {
#pragma unroll
    for (int q = 0; q < 8; q += 2) { rr[q] = row_rs(ss, row0 + (q >> 2) * HALF + (q & 3) * 16); rr[q + 1] = row_rs(ss, row0 + ((q + 1) >> 2) * HALF + ((q + 1) & 3) * 16); asm volatile("" : "+v"(rr[q]), "+v"(rr[q + 1]) :: "memory"); }
}
__device__ __forceinline__ void rows8_tab(int ui, int wr, int fr, float (&rr)[8]) {
    const PG8_LAS float* tp = (const PG8_LAS float*)(lds_raw + RS_TAB_OFF) + ui * 256 + wr * 64 + fr;
#pragma unroll
    for (int q = 0; q < 8; ++q) rr[q] = tp[(q >> 2) * HALF + (q & 3) * 16];
}
template <class Sched>
__device__ __forceinline__ bool build_rs_table(const Sched& S, const float* ss) {
    { Unit t; if (S.next(RS_TAB_UNITS, t)) return false; }
    const int tid = otid(), r = tid >> 1, hf = tid & 1; PG8_LAS float* tab = (PG8_LAS float*)(lds_raw + RS_TAB_OFF);
#pragma unroll 1
    for (int i0 = 0; i0 < RS_TAB_UNITS; i0 += 4) {
        f32x4 a[4][2]; bool ok[4];
#pragma unroll
        for (int j = 0; j < 4; ++j) { Unit u; ok[j] = S.next(i0 + j, u); if (ok[j]) { const PG8_GAS f32x4* sp = (const PG8_GAS f32x4*)(ss + ((size_t)u.pm * BM + r) * 16 + 8 * hf); a[j][0] = sp[0]; a[j][1] = sp[1]; } }
#pragma unroll
        for (int j = 0; j < 4; ++j) if (ok[j]) { float s_ = ((a[j][0][0] + a[j][0][1]) + (a[j][0][2] + a[j][0][3])) + ((a[j][1][0] + a[j][1][1]) + (a[j][1][2] + a[j][1][3])); s_ += __shfl_xor(s_, 1);
            if (hf == 0) tab[(i0 + j) * 256 + r] = __builtin_amdgcn_rsqf(s_ * (1.0f / 1024.0f) + 1e-6f); }
        if (!ok[3]) break;
    }
    return true;
}
struct EpiNormBf16 {
    static constexpr bool PERM = true; static constexpr int NSTORE = 8;
    bf16_t* O; int ldc; const float* ss; int rowsel; bool tab; int glu_from;
    __device__ __forceinline__ void operator()(const f32x4 (&acc)[2][2][4][2], const Unit& u, int wr, int wc, int fr, int fq) const {
        const int row0 = (rowsel ? u.x1 : u.pm) * BM + wr * 64 + fr, col0 = u.x0 * BM + wc * 32 + 8 * fq;
        float rr8[8];
        if (tab) rows8_tab(u.ui, wr, fr, rr8); else if (ss) rows8_rs(ss, row0, rr8); else {
#pragma unroll
            for (int q = 0; q < 8; ++q) rr8[q] = 1.0f; }
        if (u.x0 >= glu_from) {
            const int gcol = glu_from * BM + (u.x0 - glu_from) * HALF + wc * 32 + 8 * fq;
#pragma unroll
            for (int ai = 0; ai < 2; ++ai)
#pragma unroll
                for (int m = 0; m < 4; ++m) { const int row = row0 + ai * HALF + m * 16; const float rr = rr8[ai * 4 + m]; const float c1 = -1.44269504f * rr; const f32x2 c1v = {c1, c1}, rrv = {rr, rr}, one = {1.0f, 1.0f};
                    float hv[8];
#pragma unroll
                    for (int n = 0; n < 2; ++n)
#pragma unroll
                        for (int j = 0; j < 4; j += 2) { const f32x2 vv = {acc[ai][0][m][n][j], acc[ai][0][m][n][j + 1]}, gg = {acc[ai][1][m][n][j], acc[ai][1][m][n][j + 1]};
                            f32x2 e = gg * c1v; e[0] = __builtin_amdgcn_exp2f(e[0]); e[1] = __builtin_amdgcn_exp2f(e[1]); e += one;
                            f32x2 sg; sg[0] = __builtin_amdgcn_rcpf(e[0]); sg[1] = __builtin_amdgcn_rcpf(e[1]);
                            const f32x2 h2 = (vv * rrv) * sg; hv[n * 4 + j] = h2[0]; hv[n * 4 + j + 1] = h2[1]; }
                    u32x4 w; w.x = cvt_pk_bf16(hv[0], hv[1]); w.y = cvt_pk_bf16(hv[2], hv[3]); w.z = cvt_pk_bf16(hv[4], hv[5]); w.w = cvt_pk_bf16(hv[6], hv[7]);
                    *(PG8_GAS u32x4*)(O + (size_t)row * ldc + gcol) = w; }
            return; }
#pragma unroll
        for (int ai = 0; ai < 2; ++ai)
#pragma unroll
            for (int m = 0; m < 4; ++m) { const int row = row0 + ai * HALF + m * 16; const float rr = rr8[ai * 4 + m]; bf16_t* rowp = O + (size_t)row * ldc + col0;
#pragma unroll
                for (int bj = 0; bj < 2; ++bj) { const f32x4 v0 = acc[ai][bj][m][0] * rr, v1 = acc[ai][bj][m][1] * rr;
                    u32x4 w; w.x = cvt_pk_bf16(v0[0], v0[1]); w.y = cvt_pk_bf16(v0[2], v0[3]); w.z = cvt_pk_bf16(v1[0], v1[1]); w.w = cvt_pk_bf16(v1[2], v1[3]);
                    *(PG8_GAS u32x4*)(rowp + bj * HALF) = w; } }
    }
};
struct EpiBlocks256 {
    static constexpr bool PERM = true; static constexpr int NSTORE = 16;
    bf16_t* O;
    __device__ __forceinline__ void operator()(const f32x4 (&acc)[2][2][4][2], const Unit& u, int wr, int wc, int fr, int fq) const {
        bf16_t* base = O + (size_t)(((u.x0 >> 3) * 16 + u.pm) * 8 + (u.x0 & 7)) * 65536 + (wr * 64 + fr) * 256 + wc * 32 + 8 * fq;
#pragma unroll
        for (int ai = 0; ai < 2; ++ai)
#pragma unroll
            for (int m = 0; m < 4; ++m) { bf16_t* rowp = base + (ai * HALF + m * 16) * 256;
#pragma unroll
                for (int bj = 0; bj < 2; ++bj) { const f32x4 v0 = acc[ai][bj][m][0], v1 = acc[ai][bj][m][1];
                    u32x4 w; w.x = cvt_pk_bf16(v0[0], v0[1]); w.y = cvt_pk_bf16(v0[2], v0[3]); w.z = cvt_pk_bf16(v1[0], v1[1]); w.w = cvt_pk_bf16(v1[2], v1[3]);
                    *(PG8_GAS u32x4*)(rowp + bj * HALF) = w; } }
    }
};
__device__ __forceinline__ float bf_lo(unsigned w) { return __builtin_bit_cast(float, w << 16); }
__device__ __forceinline__ float bf_hi(unsigned w) { return __builtin_bit_cast(float, w & 0xffff0000u); }
struct EpiResidual {
    static constexpr bool PERM = true; static constexpr int NSTORE = 16;
    bf16_t* xb; float* ss;
    __device__ __forceinline__ void operator()(const f32x4 (&acc)[2][2][4][2], const Unit& u, int wr, int wc, int fr, int fq) const {
        const int row0 = u.pm * BM + wr * 64 + fr, col0 = u.x0 * BM + wc * 32 + 8 * fq;
#pragma unroll
        for (int ai = 0; ai < 2; ++ai) {
            u32x4 rv[4][2];
#pragma unroll
            for (int m = 0; m < 4; ++m)
#pragma unroll
                for (int bj = 0; bj < 2; ++bj) rv[m][bj] = *(const __attribute__((address_space(1))) u32x4*)(xb + (size_t)(row0 + ai * HALF + m * 16) * 1024 + col0 + bj * HALF);
#pragma unroll
            for (int m = 0; m < 4; ++m) { const int row = row0 + ai * HALF + m * 16; float q = 0.f; bf16_t* rowp = xb + (size_t)row * 1024 + col0;
#pragma unroll
                for (int bj = 0; bj < 2; ++bj) { const u32x4 r = rv[m][bj];
                    const f32x4 a0 = acc[ai][bj][m][0], a1 = acc[ai][bj][m][1];
                    const float v0 = bf_lo(r.x) + a0[0], v1 = bf_hi(r.x) + a0[1], v2 = bf_lo(r.y) + a0[2], v3 = bf_hi(r.y) + a0[3];
                    const float v4 = bf_lo(r.z) + a1[0], v5 = bf_hi(r.z) + a1[1], v6 = bf_lo(r.w) + a1[2], v7 = bf_hi(r.w) + a1[3];
                    q += ((v0 * v0 + v1 * v1) + (v2 * v2 + v3 * v3)) + ((v4 * v4 + v5 * v5) + (v6 * v6 + v7 * v7));
                    u32x4 w; w.x = cvt_pk_bf16(v0, v1); w.y = cvt_pk_bf16(v2, v3); w.z = cvt_pk_bf16(v4, v5); w.w = cvt_pk_bf16(v6, v7);
                    *(PG8_GAS u32x4*)(rowp + bj * HALF) = w; }
                q += xor_lt32<16>(q); q = sum_halves(q);
                if (fq == 0) ((PG8_GAS float*)ss)[(size_t)row * 16 + u.x0 * 4 + wc] = q; } }
    }
};
struct EpiSoftmaxBf16 {
    static constexpr bool PERM = true, MUTABLE = true; static constexpr int NSTORE = 16;
    bf16_t* O; const float* ss; PG8_LAS float* xch; bool tab;
    __device__ __forceinline__ void operator()(f32x4 (&acc)[2][2][4][2], const Unit& u, int wr, int wc, int fr, int fq) const {
        const int row0 = u.pm * BM + wr * 64 + fr, col0 = u.x0 * BM + wc * 32 + 8 * fq;
        float mw[8], rr8[8]; if (tab) rows8_tab(u.ui, wr, fr, rr8); else rows8_rs(ss, row0, rr8);
#pragma unroll
        for (int ai = 0; ai < 2; ++ai)
#pragma unroll
            for (int m = 0; m < 4; ++m) { const float rr = rr8[ai * 4 + m]; float mx = -3.0e38f;
#pragma unroll
                for (int bj = 0; bj < 2; ++bj)
#pragma unroll
                    for (int n = 0; n < 2; ++n) { acc[ai][bj][m][n] *= rr; const f32x4 v = acc[ai][bj][m][n]; mx = __builtin_fmaxf(mx, __builtin_fmaxf(__builtin_fmaxf(v[0], v[1]), __builtin_fmaxf(v[2], v[3]))); }
                mx = __builtin_fmaxf(mx, xor_lt32<16>(mx)); mx = max_halves(mx); float sm = 0.f;
#pragma unroll
                for (int bj = 0; bj < 2; ++bj)
#pragma unroll
                    for (int n = 0; n < 2; ++n) { f32x4 v = acc[ai][bj][m][n];
#pragma unroll
                        for (int j = 0; j < 4; ++j) { v[j] = __builtin_amdgcn_exp2f(v[j] - mx); sm += v[j]; }
                        acc[ai][bj][m][n] = v; }
                sm += xor_lt32<16>(sm); sm = sum_halves(sm); mw[ai * 4 + m] = mx;
                if (fq == 0) { const int rit = ai * HALF + wr * 64 + m * 16 + fr; xch[(rit * 4 + wc) * 2] = mx; xch[(rit * 4 + wc) * 2 + 1] = sm; } }
        asm volatile("s_waitcnt lgkmcnt(0)" ::: "memory"); __builtin_amdgcn_s_barrier(); asm volatile("" ::: "memory");
#pragma unroll
        for (int ai = 0; ai < 2; ++ai)
#pragma unroll
            for (int m = 0; m < 4; ++m) { const int rit = ai * HALF + wr * 64 + m * 16 + fr; const int row = row0 + ai * HALF + m * 16;
                const f32x4 e0 = *(const PG8_LAS f32x4*)(xch + rit * 8), e1 = *(const PG8_LAS f32x4*)(xch + rit * 8 + 4);
                const float M = __builtin_fmaxf(__builtin_fmaxf(e0[0], e0[2]), __builtin_fmaxf(e1[0], e1[2]));
                const float tot = e0[1] * __builtin_amdgcn_exp2f(e0[0] - M) + e0[3] * __builtin_amdgcn_exp2f(e0[2] - M) + e1[1] * __builtin_amdgcn_exp2f(e1[0] - M) + e1[3] * __builtin_amdgcn_exp2f(e1[2] - M);
                const float f = __builtin_amdgcn_exp2f(mw[ai * 4 + m] - M) * __builtin_amdgcn_rcpf(tot); bf16_t* rowp = O + (size_t)row * 1024 + col0;
#pragma unroll
                for (int bj = 0; bj < 2; ++bj) { const f32x4 v0 = acc[ai][bj][m][0] * f, v1 = acc[ai][bj][m][1] * f;
                    u32x4 w; w.x = cvt_pk_bf16(v0[0], v0[1]); w.y = cvt_pk_bf16(v0[2], v0[3]); w.z = cvt_pk_bf16(v1[0], v1[1]); w.w = cvt_pk_bf16(v1[2], v1[3]);
                    *(PG8_GAS u32x4*)(rowp + bj * HALF) = w; } }
        asm volatile("s_waitcnt lgkmcnt(0)" ::: "memory");
    }
};
struct EpiSwiglu {
    static constexpr bool PERM = true; static constexpr int NSTORE = 0;
    bf16_t* hid; const int* lists; const float* route; const PG8_LAS unsigned short* tokl;
    __device__ __forceinline__ void operator()(const f32x4 (&acc)[2][2][4][2], const Unit& u, int wr, int wc, int fr, int fq) const {
        const int which = u.x3 >> 2, col0 = which * 512 + (u.x3 & 3) * 128 + wc * 32 + 8 * fq;
        unsigned pw[8];
#pragma unroll
        for (int q = 0; q < 8; ++q) { const int rit = (q >> 2) * HALF + wr * 64 + (q & 3) * 16 + fr; const unsigned tk = tokl[u.ui * 256 + rit]; pw[q] = ((const PG8_GAS unsigned*)route)[(size_t)tk * 4 + 1 + which]; }
#pragma unroll
        for (int ai = 0; ai < 2; ++ai)
#pragma unroll
            for (int m = 0; m < 4; ++m) { const int rit = ai * HALF + wr * 64 + m * 16 + fr; const float r1 = bf_lo(pw[ai * 4 + m]), r3 = bf_hi(pw[ai * 4 + m]);
                float hv[8];
                { typedef float f32x2 __attribute__((ext_vector_type(2))); const float c1 = -1.44269504f * r1, r13 = r1 * r3; const f32x2 c1v = {c1, c1}, r13v = {r13, r13}, one = {1.0f, 1.0f};
#pragma unroll
                  for (int n = 0; n < 2; ++n)
#pragma unroll
                      for (int j = 0; j < 4; j += 2) { const f32x2 g = {acc[ai][0][m][n][j], acc[ai][0][m][n][j + 1]}, uu = {acc[ai][1][m][n][j], acc[ai][1][m][n][j + 1]};
                          f32x2 e = g * c1v; e[0] = __builtin_amdgcn_exp2f(e[0]); e[1] = __builtin_amdgcn_exp2f(e[1]); e += one;
                          f32x2 sg; sg[0] = __builtin_amdgcn_rcpf(e[0]); sg[1] = __builtin_amdgcn_rcpf(e[1]);
                          const f32x2 h2 = (g * uu) * (sg * r13v); hv[n * 4 + j] = h2[0]; hv[n * 4 + j + 1] = h2[1]; } }
                u32x4 w; w.x = cvt_pk_bf16(hv[0], hv[1]); w.y = cvt_pk_bf16(hv[2], hv[3]); w.z = cvt_pk_bf16(hv[4], hv[5]); w.w = cvt_pk_bf16(hv[6], hv[7]);
                *(PG8_GAS u32x4*)(hid + (size_t)(u.pm * BM + rit) * 1024 + col0) = w; }
    }
};
struct EpiMoeDown {
    static constexpr bool PERM = true; static constexpr int NSTORE = 0;
    bf16_t* xb; float* ss; const int* lists;
    __device__ __forceinline__ void operator()(const f32x4 (&acc)[2][2][4][2], const Unit& u, int wr, int wc, int fr, int fq) const {
        const int pnl = u.x3, col0 = pnl * BM + wc * 32 + 8 * fq;
        const PG8_GAS int* lp = (const PG8_GAS int*)(lists + (size_t)u.x0 * 65536 + u.x1 * 256); const int last = u.x2 - 1;
        int tok[8];
#pragma unroll
        for (int q = 0; q < 8; ++q) { const int rit = (q >> 2) * HALF + wr * 64 + (q & 3) * 16 + fr; tok[q] = lp[rit < last ? rit : last]; }
#pragma unroll
        for (int ai = 0; ai < 2; ++ai) {
            u32x4 rv[4][2];
#pragma unroll
            for (int m = 0; m < 4; ++m)
#pragma unroll
                for (int bj = 0; bj < 2; ++bj) rv[m][bj] = *(const PG8_GAS u32x4*)(xb + (size_t)tok[ai * 4 + m] * 1024 + col0 + bj * HALF);
#pragma unroll
            for (int m = 0; m < 4; ++m) { const int rit = ai * HALF + wr * 64 + m * 16 + fr; const bool valid = rit <= last; float q = 0.f;
                bf16_t* rowp = xb + (size_t)tok[ai * 4 + m] * 1024 + col0;
#pragma unroll
                for (int bj = 0; bj < 2; ++bj) { const u32x4 r = rv[m][bj];
                    const f32x4 a0 = acc[ai][bj][m][0], a1 = acc[ai][bj][m][1];
                    const float v0 = bf_lo(r.x) + a0[0], v1 = bf_hi(r.x) + a0[1], v2 = bf_lo(r.y) + a0[2], v3 = bf_hi(r.y) + a0[3];
                    const float v4 = bf_lo(r.z) + a1[0], v5 = bf_hi(r.z) + a1[1], v6 = bf_lo(r.w) + a1[2], v7 = bf_hi(r.w) + a1[3];
                    q += ((v0 * v0 + v1 * v1) + (v2 * v2 + v3 * v3)) + ((v4 * v4 + v5 * v5) + (v6 * v6 + v7 * v7));
                    u32x4 w; w.x = cvt_pk_bf16(v0, v1); w.y = cvt_pk_bf16(v2, v3); w.z = cvt_pk_bf16(v4, v5); w.w = cvt_pk_bf16(v6, v7);
                    if (valid) *(PG8_GAS u32x4*)(rowp + bj * HALF) = w; }
                q += xor_lt32<16>(q); q = sum_halves(q); if (valid && fq == 0) ((PG8_GAS float*)ss)[(size_t)tok[ai * 4 + m] * 16 + pnl * 4 + wc] = q; }
        }
    }
};

template <class Epi, class Sched, bool ALIGN_EPI, bool GATHER, bool BSPLIT = false>
__device__ __forceinline__ void gemm_phase(PG8_LAS unsigned char* lds, const Gemm g, const Sched& S, const Epi& E) {
    const int tid = otid(), wid = __builtin_amdgcn_readfirstlane(tid >> 6), lane = tid & 63, wr = wid >> 2, wc = wid & 3, fr = lane & 15, fq = lane >> 4;
    const int K = g.K, nt = K / BK;
    unsigned voffA[2], voffB[2], cC2[2];
#pragma unroll
    for (int i = 0; i < 2; ++i) { int R, C; stage_rc(tid * 16 + i * 8192, R, C); const int Rb = Epi::PERM ? ((R & ~31) + perm32(R & 31)) : R;
        voffA[i] = (unsigned)(R * g.lda + C) * 2u; voffB[i] = (unsigned)(Rb * g.ldb + C) * 2u; cC2[i] = (unsigned)C * 2u; }
#define PG8_RR(i) ({ int R_, C_; stage_rc(tid * 16 + (i) * 8192, R_, C_); R_; })
    const size_t kstep = (size_t)(BK * 2);
    const size_t hstep = (size_t)HALF * g.lda * 2, hstepB = (size_t)HALF * g.ldb * 2;
    const size_t tstep = 2 * hstep, tstepB = 2 * hstepB;
    const unsigned ldsw = (unsigned)wid * 1024u;
    const int aoff = lds_byte(wr * 64 + fr, fq * 8), boff = lds_byte(wc * 32 + fr, fq * 8);
#define PG8_SA(b, h) (((b) * 2 + (h)) * HTB)
#define PG8_SB(b, h) ((4 + (b) * 2 + (h)) * HTB)
#define PG8_STAGE(bufoff, gbase, voff) do { _Pragma("unroll") for (int _i = 0; _i < 2; ++_i) \
        __builtin_amdgcn_global_load_lds((const unsigned*)((const char*)(gbase) + (voff)[_i]), (PG8_LAS unsigned*)(lds + (bufoff) + ldsw + _i * 8192), 16, 0, 0); } while (0)
#define PG8_STAGE_A(bufoff, h, kb, NX) do { if constexpr (GATHER) { const unsigned _p = (NX) ? nvA[h] : cvA[h]; unsigned _v[2]; _v[0] = (_p & 0xffffu) * (unsigned)(g.lda * 2) + cC2[0]; _v[1] = (_p >> 16) * (unsigned)(g.lda * 2) + cC2[1]; PG8_STAGE(bufoff, (const char*)g.A + (kb), _v); } \
        else { PG8_STAGE(bufoff, ((NX) ? nA : cA) + (h) * hstep + (kb), voffA); } } while (0)
#define PG8_LDA(dst, b, h) do { _Pragma("unroll") for (int m = 0; m < 4; ++m) _Pragma("unroll") for (int k = 0; k < 2; ++k) dst[m][k] = *(const PG8_LAS bf16x8*)(lds + PG8_SA(b, h) + aoff + m * 2048 + k * 1024); } while (0)
#define PG8_LDB(dst, b, h) do { _Pragma("unroll") for (int n = 0; n < 2; ++n) _Pragma("unroll") for (int k = 0; k < 2; ++k) dst[n][k] = *(const PG8_LAS bf16x8*)(lds + PG8_SB(b, h) + boff + n * 2048 + k * 1024); } while (0)
#define PG8_MMA(ai, bj, At, Bt) do { __builtin_amdgcn_s_setprio(1); _Pragma("unroll") for (int m = 0; m < 4; ++m) _Pragma("unroll") for (int n = 0; n < 2; ++n) _Pragma("unroll") for (int k = 0; k < 2; ++k) \
        acc[ai][bj][m][n] = __builtin_amdgcn_mfma_f32_16x16x32_bf16(Bt[n][k], At[m][k], acc[ai][bj][m][n], 0, 0, 0); __builtin_amdgcn_s_setprio(0); } while (0)
#define PG8_WAIT_V(n) asm volatile("s_waitcnt vmcnt(" #n ")" ::: "memory")
#define PG8_WAIT_L(n) asm volatile("s_waitcnt lgkmcnt(" #n ")" ::: "memory")
#define PG8_BAR __builtin_amdgcn_s_barrier()
#define PG8_SCHED __builtin_amdgcn_sched_barrier(0)
    Unit cur, nxt; int ui = 0;
    if constexpr (Sched::PRELOAD) { S.preload(tid); asm volatile("s_waitcnt vmcnt(0) lgkmcnt(0)" ::: "memory"); __builtin_amdgcn_s_barrier(); asm volatile("" ::: "memory"); }
    if (!S.next(0, cur)) return;
    cur.ui = 0;
    f32x4 acc[2][2][4][2];
#pragma unroll
    for (int a = 0; a < 2; ++a)
#pragma unroll
        for (int b = 0; b < 2; ++b)
#pragma unroll
            for (int m = 0; m < 4; ++m)
#pragma unroll
                for (int n = 0; n < 2; ++n) acc[a][b][m][n] = (f32x4){0.f, 0.f, 0.f, 0.f};
    bf16x8 At[4][2], B0[2][2], B1[2][2];
    unsigned cvA[2], nvA[2];
    const char* cA = (const char*)g.A + (GATHER ? (size_t)0 : (size_t)cur.pm * tstep); const char* cB = (const char*)g.Bt + (size_t)cur.pn * tstepB;
    const char* nA = cA;
    if constexpr (GATHER) {
#pragma unroll
        for (int h = 0; h < 2; ++h) { cvA[h] = S.rowoff(0, h * HALF + PG8_RR(0)) | (S.rowoff(0, h * HALF + PG8_RR(1)) << 16); nvA[h] = cvA[h]; }
    }
    PG8_STAGE(PG8_SB(0, 0), cB, voffB); PG8_STAGE(PG8_SB(0, 1), cB + hstepB, voffB); PG8_STAGE_A(PG8_SA(0, 0), 0, 0, false); PG8_STAGE_A(PG8_SA(0, 1), 1, 0, false);
    if (wr == 1) PG8_BAR;
    PG8_WAIT_V(2); PG8_BAR;
    PG8_STAGE(PG8_SB(1, 0), cB + kstep, voffB); PG8_STAGE_A(PG8_SA(1, 0), 0, kstep, false); PG8_STAGE(PG8_SB(1, 1), cB + hstepB + kstep, voffB);
    PG8_WAIT_V(6); PG8_BAR;
    for (;;) {
        const bool has_next = S.next(ui + 1, nxt);
        const char* nB = has_next ? (const char*)g.Bt + (size_t)nxt.pn * tstepB : cB;
        if constexpr (GATHER) {
            if (has_next) {
#pragma unroll
                for (int h = 0; h < 2; ++h) nvA[h] = S.rowoff(ui + 1, h * HALF + PG8_RR(0)) | (S.rowoff(ui + 1, h * HALF + PG8_RR(1)) << 16);
            } else { nvA[0] = cvA[0]; nvA[1] = cvA[1]; }
        } else { nA = has_next ? (const char*)g.A + (size_t)nxt.pm * tstep : cA; }
#pragma unroll 1
        for (int t = 0; t < nt; t += 2) {
            const bool last = (t == nt - 2);
            const size_t k1 = (size_t)(t + 1) * kstep;
            const size_t k2 = last ? (size_t)0 : (size_t)(t + 2) * kstep, k3 = k2 + kstep;
            const char* b2 = last ? nB : cB + (size_t)(t + 2) * kstep; if (BSPLIT) { if (!last && 2 * (t + 2) >= nt) b2 += cur.bd; }
            const char* b3 = b2 + kstep;
            const bool rlx = (Epi::NSTORE >= 16) && (t == 0) && (ui > 0);
            PG8_LDB(B0, 0, 0); PG8_LDB(B1, 0, 1); PG8_SCHED; PG8_LDA(At, 0, 0); PG8_STAGE_A(PG8_SA(1, 1), 1, k1, false);
            if (rlx) PG8_WAIT_V(24); else PG8_WAIT_V(8); PG8_WAIT_L(0); PG8_BAR; PG8_MMA(0, 0, At, B0); PG8_MMA(0, 1, At, B1); PG8_BAR; PG8_SCHED;
            PG8_LDA(At, 0, 1); PG8_STAGE(PG8_SB(0, 0), b2, voffB); PG8_STAGE(PG8_SB(0, 1), b2 + hstepB, voffB); PG8_STAGE_A(PG8_SA(0, 0), 0, k2, last);
            if (rlx) PG8_WAIT_V(24); else PG8_WAIT_V(8); PG8_WAIT_L(0); PG8_BAR; PG8_MMA(1, 0, At, B0); PG8_MMA(1, 1, At, B1); PG8_BAR; PG8_SCHED;
            PG8_LDB(B0, 1, 0); PG8_LDB(B1, 1, 1); PG8_SCHED; PG8_LDA(At, 1, 0); PG8_STAGE_A(PG8_SA(0, 1), 1, k2, last);
            PG8_WAIT_V(8); PG8_WAIT_L(0); PG8_BAR; PG8_MMA(0, 0, At, B0); PG8_MMA(0, 1, At, B1); PG8_BAR; PG8_SCHED;
            PG8_LDA(At, 1, 1); PG8_STAGE(PG8_SB(1, 0), b3, voffB); PG8_STAGE(PG8_SB(1, 1), b3 + hstepB, voffB); PG8_STAGE_A(PG8_SA(1, 0), 0, k3, last);
            PG8_WAIT_V(8); PG8_WAIT_L(0); PG8_BAR; PG8_MMA(1, 0, At, B0); PG8_MMA(1, 1, At, B1); PG8_BAR; PG8_SCHED;
        }
        if constexpr (ALIGN_EPI) { if (wr == 0) PG8_BAR; }
        E(acc, cur, wr, wc, fr, fq);
        if (!has_next) break;
#pragma unroll
        for (int a = 0; a < 2; ++a)
#pragma unroll
            for (int b = 0; b < 2; ++b)
#pragma unroll
                for (int m = 0; m < 4; ++m)
#pragma unroll
                    for (int n = 0; n < 2; ++n) acc[a][b][m][n] = (f32x4){0.f, 0.f, 0.f, 0.f};
        cur = nxt; cA = nA; cB = nB; ++ui; cur.ui = ui;
        if constexpr (GATHER) { cvA[0] = nvA[0]; cvA[1] = nvA[1]; }
        if constexpr (ALIGN_EPI) { if (wr == 1) PG8_BAR; }
    }
    PG8_WAIT_V(0);
    if constexpr (!ALIGN_EPI) { if (wr == 0) PG8_BAR; }
    PG8_BAR;
#undef PG8_SA
#undef PG8_RR
#undef PG8_SB
#undef PG8_STAGE
#undef PG8_STAGE_A
#undef PG8_LDA
#undef PG8_LDB
#undef PG8_MMA
#undef PG8_WAIT_V
#undef PG8_WAIT_L
#undef PG8_BAR
#undef PG8_SCHED
}
}
constexpr int NB = 16, SEQ = 4096, DM = 1024, T = NB * SEQ, MEML = 256, MT = NB * MEML;
constexpr int NWAVES = 8, NTHR = 512;
constexpr float EPS = 1e-6f, LOG2E = 1.4426950408889634f;
constexpr size_t MiB = 1u << 20;
constexpr size_t WS_CTL = 0, CTL_ZERO_BYTES = 1 * MiB;
constexpr size_t WS_SS = 2 * MiB;
constexpr size_t WS_ROUTE = 6 * MiB;
constexpr size_t WS_WR = 7 * MiB;
constexpr size_t WS_DCH = 8 * MiB;
constexpr size_t WS_LISTS = 10 * MiB;
constexpr size_t WS_MEMN = 18 * MiB;
constexpr size_t WS_KV = 26 * MiB;
constexpr size_t WS_W = 90 * MiB;
constexpr size_t W_IN = 0, W_OUT = 6 * MiB, W_XQ = 8 * MiB, W_XO = 10 * MiB, W_LAYER = 12 * MiB, W_KV = 48 * MiB;
constexpr size_t WS_WM = 154 * MiB;
constexpr size_t WM_W2 = 32 * MiB;
constexpr size_t WS_XB = 202 * MiB;
constexpr size_t WS_MIX = 330 * MiB;
constexpr size_t WS_PROJ = 458 * MiB;
constexpr size_t WS_HID = WS_PROJ + 128 * MiB;
constexpr size_t WS_FOLD = 842 * MiB;
constexpr size_t WS_END = 906 * MiB;
constexpr int CW_TMO = 0, CW_BAR = 4096, CW_CNT = 8192;
constexpr int LDS_BYTES = 160 * 1024, MISC_OFF = LDS_BYTES - 2048;

#define GAS __attribute__((address_space(1)))
#define LAS __attribute__((address_space(3)))
typedef unsigned short bf16;
typedef unsigned v4u __attribute__((ext_vector_type(4)));
typedef unsigned v2u __attribute__((ext_vector_type(2)));
typedef float f32x4 __attribute__((ext_vector_type(4)));
typedef float f32x16 __attribute__((ext_vector_type(16)));
typedef short bf16x8 __attribute__((ext_vector_type(8)));
typedef short s16x4 __attribute__((ext_vector_type(4)));
typedef GAS unsigned gu32;
#define RLX_AGENT __ATOMIC_RELAXED, __HIP_MEMORY_SCOPE_AGENT
#define LDS_WAIT() asm volatile("s_waitcnt lgkmcnt(0)" ::: "memory")
#define VM_WAIT() asm volatile("s_waitcnt vmcnt(0)" ::: "memory")
#define MFMA32(a, b, c) __builtin_amdgcn_mfma_f32_32x32x16_bf16((a), (b), (c), 0, 0, 0)
#define MFMA16(a, b, c) __builtin_amdgcn_mfma_f32_16x16x32_bf16((a), (b), (c), 0, 0, 0)
typedef float f32x2_t __attribute__((ext_vector_type(2))); typedef __bf16 bf16x2_t __attribute__((ext_vector_type(2)));
__device__ __forceinline__ unsigned pk2(float lo, float hi) { f32x2_t v = {lo, hi}; bf16x2_t b = __builtin_convertvector(v, bf16x2_t); return __builtin_bit_cast(unsigned, b); }
__device__ __forceinline__ unsigned f2bf(float f) { return pk2(f, 0.f) & 0xffffu; }
__device__ __forceinline__ float bf2f(unsigned short b) { return __builtin_bit_cast(float, (unsigned)b << 16); }
__device__ __forceinline__ float bflo(unsigned w) { return __builtin_bit_cast(float, w << 16); }
__device__ __forceinline__ float bfhi(unsigned w) { return __builtin_bit_cast(float, w & 0xffff0000u); }
__device__ __forceinline__ float sigmoidf_(float x) { return __builtin_amdgcn_rcpf(1.0f + __expf(-x)); }
__device__ __forceinline__ float wave_sum(float v) {
    v += xor_lt32<1>(v); v += xor_lt32<2>(v); v += xor_lt32<4>(v); v += xor_lt32<8>(v); v += xor_lt32<16>(v);
    return sum_halves(v);
}
__device__ __forceinline__ int crow(int r, int hi) { return (r & 3) + 8 * (r >> 2) + 4 * hi; }

#define XB_TMO      128
#define XB_XCNT(j)  (256  + 64 * (j))
#define XB_XSUB(j)  (1280 + 64 * (j))
#define XB_XGEN(j)  (2304 + 64 * (j))
#define XB_TOP      3328
#define XB_TOPGEN   3392
#define XCD_BAR_WORDS 3456
#define XB_SPIN_CAP (1u << 20)
__device__ __forceinline__ unsigned xb_ld(unsigned* p)              { return __hip_atomic_load(p, __ATOMIC_RELAXED, __HIP_MEMORY_SCOPE_AGENT); }
__device__ __forceinline__ unsigned xb_add(unsigned* p, unsigned v) { return __hip_atomic_fetch_add(p, v, __ATOMIC_RELAXED, __HIP_MEMORY_SCOPE_AGENT); }
__device__ __forceinline__ unsigned xb_xcc_id() { return (unsigned)__builtin_amdgcn_s_getreg((3 << 11) | 20) & 0xFu; }
#define XB_SPIN(cond, bar) do { unsigned _sp = 0; while (cond) { __builtin_amdgcn_s_sleep(1); \
    if ((++_sp & 255u) == 0u) { if (xb_ld(&(bar)[XB_TMO])) break; if (_sp > XB_SPIN_CAP) { atomicAdd(&(bar)[XB_TMO], 1u); break; } } } } while (0)
struct XcdBarrier { unsigned* bar; unsigned x; volatile LAS unsigned* st; };
__device__ __forceinline__ XcdBarrier xcd_barrier_post(unsigned* bar, volatile LAS unsigned* st) {
    XcdBarrier b; b.bar = bar; b.x = xb_xcc_id(); b.st = st;
    if (otid() == 0) (void)xb_add(&bar[XB_XCNT(b.x)], 1u);
    return b;
}
__device__ __forceinline__ void xcd_barrier_complete(unsigned* bar, unsigned x, unsigned& nloc, unsigned& nx) {
    const unsigned G = gridDim.x * gridDim.y * gridDim.z;
    unsigned sum, cnt, mine, sp = 0u;
    for (;;) {
        sum = 0u; cnt = 0u; mine = 0u;
#pragma unroll 1
        for (unsigned j = 0; j < 16; ++j) { const unsigned c = xb_ld(&bar[XB_XCNT(j)]); sum += c; cnt += (c > 0u) ? 1u : 0u; mine = (j == x) ? c : mine; }
        if (sum == G) break;
        __builtin_amdgcn_s_sleep(1);
        if ((++sp & 255u) == 0u) { if (xb_ld(&bar[XB_TMO])) break; if (sp > XB_SPIN_CAP) { atomicAdd(&bar[XB_TMO], 1u); break; } }
    }
    nloc = mine > 0u ? mine : 1u; nx = cnt > 0u ? cnt : 1u;
}
__device__ __attribute__((noinline)) void xcd_barrier_impl(unsigned* bbar, unsigned bx, volatile LAS unsigned* bst, bool leader) {
    XcdBarrier b; b.bar = bbar; b.x = bx; b.st = bst;
    asm volatile("s_waitcnt vmcnt(0)" ::: "memory");
    __syncthreads();
    if (leader) {
        unsigned* bar = b.bar;
        __builtin_amdgcn_s_waitcnt(0);
        unsigned nloc = b.st[0], nx = b.st[1];
        if (nloc == 0u) { xcd_barrier_complete(bar, b.x, nloc, nx); b.st[0] = nloc; b.st[1] = nx; }
        const unsigned old = xb_add(&bar[XB_XSUB(b.x)], 1u);
        const unsigned gen = old / nloc;
        if (old + 1u == (gen + 1u) * nloc) {
            __builtin_amdgcn_fence(__ATOMIC_RELEASE, "agent");
            asm volatile("s_waitcnt vmcnt(0)" ::: "memory");
            const unsigned og = xb_add(&bar[XB_TOP], 1u);
            const unsigned tg = og / nx;
            if (og + 1u == (tg + 1u) * nx) xb_add(&bar[XB_TOPGEN], 1u);
            else XB_SPIN(xb_ld(&bar[XB_TOPGEN]) == tg, bar);
            __builtin_amdgcn_fence(__ATOMIC_ACQUIRE, "agent");
            xb_add(&bar[XB_XGEN(b.x)], 1u);
            asm volatile("s_waitcnt vmcnt(0)" ::: "memory");
        } else {
            XB_SPIN(xb_ld(&bar[XB_XGEN(b.x)]) == gen, bar);
            __builtin_amdgcn_fence(__ATOMIC_ACQUIRE, "agent");
            asm volatile("s_waitcnt vmcnt(0)" ::: "memory");
        }
    }
    __syncthreads();
}

__device__ __forceinline__ void xcd_barrier(const XcdBarrier& b) { xcd_barrier_impl(b.bar, b.x, b.st, otid() == 0); }

struct Params {
    const float* in[33]; float* out; unsigned char* ws;
    float lam_init[2];
    unsigned char bucket[128];
};
__device__ __forceinline__ void transpose_item(const float* W, int N, int k0, int n0, bf16* WT, int KT, int orow0, const float* gain, float scale, LAS float* scr, int lane) {
    float wv[32];
#pragma unroll
    for (int i = 0; i < 32; ++i) wv[i] = ((const GAS float*)W)[(size_t)(k0 + 2 * i + (lane >> 5)) * N + n0 + (lane & 31)];
#pragma unroll
    for (int i = 0; i < 32; ++i) scr[(2 * i + (lane >> 5)) * 33 + (lane & 31)] = wv[i];
    LDS_WAIT(); asm volatile("" ::: "memory");
    const int c = lane & 7;
    float g[8];
#pragma unroll
    for (int j = 0; j < 8; ++j) g[j] = (gain ? ((const GAS float*)gain)[k0 + 8 * c + j] : 1.0f) * scale;
#pragma unroll
    for (int j = 0; j < 4; ++j) { const int n = (lane >> 3) + 8 * j; const LAS float* s = scr + (8 * c) * 33 + n;
        v4u o; o.x = pk2(s[0 * 33] * g[0], s[1 * 33] * g[1]); o.y = pk2(s[2 * 33] * g[2], s[3 * 33] * g[3]); o.z = pk2(s[4 * 33] * g[4], s[5 * 33] * g[5]); o.w = pk2(s[6 * 33] * g[6], s[7 * 33] * g[7]);
        *(GAS v4u*)(WT + (size_t)(orow0 + n) * KT + k0 + 8 * c) = o; }
    LDS_WAIT(); asm volatile("" ::: "memory");
}
__device__ __forceinline__ void convert_matrix(const float* W, int K, int N, bf16* WT, const float* gain, float scale_lo, int n_lo, int gw, int NGW, LAS float* scr, int lane, int glu_lo = 0) {
    const int nblk = N / 32, nit = (K / 64) * nblk;
    for (int it = gw; it < nit; it += NGW) { const int kb = it / nblk, nb = it % nblk; int orow0 = 32 * nb;
        if (glu_lo > 0 && orow0 >= glu_lo) { const int s_ = orow0 - glu_lo, c_ = s_ & 511; orow0 = glu_lo + (c_ >> 7) * 256 + (s_ >> 9) * 128 + (c_ & 127); }
        transpose_item(W, N, 64 * kb, 32 * nb, WT, K, orow0, gain, (32 * nb < n_lo) ? scale_lo : 1.0f, scr, lane); }
}
__device__ __forceinline__ void convert_moe(const float* w1, const float* w3, const float* w2, bf16* w13t, bf16* w2t, const float* gain, int gw, int NGW, LAS float* scr, int lane) {
    for (int it = gw; it < 3 * 4096; it += NGW) {
        const int which = it >> 12, r = it & 4095, e = r >> 8, q = r & 255;
        if (which < 2) { const int kb = q >> 4, nb = q & 15, n0 = 32 * nb;
            const float* W = (which == 0 ? w1 : w3) + (size_t)e * 1024 * 512;
            const int orow0 = e * 1024 + (n0 >> 7) * 256 + which * 128 + (n0 & 127);
            transpose_item(W, 512, 64 * kb, n0, w13t, 1024, orow0, gain, 1.0f, scr, lane);
        } else { const int kb = q >> 5, nb = q & 31;
            transpose_item(w2 + (size_t)e * 512 * 1024, 1024, 64 * kb, 32 * nb, w2t, 512, e * 1024 + 32 * nb, nullptr, 1.0f, scr, lane); }
    }
}
__device__ __forceinline__ void rows4_to_xb(const float* x, bf16* xbp, float* ss, int m0, int mstride, int lane) {
    f32x4 v[4][4];
#pragma unroll
    for (int q = 0; q < 4; ++q) { const GAS f32x4* xr = (const GAS f32x4*)(x + (size_t)(m0 + q * mstride) * 1024) + lane;
#pragma unroll
        for (int j = 0; j < 4; ++j) v[q][j] = xr[64 * j]; }
#pragma unroll
    for (int q = 0; q < 4; ++q) { float s = 0.f;
#pragma unroll
        for (int j = 0; j < 4; ++j) s += (v[q][j].x * v[q][j].x + v[q][j].y * v[q][j].y) + (v[q][j].z * v[q][j].z + v[q][j].w * v[q][j].w);
        s = wave_sum(s);
        GAS unsigned long long* o8 = (GAS unsigned long long*)(xbp + (size_t)(m0 + q * mstride) * 1024) + lane;
#pragma unroll
        for (int j = 0; j < 4; ++j) o8[64 * j] = (unsigned long long)pk2(v[q][j].x, v[q][j].y) | ((unsigned long long)pk2(v[q][j].z, v[q][j].w) << 32);
        if (lane < 16) ss[(size_t)(m0 + q * mstride) * 16 + lane] = (lane == 0) ? s : 0.f; }
}
__device__ __forceinline__ void row_norm_bf16(const float* xrow, const float* g, bf16* orow, int lane) {
    const GAS f32x4* xr = (const GAS f32x4*)xrow + lane; const GAS f32x4* gr = (const GAS f32x4*)g + lane;
    f32x4 v[4]; float s = 0.f;
#pragma unroll
    for (int j = 0; j < 4; ++j) { v[j] = xr[64 * j]; s += (v[j].x * v[j].x + v[j].y * v[j].y) + (v[j].z * v[j].z + v[j].w * v[j].w); }
    const float rr = __builtin_amdgcn_rsqf(wave_sum(s) * (1.0f / 1024.0f) + EPS);
    GAS unsigned long long* o8 = (GAS unsigned long long*)orow + lane;
#pragma unroll
    for (int j = 0; j < 4; ++j) { const f32x4 gg = gr[64 * j]; o8[64 * j] = (unsigned long long)pk2(v[j].x * rr * gg.x, v[j].y * rr * gg.y) | ((unsigned long long)pk2(v[j].z * rr * gg.z, v[j].w * rr * gg.w) << 32); }
}
__device__ __forceinline__ void rows4_final(const bf16* xbp, float* out, const float* ss, const f32x4 (&gg)[4], int m0, int mstride, int lane) {
    v2u w[4][4]; float rr[4];
#pragma unroll
    for (int q = 0; q < 4; ++q) { const GAS v2u* xr = (const GAS v2u*)(xbp + (size_t)(m0 + q * mstride) * 1024) + lane;
#pragma unroll
        for (int j = 0; j < 4; ++j) w[q][j] = xr[64 * j];
        rr[q] = pg8::row_rs(ss, m0 + q * mstride); }
#pragma unroll
    for (int q = 0; q < 4; ++q) { GAS f32x4* orr = (GAS f32x4*)(out + (size_t)(m0 + q * mstride) * 1024) + lane;
#pragma unroll
        for (int j = 0; j < 4; ++j) { f32x4 v; v.x = bflo(w[q][j].x) * rr[q] * gg[j].x; v.y = bfhi(w[q][j].x) * rr[q] * gg[j].y; v.z = bflo(w[q][j].y) * rr[q] * gg[j].z; v.w = bfhi(w[q][j].y) * rr[q] * gg[j].w; orr[64 * j] = v; } }
}

constexpr int HA_FS = 132, HA_Q = 0, HA_KK = 33792, HA_BL = 67584, HA_TOT = 101376, HA_KI = 103424, HA_VI = 123904, HA_AM = 144384, HA_END = 153600, HA_BS = 72, HA_IS = 160;
typedef short v4i16_t __attribute__((ext_vector_type(4)));
__device__ __forceinline__ bf16x8 tr_frag(const LAS bf16* img, int s0, int x0, int lane) {
    const LAS bf16* p = img + (s0 + ((lane & 15) >> 2)) * HA_IS + x0 + 16 * ((lane >> 4) & 1) + 4 * (lane & 3);
    const s16x4 lo = __builtin_bit_cast(s16x4, __builtin_amdgcn_ds_read_tr16_b64_v4i16((LAS v4i16_t*)p));
    const s16x4 hh = __builtin_bit_cast(s16x4, __builtin_amdgcn_ds_read_tr16_b64_v4i16((LAS v4i16_t*)(p + 4 * HA_IS)));
    return __builtin_shufflevector(lo, hh, 0, 1, 2, 3, 4, 5, 6, 7);
}
constexpr int HA_TAB = HA_END;
__device__ __forceinline__ void hgrn_phaseA(LAS unsigned char* lds, int first, int G, bf16* proj, bf16* mix, float* dch, const float* hgrn_lb, int j_even) {
    const int tid = otid(), lane = tid & 63, wid = __builtin_amdgcn_readfirstlane(tid >> 6);
    LAS float* Q = (LAS float*)(lds + HA_Q); LAS float* KK = (LAS float*)(lds + HA_KK); LAS float* BL = (LAS float*)(lds + HA_BL); LAS float* TOT = (LAS float*)(lds + HA_TOT); LAS float* TAB = (LAS float*)(lds + HA_TAB);
    LAS bf16* KI = (LAS bf16*)(lds + HA_KI); LAS bf16* VI = (LAS bf16*)(lds + HA_VI); LAS bf16* AM = (LAS bf16*)(lds + HA_AM);
    const int row = tid >> 3, cg = tid & 7, k0 = cg * 16;
    v4u zq0, zq1, zf0, zf1, zi0, zi1;
#define HA_LOAD(uu) do { const int b_ = (uu) >> 8, h_ = ((uu) >> 6) & 3, c_ = (uu) & 63; const bf16* pr_ = proj + ((size_t)b_ * SEQ + c_ * 64 + row) * 3072 + h_ * 128 + k0; \
        zq0 = *(const GAS v4u*)(pr_); zq1 = *(const GAS v4u*)(pr_ + 8); zf0 = *(const GAS v4u*)(pr_ + 512); zf1 = *(const GAS v4u*)(pr_ + 520); zi0 = *(const GAS v4u*)(pr_ + 1024); zi1 = *(const GAS v4u*)(pr_ + 1032); } while (0)
    if (first < 4096) HA_LOAD(first);
    float lbv[16]; int hprev = -1;
#pragma unroll
    for (int e = 0; e < 16; ++e) lbv[e] = 0.f;
    for (int u = first; u < 4096; u += G) {
        const int b = u >> 8, h = (u >> 6) & 3, c = u & 63; const size_t t0 = (size_t)b * SEQ + c * 64;
        {
            const unsigned zq[8] = {zq0.x, zq0.y, zq0.z, zq0.w, zq1.x, zq1.y, zq1.z, zq1.w};
            const unsigned zf[8] = {zf0.x, zf0.y, zf0.z, zf0.w, zf1.x, zf1.y, zf1.z, zf1.w};
            *(LAS v4u*)(VI + row * HA_IS + k0) = zi0; *(LAS v4u*)(VI + row * HA_IS + k0 + 8) = zi1;
            if (h != hprev) { hprev = h;
                const GAS f32x4* l0 = (const GAS f32x4*)(hgrn_lb + h * 128 + k0); const GAS f32x4* l1 = (const GAS f32x4*)(hgrn_lb + 512 + h * 128 + k0);
#pragma unroll
                for (int q4 = 0; q4 < 4; ++q4) { const f32x4 a = l0[q4], bq = l1[q4];
#pragma unroll
                    for (int e = 0; e < 4; ++e) lbv[4 * q4 + e] = (j_even == 1) ? sigmoidf_(bq[e] - a[e]) : 0.f; } }
#pragma unroll
            for (int q4 = 0; q4 < 4; ++q4) { f32x4 qv, kv, lv;
#pragma unroll
                for (int e = 0; e < 4; ++e) { const int jj = 4 * q4 + e; const unsigned wq = zq[jj >> 1], wf = zf[jj >> 1];
                    const float q_ = (jj & 1) ? bfhi(wq) : bflo(wq), f_ = (jj & 1) ? bfhi(wf) : bflo(wf);
                    const float lb = lbv[jj];
                    const float f = lb + (1.0f - lb) * sigmoidf_(f_);
                    qv[e] = q_ * sigmoidf_(q_); kv[e] = 1.0f - f; lv[e] = __logf(fmaxf(f, 1e-30f)); }
                *(LAS f32x4*)(Q + row * HA_FS + k0 + 4 * q4) = qv; *(LAS f32x4*)(KK + row * HA_FS + k0 + 4 * q4) = kv; *(LAS f32x4*)(BL + row * HA_FS + k0 + 4 * q4) = lv; }
        }
        if (u + G < 4096) HA_LOAD(u + G);
        __syncthreads();
        { const int k = tid & 127, sub = tid >> 7; float run = 0.f;
#pragma unroll
          for (int j = 0; j < 16; ++j) { const int rw = 16 * sub + j; run += BL[rw * HA_FS + k]; BL[rw * HA_FS + k] = run; }
          TOT[sub * 128 + k] = run; }
        __syncthreads();
        {
#pragma unroll
            for (int q4 = 0; q4 < 4; ++q4) { const f32x4 bl = *(const LAS f32x4*)(BL + row * HA_FS + k0 + 4 * q4); f32x4 qv = *(const LAS f32x4*)(Q + row * HA_FS + k0 + 4 * q4), kv = *(const LAS f32x4*)(KK + row * HA_FS + k0 + 4 * q4);
#pragma unroll
                for (int e = 0; e < 4; ++e) { qv[e] *= __expf(bl[e]); kv[e] *= __expf(fminf(-bl[e], 80.0f)); }
                *(LAS f32x4*)(Q + row * HA_FS + k0 + 4 * q4) = qv; *(LAS f32x4*)(KK + row * HA_FS + k0 + 4 * q4) = kv; }
            for (int e = tid; e < 1280; e += NTHR) { const int w = e >> 7, k = e & 127; const float t0_ = TOT[k], t1_ = TOT[128 + k], t2_ = TOT[256 + k], t3_ = TOT[384 + k];
                const float x = (w == 0) ? t0_ : (w == 1) ? t1_ : (w == 2) ? t2_ : (w == 3) ? t3_ : (w == 4) ? t1_ + t2_ : (w == 5) ? t0_ + t1_ : (w == 6) ? (t0_ + t1_) + t2_ : (w == 7) ? (t0_ + t1_) + (t2_ + t3_) : (w == 8) ? t1_ + (t2_ + t3_) : t2_ + t3_;
                TAB[e] = __expf(x); }
        }
        __syncthreads();
        for (int task = wid; task < 10; task += 8) {
            int it, is; int ga = -1;
            if (task < 4) { it = task; is = task; }
            else { const int pq = task - 4; it = (pq == 0) ? 1 : (pq <= 2 ? 2 : 3); is = (pq == 0) ? 0 : (pq == 1 ? 0 : (pq == 2 ? 1 : pq - 3));
                   ga = (it - is == 1) ? -1 : (it == 2 ? 1 : (is == 1 ? 2 : 4)); }
            const int r = lane & 15, quad = lane >> 4; f32x4 acc = {0.f, 0.f, 0.f, 0.f};
#pragma unroll
            for (int ks = 0; ks < 4; ++ks) { unsigned pa[4], pb[4]; const int kb = 32 * ks + 8 * quad;
#pragma unroll
                for (int q4 = 0; q4 < 2; ++q4) { f32x4 qv = *(const LAS f32x4*)(Q + (16 * it + r) * HA_FS + kb + 4 * q4), kv = *(const LAS f32x4*)(KK + (16 * is + r) * HA_FS + kb + 4 * q4);
                    if (task >= 4) { kv *= *(const LAS f32x4*)(TAB + is * 128 + kb + 4 * q4); if (ga >= 0) qv *= *(const LAS f32x4*)(TAB + ga * 128 + kb + 4 * q4); }
                    pa[2 * q4] = pk2(qv[0], qv[1]); pa[2 * q4 + 1] = pk2(qv[2], qv[3]); pb[2 * q4] = pk2(kv[0], kv[1]); pb[2 * q4 + 1] = pk2(kv[2], kv[3]); }
                const v4u va = {pa[0], pa[1], pa[2], pa[3]}, vb = {pb[0], pb[1], pb[2], pb[3]};
                acc = MFMA16(__builtin_bit_cast(bf16x8, va), __builtin_bit_cast(bf16x8, vb), acc); }
#pragma unroll
            for (int j = 0; j < 4; ++j) { const int tl = 4 * quad + j;
                if (task < 4) AM[(16 * it + tl) * HA_BS + 16 * is + r] = (r <= tl) ? (bf16)f2bf(acc[j]) : (bf16)0;
                else { AM[(16 * it + tl) * HA_BS + 16 * is + r] = (bf16)f2bf(acc[j]); AM[(16 * is + tl) * HA_BS + 16 * it + r] = (bf16)0; } }
        }
        {
            const int sc = row >> 4; unsigned qo[8], ko[8];
#pragma unroll
            for (int q4 = 0; q4 < 4; ++q4) { f32x4 qv = *(const LAS f32x4*)(Q + row * HA_FS + k0 + 4 * q4), kv = *(const LAS f32x4*)(KK + row * HA_FS + k0 + 4 * q4);
                if (sc > 0) qv *= *(const LAS f32x4*)(TAB + ((sc == 1) ? 0 : (sc == 2) ? 5 : 6) * 128 + k0 + 4 * q4);
                kv *= *(const LAS f32x4*)(TAB + ((sc == 0) ? 7 : (sc == 1) ? 8 : (sc == 2) ? 9 : 3) * 128 + k0 + 4 * q4);
                qo[2 * q4] = pk2(qv[0], qv[1]); qo[2 * q4 + 1] = pk2(qv[2], qv[3]); ko[2 * q4] = pk2(kv[0], kv[1]); ko[2 * q4 + 1] = pk2(kv[2], kv[3]); }
            bf16* pq = proj + (t0 + row) * 3072 + h * 128 + k0;
            *(GAS v4u*)(pq) = (v4u){qo[0], qo[1], qo[2], qo[3]}; *(GAS v4u*)(pq + 8) = (v4u){qo[4], qo[5], qo[6], qo[7]};
            *(LAS v4u*)(KI + row * HA_IS + k0) = (v4u){ko[0], ko[1], ko[2], ko[3]}; *(LAS v4u*)(KI + row * HA_IS + k0 + 8) = (v4u){ko[4], ko[5], ko[6], ko[7]};
            if (tid < 128) dch[(size_t)u * 128 + tid] = TAB[7 * 128 + tid];
        }
        __syncthreads();
        { const int r = lane & 31, hi = lane >> 5, tm = wid >> 2, tn = wid & 3; f32x16 acc = {};
#pragma unroll
          for (int ks = 0; ks < 4; ++ks) { const bf16x8 a = tr_frag(VI, 16 * ks + 8 * hi, 32 * tn, lane); const bf16x8 bb = *(const LAS bf16x8*)(AM + (32 * tm + r) * HA_BS + 16 * ks + 8 * hi); acc = MFMA32(a, bb, acc); }
          bf16* po = mix + (t0 + 32 * tm + r) * 1024 + h * 128 + 32 * tn + 4 * hi;
#pragma unroll
          for (int g4 = 0; g4 < 4; ++g4) { v2u w; w.x = pk2(acc[4 * g4], acc[4 * g4 + 1]); w.y = pk2(acc[4 * g4 + 2], acc[4 * g4 + 3]); *(GAS v2u*)(po + 8 * g4) = w; }
        }
        { const int r = lane & 31, hi = lane >> 5, tk = wid >> 1;
#pragma unroll
          for (int tv2 = 0; tv2 < 2; ++tv2) { const int tv = 2 * (wid & 1) + tv2; f32x16 acc = {};
#pragma unroll
              for (int ks = 0; ks < 4; ++ks) { const bf16x8 a = tr_frag(KI, 16 * ks + 8 * hi, 32 * tk, lane); const bf16x8 bb = tr_frag(VI, 16 * ks + 8 * hi, 32 * tv, lane); acc = MFMA32(a, bb, acc); }
              const int v = 32 * tv + r;
              bf16* pu = proj + (t0 + (v & 63)) * 3072 + (v < 64 ? 512 : 1024) + h * 128 + 32 * tk + 4 * hi;
#pragma unroll
              for (int g4 = 0; g4 < 4; ++g4) { v2u w; w.x = pk2(acc[4 * g4], acc[4 * g4 + 1]); w.y = pk2(acc[4 * g4 + 2], acc[4 * g4 + 3]); *(GAS v2u*)(pu + 8 * g4) = w; } }
        }
        __syncthreads();
    }
#undef HA_LOAD
}

__device__ __forceinline__ void hgrn_phaseB(bf16* proj, const float* dch, int G) {
    const int tid = otid();
    for (int rid = blockIdx.x * 32 + (tid >> 4); rid < 8192; rid += G * 32) {
        const int bh = rid >> 7, v = rid & 127, b = bh >> 2, h = bh & 3, ks = (tid & 15) * 8;
        bf16* base = proj + ((size_t)b * SEQ + (v & 63)) * 3072 + (v < 64 ? 512 : 1024) + h * 128 + ks;
        const float* dbase = dch + (size_t)bh * 64 * 128 + ks;
        float st[8];
#pragma unroll
        for (int j = 0; j < 8; ++j) st[j] = 0.f;
        v4u ub[8]; f32x4 d0[8], d1[8];
#pragma unroll
        for (int j = 0; j < 8; ++j) { ub[j] = *(const GAS v4u*)(base + (size_t)j * 64 * 3072); d0[j] = *(const GAS f32x4*)(dbase + j * 128); d1[j] = *(const GAS f32x4*)(dbase + j * 128 + 4); }
        for (int c0 = 0; c0 < 64; c0 += 8) {
#pragma unroll
            for (int j = 0; j < 8; ++j) { const int c = c0 + j; bf16* p = base + (size_t)c * 64 * 3072;
                const v4u uu = ub[j]; const f32x4 da = d0[j], db = d1[j];
                v4u so; so.x = pk2(st[0], st[1]); so.y = pk2(st[2], st[3]); so.z = pk2(st[4], st[5]); so.w = pk2(st[6], st[7]);
                *(GAS v4u*)p = so;
                st[0] = da[0] * st[0] + bflo(uu.x); st[1] = da[1] * st[1] + bfhi(uu.x); st[2] = da[2] * st[2] + bflo(uu.y); st[3] = da[3] * st[3] + bfhi(uu.y);
                st[4] = db[0] * st[4] + bflo(uu.z); st[5] = db[1] * st[5] + bfhi(uu.z); st[6] = db[2] * st[6] + bflo(uu.w); st[7] = db[3] * st[7] + bfhi(uu.w);
                if (c + 8 < 64) { ub[j] = *(const GAS v4u*)(base + (size_t)(c + 8) * 64 * 3072); d0[j] = *(const GAS f32x4*)(dbase + (c + 8) * 128); d1[j] = *(const GAS f32x4*)(dbase + (c + 8) * 128 + 4); } }
        }
    }
}

__device__ __forceinline__ void hgrn_phaseC(LAS unsigned char* lds, int first, int G, const bf16* proj, bf16* mix, const float* gnorm) {
    const int tid = otid(), lane = tid & 63, wid = __builtin_amdgcn_readfirstlane(tid >> 6);
    LAS float* OF = (LAS float*)lds;
    const int r = lane & 31, hi = lane >> 5, tm = wid >> 2, tn = wid & 3, v = 32 * tn + r;
    const int row = tid >> 3, cg = tid & 7, v0 = cg * 16;
    bf16x8 af[8], bfr[8]; v2u ol[4]; v4u g0, g1;
#define HC_LOAD(uu) do { const int b_ = (uu) >> 8, h_ = ((uu) >> 6) & 3, c_ = (uu) & 63; const size_t t0_ = (size_t)b_ * SEQ + c_ * 64; \
        const bf16* ps_ = proj + (t0_ + (v & 63)) * 3072 + (v < 64 ? 512 : 1024) + h_ * 128 + 8 * hi; const bf16* pq_ = proj + (t0_ + 32 * tm + r) * 3072 + h_ * 128 + 8 * hi; \
        _Pragma("unroll") for (int ks = 0; ks < 8; ++ks) { af[ks] = *(const GAS bf16x8*)(ps_ + 16 * ks); bfr[ks] = *(const GAS bf16x8*)(pq_ + 16 * ks); } \
        const bf16* pl_ = mix + (t0_ + 32 * tm + r) * 1024 + h_ * 128 + 32 * tn + 4 * hi; _Pragma("unroll") for (int g4 = 0; g4 < 4; ++g4) ol[g4] = *(const GAS v2u*)(pl_ + 8 * g4); \
        const bf16* pg_ = proj + (t0_ + row) * 3072 + 1536 + h_ * 128 + v0; g0 = *(const GAS v4u*)pg_; g1 = *(const GAS v4u*)(pg_ + 8); } while (0)
    if (first < 4096) HC_LOAD(first);
    float gn[16];
#pragma unroll
    for (int j = 0; j < 16; ++j) gn[j] = gnorm[v0 + j];
    for (int u = first; u < 4096; u += G) {
        const int b = u >> 8, h = (u >> 6) & 3, c = u & 63; const size_t t0 = (size_t)b * SEQ + c * 64;
        { f32x16 acc = {};
#pragma unroll
          for (int ks = 0; ks < 8; ++ks) acc = MFMA32(af[ks], bfr[ks], acc);
#pragma unroll
          for (int g4 = 0; g4 < 4; ++g4) { const v2u w = ol[g4];
              f32x4 o; o[0] = acc[4 * g4] + bflo(w.x); o[1] = acc[4 * g4 + 1] + bfhi(w.x); o[2] = acc[4 * g4 + 2] + bflo(w.y); o[3] = acc[4 * g4 + 3] + bfhi(w.y);
              *(LAS f32x4*)(OF + (32 * tm + r) * 132 + 32 * tn + 8 * g4 + 4 * hi) = o; }
        }
        const unsigned zg[8] = {g0.x, g0.y, g0.z, g0.w, g1.x, g1.y, g1.z, g1.w};
        if (u + G < 4096) HC_LOAD(u + G);
        __syncthreads();
        { float o[16]; float s2 = 0.f;
#pragma unroll
          for (int j = 0; j < 4; ++j) { const f32x4 x = *(const LAS f32x4*)(OF + row * 132 + v0 + 4 * j); o[4 * j] = x[0]; o[4 * j + 1] = x[1]; o[4 * j + 2] = x[2]; o[4 * j + 3] = x[3]; s2 += (x[0] * x[0] + x[1] * x[1]) + (x[2] * x[2] + x[3] * x[3]); }
          s2 += xor_lt32<1>(s2); s2 += xor_lt32<2>(s2); s2 += xor_lt32<4>(s2);
          const float rr = __builtin_amdgcn_rsqf(s2 * (1.0f / 128.0f) + EPS);
          unsigned w[8];
#pragma unroll
          for (int p = 0; p < 8; ++p) { const float a = o[2 * p] * rr * gn[2 * p] * sigmoidf_(bflo(zg[p])); const float bq = o[2 * p + 1] * rr * gn[2 * p + 1] * sigmoidf_(bfhi(zg[p])); w[p] = pk2(a, bq); }
          bf16* po = mix + (t0 + row) * 1024 + h * 128 + v0;
          *(GAS v4u*)po = (v4u){w[0], w[1], w[2], w[3]}; *(GAS v4u*)(po + 8) = (v4u){w[4], w[5], w[6], w[7]};
        }
        __syncthreads();
    }
#undef HC_LOAD
}

constexpr int CV_R = 64;
__device__ __forceinline__ void conv_unit(LAS unsigned char* lds, int u, const bf16* proj, bf16* mix, const float* dw, const float* db, const float* lng, const float* lnb) {
    const int tid = otid(), lane = tid & 63, wid = __builtin_amdgcn_readfirstlane(tid >> 6);
    constexpr int UPS = SEQ / CV_R;
    const int b = u / UPS, tb = u % UPS, ch = tid;
    LAS float* CB = (LAS float*)lds;
    LAS float* STAT = (LAS float*)(lds + CV_R * 516 * 4);
    float uu[CV_R + 30];
#pragma unroll
    for (int j = 0; j < CV_R + 30; ++j) { const int tt = tb * CV_R - 30 + j; float val = 0.f;
        { const int tc = tt < 0 ? 0 : tt; const GAS bf16* p = (const GAS bf16*)(proj + ((size_t)b * SEQ + tc) * 3072 + 2048 + ch); val = bf2f(p[0]); }
        uu[j] = (tt >= 0) ? val : 0.f; }
    float w[31];
#pragma unroll
    for (int j = 0; j < 31; ++j) w[j] = ((const GAS float*)dw)[j * 512 + ch];
    const float bias = db[ch];
    float cv[CV_R];
#pragma unroll
    for (int i = 0; i < CV_R; ++i) { float a = bias;
#pragma unroll
        for (int j = 0; j < 31; ++j) a += w[j] * uu[i + j];
        cv[i] = a; CB[i * 516 + ch] = a; }
    __syncthreads();
#pragma unroll
    for (int rr = 0; rr < CV_R / 8; ++rr) { const int row = wid * (CV_R / 8) + rr; float s = 0.f; float x[8];
#pragma unroll
        for (int j = 0; j < 8; ++j) { x[j] = CB[row * 516 + lane + 64 * j]; s += x[j]; }
        const float mean = wave_sum(s) * (1.0f / 512.0f); float q = 0.f;
#pragma unroll
        for (int j = 0; j < 8; ++j) { const float d = x[j] - mean; q += d * d; }
        const float var = wave_sum(q) * (1.0f / 512.0f);
        if (lane == 0) { STAT[row * 2] = mean; STAT[row * 2 + 1] = __builtin_amdgcn_rsqf(var + EPS); } }
    __syncthreads();
    const float g = lng[ch], bb = lnb[ch];
#pragma unroll
    for (int i = 0; i < CV_R; ++i) { const float y = (cv[i] - STAT[i * 2]) * STAT[i * 2 + 1] * g + bb; ((GAS bf16*)mix)[((size_t)b * SEQ + tb * CV_R + i) * 1024 + 512 + ch] = (bf16)f2bf(y * sigmoidf_(y)); }
    __syncthreads();
}

__device__ __forceinline__ void router_tile256(LAS unsigned char* lds, int tile, const bf16* xb, const float* ss, const bf16* wr, const float* b_grp, const float* b_exp,
                                               unsigned* route, int* lists, unsigned* gcnt  , bool commit = true) {
    const int tid = otid(), lane = tid & 63, wid = __builtin_amdgcn_readfirstlane(tid >> 6);
    LAS float* LG = (LAS float*)lds + wid * (32 * 33);
    LAS int* LC = (LAS int*)(lds + 8 * 32 * 33 * 4);
    if (tid < 64) LC[tid] = 0;
    __syncthreads();
    const int r = lane & 31, hi = lane >> 5; const int tok0 = tile * 256 + wid * 32;
    f32x16 acc = {};
    const bf16* pa = wr + (size_t)r * 1024 + 8 * hi;
    const bf16* pb = xb + (size_t)(tok0 + r) * 1024 + 8 * hi;
    for (int k0 = 0; k0 < 64; k0 += 16) { bf16x8 av[16], bv[16];
#pragma unroll
        for (int ks = 0; ks < 16; ++ks) { av[ks] = *(const GAS bf16x8*)(pa + 16 * (k0 + ks)); bv[ks] = *(const GAS bf16x8*)(pb + 16 * (k0 + ks)); }
#pragma unroll
        for (int ks = 0; ks < 16; ++ks) acc = MFMA32(av[ks], bv[ks], acc); }
    const float rr = pg8::row_rs(ss, tok0 + r);
#pragma unroll
    for (int i = 0; i < 16; ++i) LG[r * 33 + crow(i, hi)] = acc[i] * rr;
    LDS_WAIT(); asm volatile("" ::: "memory");
    int ea = 0, eb = 0, pa_ = 0, pb_ = 0; float wa = 0.f, wb = 0.f; const int tok = tok0 + r;
    if (hi == 0) {
        float gl[4];
#pragma unroll
        for (int j = 0; j < 4; ++j) gl[j] = LG[r * 33 + j] + b_grp[j];
        int gs = 0; float gm = gl[0];
#pragma unroll
        for (int j = 1; j < 4; ++j) if (gl[j] > gm) { gm = gl[j]; gs = j; }
        float den = 0.f;
#pragma unroll
        for (int j = 0; j < 4; ++j) den += __expf(gl[j] - gm);
        const float gw = __builtin_amdgcn_rcpf(den);
        float el[4];
#pragma unroll
        for (int j = 0; j < 4; ++j) el[j] = LG[r * 33 + 4 + gs * 4 + j] + b_exp[gs * 4 + j];
        int i1 = 0; float v1 = el[0];
#pragma unroll
        for (int j = 1; j < 4; ++j) if (el[j] > v1) { v1 = el[j]; i1 = j; }
        int i2 = -1; float v2 = 0.f;
#pragma unroll
        for (int j = 0; j < 4; ++j) if (j != i1 && (i2 < 0 || el[j] > v2)) { v2 = el[j]; i2 = j; }
        const float e2 = __expf(v2 - v1); { const float ri = __builtin_amdgcn_rcpf(1.0f + e2); wa = gw * ri; wb = gw * e2 * ri; }
        const int plo = i1 < i2 ? i1 : i2, phi = i1 < i2 ? i2 : i1;
        ea = gs * 6 + ((plo * (7 - plo)) >> 1) + (phi - plo - 1); eb = 0;
        const float wlo = (i1 < i2) ? wa : wb, whi = (i1 < i2) ? wb : wa;
        if (commit) pa_ = __hip_atomic_fetch_add(&LC[ea], 1, __ATOMIC_RELAXED, __HIP_MEMORY_SCOPE_WORKGROUP);
        *(GAS v4u*)(route + (size_t)tok * 4) = (v4u){(unsigned)((gs * 4 + plo) | ((gs * 4 + phi) << 8)), pk2(rr, rr * wlo), pk2(rr, rr * whi), __builtin_bit_cast(unsigned, rr)};
    }
    __syncthreads();
    if (tid < 32 && commit) LC[32 + tid] = (int)__hip_atomic_fetch_add(gcnt + 32 * tid, (unsigned)LC[tid], RLX_AGENT);
    __syncthreads();
    if (hi == 0 && commit) lists[(size_t)ea * 65536 + LC[32 + ea] + pa_] = tok;
    __syncthreads();
}
typedef short v4i16_att_t __attribute__((ext_vector_type(4)));
constexpr int ATT_TPS = 1;
template <int KW> struct AttnLdsR {
    static constexpr int KSTR = KW + 8, KBYTES = 64 * KSTR * 2, VBYTES = 64 * 256;
    static constexpr int K0 = 0, V0 = 2 * ATT_TPS * KBYTES, LUT = V0 + 2 * ATT_TPS * VBYTES, END = LUT + 512;
};
template <int KW, int DK, bool CAUSAL, bool PREFETCH>
__device__ __forceinline__ void attn_block_reg(LAS unsigned char* lds, const bf16* Qw  , int qpitch,
                                           const bf16* Kg, int kpitch, const bf16* Vg, int vpitch, int ntiles, int kmapoff, int qpos0  ,
                                           f32x16 (&o)[4], float& m_run, float& l_run) {
    typedef AttnLdsR<KW> L;
    const int tid = otid(), lane = tid & 63, wid = __builtin_amdgcn_readfirstlane(tid >> 6), r = lane & 31, hi = lane >> 5;
    bf16x8 qf[DK / 16];
#pragma unroll
    for (int ks = 0; ks < DK / 16; ++ks) qf[ks] = *(const GAS bf16x8*)(Qw + (size_t)r * qpitch + 16 * ks + 8 * hi);
#pragma unroll
    for (int vt = 0; vt < 4; ++vt) o[vt] = (f32x16){};
    m_run = -1e30f; l_run = 0.f;
    constexpr int KCH = KW / 64;
    const int vkey = tid >> 4, vc = tid & 15;
    v4u kreg[ATT_TPS][KCH], vreg[ATT_TPS][2];
    const LAS float* lut = (const LAS float*)(lds + L::LUT);
    unsigned koff[KCH];
#pragma unroll
    for (int i_ = 0; i_ < KCH; ++i_) { const int c_ = tid + i_ * NTHR, key_ = c_ / (KW / 8), kc_ = c_ % (KW / 8); koff[i_] = (unsigned)(key_ * kpitch + 8 * kc_) * 2u; }
    const unsigned voff0 = (unsigned)(vkey * vpitch + 8 * vc) * 2u, voff1 = voff0 + (unsigned)(32 * vpitch) * 2u;
    const int vst0 = ((vkey >> 3) * 4 + (vc >> 2)) * 512 + (vkey & 7) * 64 + (vc & 3) * 16;
    const int vbase = (4 * hi + ((lane & 15) >> 2)) * 64 + 32 * ((lane >> 4) & 1) + 8 * (lane & 3);
#define ATT_LOADK(t, sl) do { const char* kt_ = (const char*)Kg + (size_t)(t) * 64 * kpitch * 2; _Pragma("unroll") for (int i_ = 0; i_ < KCH; ++i_) kreg[sl][i_] = *(const GAS v4u*)(kt_ + koff[i_]); } while (0)
#define ATT_LOADV(t, sl) do { const char* vt2_ = (const char*)Vg + (size_t)(t) * 64 * vpitch * 2; vreg[sl][0] = *(const GAS v4u*)(vt2_ + voff0); vreg[sl][1] = *(const GAS v4u*)(vt2_ + voff1); } while (0)
#define ATT_STORE(buf, sl) do { _Pragma("unroll") for (int i_ = 0; i_ < KCH; ++i_) { const int c_ = tid + i_ * NTHR, key_ = c_ / (KW / 8), kc_ = c_ % (KW / 8); \
        *(LAS v4u*)(lds + L::K0 + (buf) * L::KBYTES + (key_ * L::KSTR + 8 * kc_) * 2) = kreg[sl][i_]; } \
        { LAS unsigned char* vt_ = lds + L::V0 + (buf) * L::VBYTES + vst0; *(LAS v4u*)vt_ = vreg[sl][0]; *(LAS v4u*)(vt_ + 8192) = vreg[sl][1]; } } while (0)
#pragma unroll
    for (int j_ = 0; j_ < ATT_TPS; ++j_) { ATT_LOADK(j_, j_); ATT_LOADV(j_, j_); }
#pragma unroll
    for (int j_ = 0; j_ < ATT_TPS; ++j_) ATT_STORE(j_, j_);
    __syncthreads();
    const int nsteps = ntiles / ATT_TPS;
    for (int st = 0; st < nsteps; ++st) {
        const int cur = st & 1;
        if (st + 1 < nsteps) {
#pragma unroll
            for (int j_ = 0; j_ < ATT_TPS; ++j_) { ATT_LOADK(ATT_TPS * (st + 1) + j_, j_); ATT_LOADV(ATT_TPS * (st + 1) + j_, j_); } }
#pragma unroll
        for (int sub = 0; sub < ATT_TPS; ++sub) {
        const int t = ATT_TPS * st + sub, buf = cur * ATT_TPS + sub;
        const bool active = !CAUSAL || (64 * t <= qpos0 + 31);
        if (active) {
            const LAS unsigned char* kb = lds + L::K0 + buf * L::KBYTES;
            const LAS unsigned char* vb = lds + L::V0 + buf * L::VBYTES;
            f32x16 s0 = {}, s1 = {};
            {
                constexpr int NG = DK / 64;
                const LAS unsigned char* ka0 = kb + ((r) * L::KSTR + kmapoff + 8 * hi) * 2;
                const LAS unsigned char* ka1 = ka0 + 32 * L::KSTR * 2;
                bf16x8 kf[2][8];
#pragma unroll
                for (int j = 0; j < 4; ++j) { kf[0][2 * j] = *(const LAS bf16x8*)(ka0 + 32 * j); kf[0][2 * j + 1] = *(const LAS bf16x8*)(ka1 + 32 * j); }
#pragma unroll
                for (int g = 0; g < NG; ++g) {
                    if (g + 1 < NG) {
#pragma unroll
                        for (int j = 0; j < 4; ++j) { kf[(g + 1) & 1][2 * j] = *(const LAS bf16x8*)(ka0 + 128 * (g + 1) + 32 * j); kf[(g + 1) & 1][2 * j + 1] = *(const LAS bf16x8*)(ka1 + 128 * (g + 1) + 32 * j); }
                    }
#pragma unroll
                    for (int j = 0; j < 4; ++j) { s0 = MFMA32(kf[g & 1][2 * j], qf[4 * g + j], s0); s1 = MFMA32(kf[g & 1][2 * j + 1], qf[4 * g + j], s1); }
                    __builtin_amdgcn_sched_barrier(0);
                }
            }
            if (CAUSAL && (qpos0 - (64 * t + 63) < 128)) {
                const int qp = qpos0 + r;
#pragma unroll
                for (int i = 0; i < 16; ++i) { const int n0 = qp - (64 * t + crow(i, hi)), n1 = n0 - 32;
                    const float b0 = lut[min(max(n0, 0), 127)], b1 = lut[min(max(n1, 0), 127)];
                    s0[i] = (n0 < 0) ? -1e30f : s0[i] + b0;
                    s1[i] = (n1 < 0) ? -1e30f : s1[i] + b1; }
            }
            float mx = fmaxf(s0[0], s1[0]);
#pragma unroll
            for (int i = 1; i < 16; ++i) mx = __builtin_fmaxf(__builtin_fmaxf(mx, s0[i]), s1[i]);
            mx = fmaxf(mx, __shfl_xor(mx, 32));
            const float mnc = fmaxf(m_run, mx);
            const bool resc = __any(mnc > m_run + 8.0f);
            const float mn = resc ? mnc : m_run;
            float ps = 0.f;
#pragma unroll
            for (int i = 0; i < 16; ++i) { s0[i] = __builtin_amdgcn_exp2f(s0[i] - mn); s1[i] = __builtin_amdgcn_exp2f(s1[i] - mn); ps += s0[i] + s1[i]; }
            if (resc) {
                const float alpha = __builtin_amdgcn_exp2f(m_run - mn); l_run *= alpha;
#pragma unroll
                for (int vt = 0; vt < 4; ++vt)
#pragma unroll
                    for (int i = 0; i < 16; ++i) o[vt][i] *= alpha;
            }
            m_run = mn; l_run += ps;
            bf16x8 pf[4];
#pragma unroll
            for (int s = 0; s < 2; ++s) {
                v4u w0, w1;
                w0.x = pk2(s0[8 * s], s0[8 * s + 1]); w0.y = pk2(s0[8 * s + 2], s0[8 * s + 3]); w0.z = pk2(s0[8 * s + 4], s0[8 * s + 5]); w0.w = pk2(s0[8 * s + 6], s0[8 * s + 7]);
                w1.x = pk2(s1[8 * s], s1[8 * s + 1]); w1.y = pk2(s1[8 * s + 2], s1[8 * s + 3]); w1.z = pk2(s1[8 * s + 4], s1[8 * s + 5]); w1.w = pk2(s1[8 * s + 6], s1[8 * s + 7]);
                pf[s] = __builtin_bit_cast(bf16x8, w0); pf[2 + s] = __builtin_bit_cast(bf16x8, w1); }
            {
                const LAS unsigned char* vp0 = vb + vbase;
                s16x4 vl[2][4], vh[2][4];
#define ATT_TR(p_) __builtin_bit_cast(s16x4, __builtin_amdgcn_ds_read_tr16_b64_v4i16((LAS v4i16_t*)(p_)))
#pragma unroll
                for (int vt = 0; vt < 4; ++vt) { vl[0][vt] = ATT_TR(vp0 + vt * 512); vh[0][vt] = ATT_TR(vp0 + vt * 512 + 2048); }
#pragma unroll
                for (int f = 0; f < 4; ++f) {
                    if (f + 1 < 4) {
#pragma unroll
                        for (int vt = 0; vt < 4; ++vt) { vl[(f + 1) & 1][vt] = ATT_TR(vp0 + ((2 * (f + 1)) * 4 + vt) * 512); vh[(f + 1) & 1][vt] = ATT_TR(vp0 + ((2 * (f + 1)) * 4 + vt) * 512 + 2048); }
                    }
                    __builtin_amdgcn_s_setprio(1);
#pragma unroll
                    for (int vt = 0; vt < 4; ++vt) { const bf16x8 a = __builtin_shufflevector(vl[f & 1][vt], vh[f & 1][vt], 0, 1, 2, 3, 4, 5, 6, 7); o[vt] = MFMA32(a, pf[f], o[vt]); }
                    __builtin_amdgcn_s_setprio(0);
                    __builtin_amdgcn_sched_barrier(0);
                }
            }
        }
        }
        if (st + 1 < nsteps) {
#pragma unroll
            for (int j_ = 0; j_ < ATT_TPS; ++j_) ATT_STORE((cur ^ 1) * ATT_TPS + j_, j_); }
        __syncthreads();
    }
#undef ATT_LOADK
#undef ATT_LOADV
#undef ATT_STORE
#undef ATT_TR
}

__device__ __forceinline__ void diffattn_unit(LAS unsigned char* lds, int b, int h, int qb, const bf16* proj, bf16* mix, float lam, float lam_init, const float* subg,
                                              const float* rel_bias, const LAS unsigned char* bucket) {
    typedef AttnLdsR<128> L;
    const int tid = otid(), lane = tid & 63, wid = __builtin_amdgcn_readfirstlane(tid >> 6), r = lane & 31, hi = lane >> 5;
    const int map = wid >> 2, wq = wid & 3, q0 = qb * 128 + wq * 32;
    if (tid < 128) { const float c31 = rel_bias[31 * 8 + h]; ((LAS float*)(lds + L::LUT))[tid] = (rel_bias[bucket[tid] * 8 + h] - c31) * LOG2E; }
    const size_t rb = (size_t)b * SEQ;
    f32x16 o[4]; float m_run, l_run;
    attn_block_reg<128, 64, true, true>(lds, proj + (rb + q0) * 3072 + h * 128 + map * 64, 3072, proj + rb * 3072 + 1024 + h * 128, 3072, proj + rb * 3072 + 2048 + h * 128, 3072,
                              (qb * 128 + 128) / 64, map * 64, q0, o, m_run, l_run);
    const float lt = sum_halves(l_run), inv = __builtin_amdgcn_rcpf(lt);
    LAS float* XO = (LAS float*)lds;
    if (map == 1) {
#pragma unroll
        for (int vt = 0; vt < 4; ++vt)
#pragma unroll
            for (int g4 = 0; g4 < 4; ++g4) { f32x4 x; x[0] = o[vt][4 * g4] * inv; x[1] = o[vt][4 * g4 + 1] * inv; x[2] = o[vt][4 * g4 + 2] * inv; x[3] = o[vt][4 * g4 + 3] * inv;
                *(LAS f32x4*)(XO + (wq * 32 + r) * 132 + 32 * vt + 8 * g4 + 4 * hi) = x; }
    }
    __syncthreads();
    if (map == 0) {
        float ssq = 0.f;
#pragma unroll
        for (int vt = 0; vt < 4; ++vt)
#pragma unroll
            for (int g4 = 0; g4 < 4; ++g4) { const f32x4 x2 = *(const LAS f32x4*)(XO + (wq * 32 + r) * 132 + 32 * vt + 8 * g4 + 4 * hi);
#pragma unroll
                for (int j = 0; j < 4; ++j) { const float v = o[vt][4 * g4 + j] * inv - lam * x2[j]; o[vt][4 * g4 + j] = v; ssq += v * v; } }
        ssq = sum_halves(ssq);
        const float sc = (1.0f - lam_init) * __builtin_amdgcn_rsqf(ssq * (1.0f / 128.0f) + EPS);
        bf16* po = mix + (rb + q0 + r) * 1024 + h * 128 + 4 * hi; const GAS float* sgp = (const GAS float*)subg;
#pragma unroll
        for (int vt = 0; vt < 4; ++vt)
#pragma unroll
            for (int g4 = 0; g4 < 4; ++g4) { const int v0 = 32 * vt + 8 * g4 + 4 * hi;
                v2u w; w.x = pk2(o[vt][4 * g4] * sc * sgp[v0], o[vt][4 * g4 + 1] * sc * sgp[v0 + 1]); w.y = pk2(o[vt][4 * g4 + 2] * sc * sgp[v0 + 2], o[vt][4 * g4 + 3] * sc * sgp[v0 + 3]);
                *(GAS v2u*)(po + 32 * vt + 8 * g4) = w; }
    }
    __syncthreads();
}

__device__ __forceinline__ const float* pin_ptr(LAS unsigned char* lds, int k) {
    int ko = k * 8; asm volatile("" : "+v"(ko));
    const unsigned long long v = *(const LAS unsigned long long*)(lds + MISC_OFF + 512 + ko);
    const unsigned lo = __builtin_amdgcn_readfirstlane((unsigned)v), hi = __builtin_amdgcn_readfirstlane((unsigned)(v >> 32));
    return (const float*)(((unsigned long long)hi << 32) | lo);
}
__global__ void __launch_bounds__(NTHR, 2) mk_fwd(Params P) {
    static_assert(WAVE_TAB_OFF == MISC_OFF + 1024 && HA_TAB + 5120 <= MISC_OFF, "LDS map");
    if ((threadIdx.x & 63) == 0) ((LAS int*)((LAS unsigned char*)lds_raw + WAVE_TAB_OFF))[hw_slot()] = (int)(threadIdx.x >> 6);
    __syncthreads();
    unsigned ldsb = (unsigned)(size_t)(LAS unsigned char*)lds_raw;
    asm volatile("" : "+s"(ldsb));
#define lds ((LAS unsigned char*)ldsb)
    volatile LAS unsigned* MISC = (volatile LAS unsigned*)(lds + MISC_OFF);
    const int G = gridDim.x, blk = blockIdx.x;
#define FL const int tid = otid(), lane = tid & 63, wave = __builtin_amdgcn_readfirstlane(tid >> 6), gw = blk * NWAVES + wave, NGW = G * NWAVES; LAS float* scr = (LAS float*)(lds + wave * 16384); (void)lane; (void)gw; (void)NGW; (void)scr;
    { FL for (int u = tid; u < 256; u += NTHR) MISC[u] = 0u; }
    __syncthreads();
    { FL if (tid < 128) ((LAS unsigned char*)(lds + MISC_OFF + 784))[tid] = P.bucket[tid];
    if (tid < 33) ((LAS unsigned long long*)(lds + MISC_OFF + 512))[tid] = (unsigned long long)P.in[tid]; }
    __syncthreads();
#define PIN(k) pin_ptr(lds, (k))
    unsigned char* ws = P.ws;
    gu32* ctl = (gu32*)(ws + WS_CTL);
    XcdBarrier bar = xcd_barrier_post((unsigned*)(ctl + CW_BAR), MISC + 8);
#define GRID_BAR() do { xcd_barrier(bar); NEWPH(); } while (0)
    float* const xout = P.out;
    unsigned char* wsl = ws;
#define NEWPH() asm volatile("" : "+s"(wsl), "+s"(ldsb))
#define ssb ((float*)(wsl + WS_SS))
#define route ((unsigned*)(wsl + WS_ROUTE))
#define wr_all ((bf16*)(wsl + WS_WR))
#define dch ((float*)(wsl + WS_DCH))
#define lists ((int*)(wsl + WS_LISTS))
#define memn ((bf16*)(wsl + WS_MEMN))
#define kvb ((bf16*)(wsl + WS_KV))
#define xb ((bf16*)(wsl + WS_XB))
#define mix ((bf16*)(wsl + WS_MIX))
#define proj ((bf16*)(wsl + WS_PROJ))
#define xq ((bf16*)(wsl + WS_PROJ))
#define hid ((bf16*)(wsl + WS_HID))
#define w13t ((bf16*)(wsl + WS_WM))
#define w2t ((bf16*)(wsl + WS_WM + WM_W2))

    { FL
    for (int i = 0; i < 4; ++i) {
        const int j = i >> 1; unsigned char* wl = wsl + WS_W + (size_t)i * W_LAYER;
        if ((i & 1) == 0) {
            convert_matrix(PIN(9) + (size_t)j * 1024 * 3072, 1024, 3072, (bf16*)(wl + W_IN), PIN(6) + i * 1024, 1.0f, 0, gw, NGW, scr, lane, 2048);
            convert_matrix(PIN(10) + (size_t)j * 1024 * 1024, 1024, 1024, (bf16*)(wl + W_OUT), nullptr, 1.0f, 0, gw, NGW, scr, lane);
        } else {
            convert_matrix(PIN(16) + (size_t)j * 1024 * 3072, 1024, 3072, (bf16*)(wl + W_IN), PIN(6) + i * 1024, 0.125f * LOG2E, 1024, gw, NGW, scr, lane);
            convert_matrix(PIN(17) + (size_t)j * 1024 * 1024, 1024, 1024, (bf16*)(wl + W_OUT), nullptr, 1.0f, 0, gw, NGW, scr, lane);
        }
        for (int e = (gw * 64 + lane) * 8; e < 1024 * 1024; e += NGW * 64 * 8) { const int k = e >> 10, n = e & 1023; const float* src = PIN(23) + (size_t)i * 1024 * 1024 + e; const float gk = PIN(7)[i * 1024 + k] * (0.0625f * LOG2E);
            const f32x4 a = *(const GAS f32x4*)src, bq = *(const GAS f32x4*)(src + 4);
            *(GAS v4u*)((bf16*)(wl + W_XQ) + (size_t)(n >> 8) * 262144 + k * 256 + (n & 255)) = (v4u){pk2(a[0] * gk, a[1] * gk), pk2(a[2] * gk, a[3] * gk), pk2(bq[0] * gk, bq[1] * gk), pk2(bq[2] * gk, bq[3] * gk)}; }
        for (int hh = 0; hh < 4; ++hh) convert_matrix(PIN(25) + (size_t)i * 1024 * 1024 + (size_t)hh * 256 * 1024, 256, 1024, (bf16*)(wl + W_XO) + (size_t)hh * 262144, nullptr, 1.0f, 0, gw, NGW, scr, lane);
        convert_matrix(PIN(24) + (size_t)i * 1024 * 2048, 1024, 2048, (bf16*)(wsl + WS_W + W_KV) + (size_t)i * 2048 * 1024, nullptr, 1.0f, 0, gw, NGW, scr, lane);
    }
    for (int e = blk * NTHR + tid; e < 4 * 32 * 1024; e += G * NTHR) { const int l = e >> 15, jr = (e >> 10) & 31, k = e & 1023; float v = 0.f;
        if (jr < 4) v = PIN(26)[((size_t)l * 1024 + k) * 4 + jr]; else if (jr < 20) v = PIN(28)[((size_t)l * 1024 + k) * 16 + (jr - 4)];
        wr_all[e] = (bf16)f2bf(v * PIN(8)[l * 1024 + k]); }
    for (int m = gw; m < MT; m += NGW) row_norm_bf16(PIN(1) + (size_t)m * 1024, PIN(3), memn + (size_t)m * 1024, lane);
    for (int m = gw; m < T; m += 4 * NGW) rows4_to_xb(PIN(0), xb, ssb, m, NGW, lane);
    }
    GRID_BAR();
    { pg8::Gemm g{memn, (const bf16*)(wsl + WS_W + W_KV), 1024, 1024, 1024}; pg8::StaticOrder S; S.init(MT, 8192, G, blk);
      pg8::EpiBlocks256 E{kvb};
      pg8::gemm_phase<pg8::EpiBlocks256, pg8::StaticOrder, true, false>(lds, g, S, E); }


    for (int i = 0; i < 4; ++i) {
        const int j = i >> 1; unsigned char* wl = wsl + WS_W + (size_t)i * W_LAYER;
        __syncthreads();
        { FL convert_moe(PIN(30) + (size_t)i * 16 * 1024 * 512, PIN(31) + (size_t)i * 16 * 1024 * 512, PIN(32) + (size_t)i * 16 * 512 * 1024, w13t, w2t, PIN(8) + i * 1024, gw, NGW, scr, lane); }
        __syncthreads();
        {
        { pg8::Gemm g{xb, (const bf16*)(wl + W_IN), 1024, 1024, 1024}; pg8::StaticOrder S; S.init(T, 3072, G, blk);
          const bool tb = pg8::build_rs_table(S, ssb); __syncthreads();
          pg8::EpiNormBf16 E{proj, 3072, ssb, 0, tb, (i & 1) ? (1 << 30) : 8};
          pg8::gemm_phase<pg8::EpiNormBf16, pg8::StaticOrder, true, false>(lds, g, S, E); }
        GRID_BAR();
        if ((i & 1) == 0) {
            hgrn_phaseA(lds, blk, G, proj, mix, dch, PIN(5), j);
            GRID_BAR();
            hgrn_phaseB(proj, dch, G);
            for (int u = blk; u < NB * (SEQ / CV_R); u += G) conv_unit(lds, u, proj, mix, PIN(12) + (size_t)j * 31 * 512, PIN(13) + j * 512, PIN(14) + j * 512, PIN(15) + j * 512);
            GRID_BAR();
            hgrn_phaseC(lds, blk, G, proj, mix, PIN(11) + j * 128);
        } else {
            float d1 = 0.f, d2 = 0.f;
            for (int k = 0; k < 64; ++k) { d1 += PIN(18)[j * 64 + k] * PIN(19)[j * 64 + k]; d2 += PIN(20)[j * 64 + k] * PIN(21)[j * 64 + k]; }
            const float lam_init = (j == 0) ? P.lam_init[0] : P.lam_init[1], lam = __expf(d1) - __expf(d2) + lam_init;
            const int vcu = (G % 8 == 0) ? (blk % 8) * (G / 8) + blk / 8 : blk;
            for (int idx = vcu; idx < 2048; idx += G) { const int bh = idx >> 4, pr = idx & 15, b = bh >> 3, h = bh & 7;
                diffattn_unit(lds, b, h, 31 - pr, proj, mix, lam, lam_init, PIN(22) + j * 128, PIN(2), (const LAS unsigned char*)(lds + MISC_OFF + 784));
                diffattn_unit(lds, b, h, pr, proj, mix, lam, lam_init, PIN(22) + j * 128, PIN(2), (const LAS unsigned char*)(lds + MISC_OFF + 784)); }
        }
        }
        GRID_BAR();
        { pg8::Gemm g{mix, (const bf16*)(wl + W_OUT), 1024, 1024, 1024}; pg8::StaticOrder S; S.init(T, 1024, G, blk);
          pg8::EpiResidual E{xb, ssb};
          pg8::gemm_phase<pg8::EpiResidual, pg8::StaticOrder, true, false>(lds, g, S, E); }
        { const bf16* kvl = kvb + (size_t)i * 16 * 8 * 65536;
          for (int mode = 0; mode < 2; ++mode) {
              pg8::Gemm g{mode ? (const bf16*)(wl + W_XO) : kvl, mode ? kvl : (const bf16*)(wl + W_XQ), 256, 256, 256}; pg8::FoldOrder S{G, blk, mode};
              pg8::EpiNormBf16 E{(bf16*)(wsl + WS_FOLD + (mode ? 32 * MiB : 0)), 1024, nullptr, 1, false, 1 << 30};
              pg8::gemm_phase<pg8::EpiNormBf16, pg8::FoldOrder, true, false>(lds, g, S, E); } }
        GRID_BAR();
        { pg8::Gemm g{xb, (const bf16*)(wsl + WS_FOLD), 1024, 1024, 1024}; pg8::BatchOrder S; S.init(T, 1024, G, blk);
          const bool tb = pg8::build_rs_table(S, ssb); __syncthreads();
          pg8::EpiSoftmaxBf16 E{xq, ssb, (LAS float*)(lds + 131072), tb};
          pg8::gemm_phase<pg8::EpiSoftmaxBf16, pg8::BatchOrder, true, false>(lds, g, S, E); }
        GRID_BAR();
        { pg8::Gemm g{xq, (const bf16*)(wsl + WS_FOLD + 32 * MiB), 1024, 1024, 1024}; pg8::BatchOrder S; S.init(T, 1024, G, blk);
          pg8::EpiResidual E{xb, ssb};
          pg8::gemm_phase<pg8::EpiResidual, pg8::BatchOrder, true, false>(lds, g, S, E); }
        GRID_BAR();
        for (int tile = blk; tile < T / 256; tile += G)
            router_tile256(lds, tile, xb, ssb, wr_all + (size_t)i * 32 * 1024, PIN(27) + i * 4, PIN(29) + i * 16, route, lists, (unsigned*)(ctl + CW_CNT + 32 * (i * 32)));
        GRID_BAR();
        LAS int* tab = (LAS int*)(lds + MISC_OFF) + 32;
        const int mvc = (G % 8 == 0) ? (blk % 8) * (G / 8) + blk / 8 : blk;
        { FL if (tid < 32) tab[33 + tid] = (int)__hip_atomic_load(ctl + CW_CNT + 32 * (i * 32 + tid), RLX_AGENT);
        __syncthreads();
        if (tid == 0) { int a = 0; tab[0] = 0; for (int q = 0; q < 32; ++q) { a += (tab[33 + q] + 255) >> 8; tab[q + 1] = a; } } }
        __syncthreads();
        { pg8::Gemm g{xb, w13t, 1024, 1024, 1024}; pg8::MoeOrder S{G, mvc, 0, tab[32], tab, lists, (LAS unsigned short*)(lds + 131072), 8};
          pg8::EpiSwiglu E{hid, lists, (const float*)route, (LAS unsigned short*)(lds + 131072)};
          pg8::gemm_phase<pg8::EpiSwiglu, pg8::MoeOrder, true, true>(lds, g, S, E); }
        GRID_BAR();
        { pg8::Gemm g{hid, w2t, 1024, 1024, 512}; pg8::MoeOrder S{G, mvc, 0, tab[32], tab, lists, (LAS unsigned short*)(lds + 131072), 4};
          pg8::EpiMoeDown E{xb, ssb, lists};
          pg8::gemm_phase<pg8::EpiMoeDown, pg8::MoeOrder, true, false, true>(lds, g, S, E); }
        GRID_BAR();
    }
    { FL f32x4 gg[4]; { const GAS f32x4* gr = (const GAS f32x4*)PIN(4) + lane;
#pragma unroll
      for (int j = 0; j < 4; ++j) gg[j] = gr[64 * j]; }
      for (int m = gw; m < T; m += 4 * NGW) rows4_final(xb, xout, ssb, gg, m, NGW, lane); }
}

extern "C" void kernel_launch(void* const* d_in, const int* in_sizes, int n_in, void* d_out, int out_size, void* d_ws, size_t ws_size, hipStream_t stream) {
    static int grid = 0;
    if (grid == 0) {
        if (n_in != 33 || out_size != T * DM || ws_size < WS_END) { fprintf(stderr, "kernel_launch: unexpected problem (n_in %d out %d ws %zu)\n", n_in, out_size, ws_size); grid = -1; return; }
        int dev = 0, cus = 0, per_cu = 0;
        if (hipGetDevice(&dev) != hipSuccess || hipDeviceGetAttribute(&cus, hipDeviceAttributeMultiprocessorCount, dev) != hipSuccess) { grid = -1; return; }
        if (hipFuncSetAttribute((const void*)mk_fwd, hipFuncAttributeMaxDynamicSharedMemorySize, LDS_BYTES) != hipSuccess) { fprintf(stderr, "kernel_launch: hipFuncSetAttribute failed\n"); grid = -1; return; }
        if (hipOccupancyMaxActiveBlocksPerMultiprocessor(&per_cu, (const void*)mk_fwd, NTHR, LDS_BYTES) != hipSuccess || per_cu < 1) { fprintf(stderr, "kernel_launch: occupancy query says %d\n", per_cu); }
        (void)hipGetLastError();
        grid = cus;
        while (grid > 1 && (T % (32 * grid)) != 0) --grid;
    }
    if (grid < 0) return;
    if (hipMemsetAsync((char*)d_ws + WS_CTL, 0, CTL_ZERO_BYTES, stream) != hipSuccess) return;
    Params p; memset(&p, 0, sizeof(p));
    for (int i = 0; i < 33; ++i) p.in[i] = (const float*)d_in[i];
    p.out = (float*)d_out; p.ws = (unsigned char*)d_ws;
    p.lam_init[0] = (float)(0.8 - 0.6 * exp(-0.3 * 1.0)); p.lam_init[1] = (float)(0.8 - 0.6 * exp(-0.3 * 3.0));
    for (int n = 0; n < 128; ++n) { int bk; if (n < 16) bk = n; else { bk = 16 + (int)(log((double)n / 16.0) / log(8.0) * 16.0); if (bk > 31) bk = 31; if (bk < 0) bk = 0; } p.bucket[n] = (unsigned char)bk; }
    hipLaunchKernelGGL(mk_fwd, dim3(grid), dim3(NTHR), LDS_BYTES, stream, p);
}
```

```cpp
#include <hip/hip_runtime.h>
#include <cstdio>
#include <cstdint>
#include <cmath>
#include <cstring>
extern __shared__ __attribute__((aligned(16))) unsigned char lds_raw[];
constexpr int WAVE_TAB_OFF = 160 * 1024 - 1024;
__device__ __forceinline__ int hw_slot() { return (int)(__builtin_amdgcn_s_getreg((5 << 11) | 4) & 0x3f); }
__device__ __forceinline__ int otid() {
    const int wv = __builtin_amdgcn_readfirstlane(((const __attribute__((address_space(3))) int*)((const __attribute__((address_space(3))) unsigned char*)lds_raw + WAVE_TAB_OFF))[hw_slot()]);
    int t = wv * 64 + (int)__builtin_amdgcn_mbcnt_hi(~0u, __builtin_amdgcn_mbcnt_lo(~0u, 0u)); asm volatile("" : "+v"(t)); return t; }
#ifndef SHFL_SAFE
#define SHFL_SAFE 1
#endif
#if SHFL_SAFE
template <int M> __device__ __forceinline__ float xor_lt32(float v) { return __shfl_xor(v, M); }
__device__ __forceinline__ float sum_halves(float v) { return v + __shfl_xor(v, 32); }
__device__ __forceinline__ float max_halves(float v) { return __builtin_fmaxf(v, __shfl_xor(v, 32)); }
#else
template <int M> __device__ __forceinline__ float xor_lt32(float v) { return __builtin_bit_cast(float, __builtin_amdgcn_ds_swizzle(__builtin_bit_cast(int, v), 0x1f | (M << 10))); }
__device__ __forceinline__ float sum_halves(float v) { auto rr = __builtin_amdgcn_permlane32_swap(__builtin_bit_cast(unsigned, v), __builtin_bit_cast(unsigned, v), false, false); return __builtin_bit_cast(float, rr[0]) + __builtin_bit_cast(float, rr[1]); }
__device__ __forceinline__ float max_halves(float v) { auto rr = __builtin_amdgcn_permlane32_swap(__builtin_bit_cast(unsigned, v), __builtin_bit_cast(unsigned, v), false, false); return __builtin_fmaxf(__builtin_bit_cast(float, rr[0]), __builtin_bit_cast(float, rr[1])); }
#endif
namespace pg8 {
#define PG8_LAS __attribute__((address_space(3)))
#define PG8_GAS __attribute__((address_space(1)))
typedef unsigned short bf16_t;
typedef short bf16x8 __attribute__((ext_vector_type(8)));
typedef float f32x4 __attribute__((ext_vector_type(4)));
typedef float f32x2 __attribute__((ext_vector_type(2)));
typedef unsigned u32x4 __attribute__((ext_vector_type(4)));
typedef unsigned u32x2 __attribute__((ext_vector_type(2)));
constexpr int BM = 256, BK = 64, HALF = 128, HTB = HALF * BK * 2, STAGE_BYTES = 8 * HTB, NXCD = 8, WGM = 8;

__host__ __device__ __forceinline__ int lds_byte(int r, int c) { const int st = (r >> 4) * 2 + (c >> 5), rr = r & 15, cc = c & 31, ob = rr * 64 + cc * 2; return st * 1024 + (ob ^ (((ob >> 9) & 1) << 5)); }
__host__ __device__ __forceinline__ void stage_rc(int b, int& R, int& C) { const int st = b / 1024, sb = b % 1024, swz = sb ^ (((sb >> 9) & 1) << 5); R = (st >> 1) * 16 + swz / 64; C = (st & 1) * 32 + (swz % 64) / 2; }
__host__ __device__ __forceinline__ int perm32(int rho) { const int n = rho >> 4, i = rho & 15; return 8 * (i >> 2) + 4 * n + (i & 3); }

struct Unit { int pm, pn, x0, x1, x2, x3, ui; long bd; };
constexpr int RS_TAB_OFF = 131072 + 8192, RS_TAB_UNITS = 12;
struct Gemm { const bf16_t* A; const bf16_t* Bt; int K, lda, ldb; };

struct StaticOrder {
    static constexpr bool PRELOAD = false;
    int nM, nN, nwg, G, c;
    __device__ __forceinline__ void init(int M, int N, int G_, int c_) { nM = M / BM; nN = N / BM; nwg = nM * nN; G = G_; c = c_; }
    __device__ __forceinline__ bool next(int i, Unit& u) const {
        const long L = (long)i * G + c; if (L >= nwg) return false;
        int wgid = (int)L; { const int q = nwg / NXCD, r = nwg % NXCD, xcd = wgid % NXCD, off = wgid / NXCD; wgid = (xcd < r ? xcd * (q + 1) : r * (q + 1) + (xcd - r) * q) + off; }
        const int nig = WGM * nN, gid = wgid / nig, fm = gid * WGM, gsz = (nM - fm) < WGM ? (nM - fm) : WGM;
        u.pm = fm + ((wgid % nig) % gsz); u.pn = (wgid % nig) / gsz; u.x0 = u.pn; u.x1 = 0; u.x2 = 256; u.x3 = 0; u.bd = 0; return true;
    }
    __device__ __forceinline__ void preload(int) const {}
    __device__ __forceinline__ unsigned rowoff(int, int) const { return 0u; }
};

struct BatchOrder : StaticOrder {
    __device__ __forceinline__ bool next(int i, Unit& u) const { if (!StaticOrder::next(i, u)) return false; u.pn = (u.pm >> 4) * 4 + u.x0; return true; }
};
struct FoldOrder {
    static constexpr bool PRELOAD = false;
    int G, c, mode;
    __device__ __forceinline__ bool next(int i, Unit& u) const { const int L = i * G + c; if (L >= 256) return false; const int bh = L >> 2, q = L & 3, b = bh >> 2, h = bh & 3;
        if (mode == 0) { u.pm = b * 8 + h; u.pn = h * 4 + q; u.x0 = q; u.x1 = b * 4 + h; } else { u.pm = h * 4 + q; u.pn = b * 8 + 4 + h; u.x0 = h; u.x1 = b * 4 + q; }
        u.x2 = 256; u.x3 = 0; u.bd = 0; return true; }
    __device__ __forceinline__ void preload(int) const {}
    __device__ __forceinline__ unsigned rowoff(int, int) const { return 0u; }
};
struct MoeOrder {
    static constexpr bool PRELOAD = true;
    int G, c, t0, t1; const PG8_LAS int* tab; const int* lists; PG8_LAS unsigned short* tokl; int ncol;
    __device__ __forceinline__ PG8_LAS unsigned* uinfo() const { return (PG8_LAS unsigned*)(lds_raw + (160 * 1024 - 2048) + 1280); }
    __device__ __forceinline__ bool tile_of(int i, int& tile, int& col) const { const int L = i * G + c; const int sh = (ncol == 8) ? 3 : 2; tile = t0 + (L >> sh); col = L & (ncol - 1); return tile < t1; }
    __device__ __forceinline__ unsigned scan(int tile) const {
        int idx = 0;
        for (int j = 0; j < 32; ++j) { if (tab[j + 1] > tile) { idx = j; break; } }
        const int mt = tile - tab[idx]; int nv = tab[33 + idx] - mt * 256; nv = nv > 256 ? 256 : nv;
        return (unsigned)idx | ((unsigned)(nv - 1) << 8) | ((unsigned)mt << 16); }
    __device__ __forceinline__ bool next(int i, Unit& u) const {
        int tile, col; if (!tile_of(i, tile, col)) return false;
        const unsigned w = uinfo()[i]; const int idx = w & 31, nv = ((w >> 8) & 255) + 1, mt = w >> 16;
        const int gs = idx / 6, q = idx - gs * 6, lo = gs * 4 + ((0x211000 >> (4 * q)) & 15), hi = gs * 4 + ((0x332321 >> (4 * q)) & 15);
        u.pm = tile; u.x0 = idx; u.x1 = mt; u.x2 = nv; u.x3 = col;
        if (ncol == 8) { u.pn = ((col < 4) ? lo : hi) * 4 + (col & 3); u.bd = 0; }
        else { u.pn = lo * 4 + col; u.bd = (long)(hi - lo) * 4 * (256 * 512 * 2) - 8 * (BK * 2); }
        return true;
    }
    __device__ __forceinline__ void preload(int tid) const {
        { int tile, col; if (tid < 32 && tile_of(tid, tile, col)) uinfo()[tid] = scan(tile); }
        if (ncol != 8) return;
        const int half = tid >> 8, r = tid & 255;
#pragma unroll 1
        for (int i0 = 0; ; i0 += 4) { int tile, col; if (!tile_of(i0, tile, col)) break;
            unsigned w[2]; bool ok[2]; int tok[2];
#pragma unroll
            for (int j = 0; j < 2; ++j) { const int ii = i0 + 2 * j + half; ok[j] = tile_of(ii, tile, col); tok[j] = 0; w[j] = 0u;
                if (ok[j]) { w[j] = scan(tile); if (r <= (int)((w[j] >> 8) & 255)) tok[j] = ((const PG8_GAS int*)lists)[(size_t)(w[j] & 31) * 65536 + (w[j] >> 16) * 256 + r]; } }
#pragma unroll
            for (int j = 0; j < 2; ++j) { const int ii = i0 + 2 * j + half; if (ok[j]) tokl[ii * 256 + r] = (unsigned short)tok[j]; }
        } }
    __device__ __forceinline__ unsigned rowoff(int ui, int row) const { return (unsigned)tokl[ui * 256 + row]; }
};

__device__ __forceinline__ unsigned cvt_pk_bf16(float lo, float hi) { unsigned r; asm volatile("v_cvt_pk_bf16_f32 %0, %1, %2" : "=v"(r) : "v"(lo), "v"(hi)); return r; }

__device__ __forceinline__ float row_rs(const float* ss, int row) {
    const PG8_GAS f32x4* sp = (const PG8_GAS f32x4*)(ss + (size_t)row * 16); const f32x4 a = sp[0], b = sp[1], c = sp[2], d = sp[3];
    const float s = ((a[0] + a[1]) + (a[2] + a[3])) + ((b[0] + b[1]) + (b[2] + b[3])) + ((c[0] + c[1]) + (c[2] + c[3])) + ((d[0] + d[1]) + (d[2] + d[3]));
    return __builtin_amdgcn_rsqf(s * (1.0f / 1024.0f) + 1e-6f);
}
__device__ __forceinline__ void rows8_rs(const float* ss, int row0, float (&rr)[8]) {
#pragma unroll
    for (int q = 0; q < 8; q += 2) { rr[q] = row_rs(ss, row0 + (q >> 2) * HALF + (q & 3) * 16); rr[q + 1] = row_rs(ss, row0 + ((q + 1) >> 2) * HALF + ((q + 1) & 3) * 16); asm volatile("" : "+v"(rr[q]), "+v"(rr[q + 1]) :: "memory"); }
}
__device__ __forceinline__ void rows8_tab(int ui, int wr, int fr, float (&rr)[8]) {
    const PG8_LAS float* tp = (const PG8_LAS float*)(lds_raw + RS_TAB_OFF) + ui * 256 + wr * 64 + fr;
#pragma unroll
    for (int q = 0; q < 8; ++q) rr[q] = tp[(q >> 2) * HALF + (q & 3) * 16];
}
template <class Sched>
__device__ __forceinline__ bool build_rs_table(const Sched& S, const float* ss) {
    { Unit t; if (S.next(RS_TAB_UNITS, t)) return false; }
    const int tid = otid(), r = tid >> 1, hf = tid & 1; PG8_LAS float* tab = (PG8_LAS float*)(lds_raw + RS_TAB_OFF);
#pragma unroll 1
    for (int i0 = 0; i0 < RS_TAB_UNITS; i0 += 4) {
        f32x4 a[4][2]; bool ok[4];
#pragma unroll
        for (int j = 0; j < 4; ++j) { Unit u; ok[j] = S.next(i0 + j, u); if (ok[j]) { const PG8_GAS f32x4* sp = (const PG8_GAS f32x4*)(ss + ((size_t)u.pm * BM + r) * 16 + 8 * hf); a[j][0] = sp[0]; a[j][1] = sp[1]; } }
#pragma unroll
        for (int j = 0; j < 4; ++j) if (ok[j]) { float s_ = ((a[j][0][0] + a[j][0][1]) + (a[j][0][2] + a[j][0][3])) + ((a[j][1][0] + a[j][1][1]) + (a[j][1][2] + a[j][1][3])); s_ += __shfl_xor(s_, 1);
            if (hf == 0) tab[(i0 + j) * 256 + r] = __builtin_amdgcn_rsqf(s_ * (1.0f / 1024.0f) + 1e-6f); }
        if (!ok[3]) break;
    }
    return true;
}
struct EpiNormBf16 {
    static constexpr bool PERM = true; static constexpr int NSTORE = 8;
    bf16_t* O; int ldc; const float* ss; int rowsel; bool tab; int glu_from;
    __device__ __forceinline__ void operator()(const f32x4 (&acc)[2][2][4][2], const Unit& u, int wr, int wc, int fr, int fq) const {
        const int row0 = (rowsel ? u.x1 : u.pm) * BM + wr * 64 + fr, col0 = u.x0 * BM + wc * 32 + 8 * fq;
        float rr8[8];
        if (tab) rows8_tab(u.ui, wr, fr, rr8); else if (ss) rows8_rs(ss, row0, rr8); else {
#pragma unroll
            for (int q = 0; q < 8; ++q) rr8[q] = 1.0f; }
        if (u.x0 >= glu_from) {
            const int gcol = glu_from * BM + (u.x0 - glu_from) * HALF + wc * 32 + 8 * fq;
#pragma unroll
            for (int ai = 0; ai < 2; ++ai)
#pragma unroll
                for (int m = 0; m < 4; ++m) { const int row = row0 + ai * HALF + m * 16; const float rr = rr8[ai * 4 + m]; const float c1 = -1.44269504f * rr; const f32x2 c1v = {c1, c1}, rrv = {rr, rr}, one = {1.0f, 1.0f};
                    float hv[8];
#pragma unroll
                    for (int n = 0; n < 2; ++n)
#pragma unroll
                        for (int j = 0; j < 4; j += 2) { const f32x2 vv = {acc[ai][0][m][n][j], acc[ai][0][m][n][j + 1]}, gg = {acc[ai][1][m][n][j], acc[ai][1][m][n][j + 1]};
                            f32x2 e = gg * c1v; e[0] = __builtin_amdgcn_exp2f(e[0]); e[1] = __builtin_amdgcn_exp2f(e[1]); e += one;
                            f32x2 sg; sg[0] = __builtin_amdgcn_rcpf(e[0]); sg[1] = __builtin_amdgcn_rcpf(e[1]);
                            const f32x2 h2 = (vv * rrv) * sg; hv[n * 4 + j] = h2[0]; hv[n * 4 + j + 1] = h2[1]; }
                    u32x4 w; w.x = cvt_pk_bf16(hv[0], hv[1]); w.y = cvt_pk_bf16(hv[2], hv[3]); w.z = cvt_pk_bf16(hv[4], hv[5]); w.w = cvt_pk_bf16(hv[6], hv[7]);
                    *(PG8_GAS u32x4*)(O + (size_t)row * ldc + gcol) = w; }
            return; }
#pragma unroll
        for (int ai = 0; ai < 2; ++ai)
#pragma unroll
            for (int m = 0; m < 4; ++m) { const int row = row0 + ai * HALF + m * 16; const float rr = rr8[ai * 4 + m]; bf16_t* rowp = O + (size_t)row * ldc + col0;
#pragma unroll
                for (int bj = 0; bj < 2; ++bj) { const f32x4 v0 = acc[ai][bj][m][0] * rr, v1 = acc[ai][bj][m][1] * rr;
                    u32x4 w; w.x = cvt_pk_bf16(v0[0], v0[1]); w.y = cvt_pk_bf16(v0[2], v0[3]); w.z = cvt_pk_bf16(v1[0], v1[1]); w.w = cvt_pk_bf16(v1[2], v1[3]);
                    *(PG8_GAS u32x4*)(rowp + bj * HALF) = w; } }
    }
};
struct EpiBlocks256 {
    static constexpr bool PERM = true; static constexpr int NSTORE = 16;
    bf16_t* O;
    __device__ __forceinline__ void operator()(const f32x4 (&acc)[2][2][4][2], const Unit& u, int wr, int wc, int fr, int fq) const {
        bf16_t* base = O + (size_t)(((u.x0 >> 3) * 16 + u.pm) * 8 + (u.x0 & 7)) * 65536 + (wr * 64 + fr) * 256 + wc * 32 + 8 * fq;
#pragma unroll
        for (int ai = 0; ai < 2; ++ai)
#pragma unroll
            for (int m = 0; m < 4; ++m) { bf16_t* rowp = base + (ai * HALF + m * 16) * 256;
#pragma unroll
                for (int bj = 0; bj < 2; ++bj) { const f32x4 v0 = acc[ai][bj][m][0], v1 = acc[ai][bj][m][1];
                    u32x4 w; w.x = cvt_pk_bf16(v0[0], v0[1]); w.y = cvt_pk_bf16(v0[2], v0[3]); w.z = cvt_pk_bf16(v1[0], v1[1]); w.w = cvt_pk_bf16(v1[2], v1[3]);
                    *(PG8_GAS u32x4*)(rowp + bj * HALF) = w; } }
    }
};
__device__ __forceinline__ float bf_lo(unsigned w) { return __builtin_bit_cast(float, w << 16); }
__device__ __forceinline__ float bf_hi(unsigned w) { return __builtin_bit_cast(float, w & 0xffff0000u); }
struct EpiResidual {
    static constexpr bool PERM = true; static constexpr int NSTORE = 16;
    bf16_t* xb; float* ss;
    __device__ __forceinline__ void operator()(const f32x4 (&acc)[2][2][4][2], const Unit& u, int wr, int wc, int fr, int fq) const {
        const int row0 = u.pm * BM + wr * 64 + fr, col0 = u.x0 * BM + wc * 32 + 8 * fq;
#pragma unroll
        for (int ai = 0; ai < 2; ++ai) {
            u32x4 rv[4][2];
#pragma unroll
            for (int m = 0; m < 4; ++m)
#pragma unroll
                for (int bj = 0; bj < 2; ++bj) rv[m][bj] = *(const __attribute__((address_space(1))) u32x4*)(xb + (size_t)(row0 + ai * HALF + m * 16) * 1024 + col0 + bj * HALF);
#pragma unroll
            for (int m = 0; m < 4; ++m) { const int row = row0 + ai * HALF + m * 16; float q = 0.f; bf16_t* rowp = xb + (size_t)row * 1024 + col0;
#pragma unroll
                for (int bj = 0; bj < 2; ++bj) { const u32x4 r = rv[m][bj];
                    const f32x4 a0 = acc[ai][bj][m][0], a1 = acc[ai][bj][m][1];
                    const float v0 = bf_lo(r.x) + a0[0], v1 = bf_hi(r.x) + a0[1], v2 = bf_lo(r.y) + a0[2], v3 = bf_hi(r.y) + a0[3];
                    const float v4 = bf_lo(r.z) + a1[0], v5 = bf_hi(r.z) + a1[1], v6 = bf_lo(r.w) + a1[2], v7 = bf_hi(r.w) + a1[3];
                    q += ((v0 * v0 + v1 * v1) + (v2 * v2 + v3 * v3)) + ((v4 * v4 + v5 * v5) + (v6 * v6 + v7 * v7));
                    u32x4 w; w.x = cvt_pk_bf16(v0, v1); w.y = cvt_pk_bf16(v2, v3); w.z = cvt_pk_bf16(v4, v5); w.w = cvt_pk_bf16(v6, v7);
                    *(PG8_GAS u32x4*)(rowp + bj * HALF) = w; }
                q += xor_lt32<16>(q); q = sum_halves(q);
                if (fq == 0) ((PG8_GAS float*)ss)[(size_t)row * 16 + u.x0 * 4 + wc] = q; } }
    }
};
struct EpiSoftmaxBf16 {
    static constexpr bool PERM = true, MUTABLE = true; static constexpr int NSTORE = 16;
    bf16_t* O; const float* ss; PG8_LAS float* xch; bool tab;
    __device__ __forceinline__ void operator()(f32x4 (&acc)[2][2][4][2], const Unit& u, int wr, int wc, int fr, int fq) const {
        const int row0 = u.pm * BM + wr * 64 + fr, col0 = u.x0 * BM + wc * 32 + 8 * fq;
        float mw[8], rr8[8]; if (tab) rows8_tab(u.ui, wr, fr, rr8); else rows8_rs(ss, row0, rr8);
#pragma unroll
        for (int ai = 0; ai < 2; ++ai)
#pragma unroll
            for (int m = 0; m < 4; ++m) { const float rr = rr8[ai * 4 + m]; float mx = -3.0e38f;
#pragma unroll
                for (int bj = 0; bj < 2; ++bj)
#pragma unroll
                    for (int n = 0; n < 2; ++n) { acc[ai][bj][m][n] *= rr; const f32x4 v = acc[ai][bj][m][n]; mx = __builtin_fmaxf(mx, __builtin_fmaxf(__builtin_fmaxf(v[0], v[1]), __builtin_fmaxf(v[2], v[3]))); }
                mx = __builtin_fmaxf(mx, xor_lt32<16>(mx)); mx = max_halves(mx); float sm = 0.f;
#pragma unroll
                for (int bj = 0; bj < 2; ++bj)
#pragma unroll
                    for (int n = 0; n < 2; ++n) { f32x4 v = acc[ai][bj][m][n];
#pragma unroll
                        for (int j = 0; j < 4; ++j) { v[j] = __builtin_amdgcn_exp2f(v[j] - mx); sm += v[j]; }
                        acc[ai][bj][m][n] = v; }
                sm += xor_lt32<16>(sm); sm = sum_halves(sm); mw[ai * 4 + m] = mx;
                if (fq == 0) { const int rit = ai * HALF + wr * 64 + m * 16 + fr; xch[(rit * 4 + wc) * 2] = mx; xch[(rit * 4 + wc) * 2 + 1] = sm; } }
        asm volatile("s_waitcnt lgkmcnt(0)" ::: "memory"); __builtin_amdgcn_s_barrier(); asm volatile("" ::: "memory");
#pragma unroll
        for (int ai = 0; ai < 2; ++ai)
#pragma unroll
            for (int m = 0; m < 4; ++m) { const int rit = ai * HALF + wr * 64 + m * 16 + fr; const int row = row0 + ai * HALF + m * 16;
                const f32x4 e0 = *(const PG8_LAS f32x4*)(xch + rit * 8), e1 = *(const PG8_LAS f32x4*)(xch + rit * 8 + 4);
                const float M = __builtin_fmaxf(__builtin_fmaxf(e0[0], e0[2]), __builtin_fmaxf(e1[0], e1[2]));
                const float tot = e0[1] * __builtin_amdgcn_exp2f(e0[0] - M) + e0[3] * __builtin_amdgcn_exp2f(e0[2] - M) + e1[1] * __builtin_amdgcn_exp2f(e1[0] - M) + e1[3] * __builtin_amdgcn_exp2f(e1[2] - M);
                const float f = __builtin_amdgcn_exp2f(mw[ai * 4 + m] - M) * __builtin_amdgcn_rcpf(tot); bf16_t* rowp = O + (size_t)row * 1024 + col0;
#pragma unroll
                for (int bj = 0; bj < 2; ++bj) { const f32x4 v0 = acc[ai][bj][m][0] * f, v1 = acc[ai][bj][m][1] * f;
                    u32x4 w; w.x = cvt_pk_bf16(v0[0], v0[1]); w.y = cvt_pk_bf16(v0[2], v0[3]); w.z = cvt_pk_bf16(v1[0], v1[1]); w.w = cvt_pk_bf16(v1[2], v1[3]);
                    *(PG8_GAS u32x4*)(rowp + bj * HALF) = w; } }
        asm volatile("s_waitcnt lgkmcnt(0)" ::: "memory");
    }
};
struct EpiSwiglu {
    static constexpr bool PERM = true; static constexpr int NSTORE = 0;
    bf16_t* hid; const int* lists; const float* route; const PG8_LAS unsigned short* tokl;
    __device__ __forceinline__ void operator()(const f32x4 (&acc)[2][2][4][2], const Unit& u, int wr, int wc, int fr, int fq) const {
        const int which = u.x3 >> 2, col0 = which * 512 + (u.x3 & 3) * 128 + wc * 32 + 8 * fq;
        unsigned pw[8];
#pragma unroll
        for (int q = 0; q < 8; ++q) { const int rit = (q >> 2) * HALF + wr * 64 + (q & 3) * 16 + fr; const unsigned tk = tokl[u.ui * 256 + rit]; pw[q] = ((const PG8_GAS unsigned*)route)[(size_t)tk * 4 + 1 + which]; }
#pragma unroll
        for (int ai = 0; ai < 2; ++ai)
#pragma unroll
            for (int m = 0; m < 4; ++m) { const int rit = ai * HALF + wr * 64 + m * 16 + fr; const float r1 = bf_lo(pw[ai * 4 + m]), r3 = bf_hi(pw[ai * 4 + m]);
                float hv[8];
                { typedef float f32x2 __attribute__((ext_vector_type(2))); const float c1 = -1.44269504f * r1, r13 = r1 * r3; const f32x2 c1v = {c1, c1}, r13v = {r13, r13}, one = {1.0f, 1.0f};
#pragma unroll
                  for (int n = 0; n < 2; ++n)
#pragma unroll
                      for (int j = 0; j < 4; j += 2) { const f32x2 g = {acc[ai][0][m][n][j], acc[ai][0][m][n][j + 1]}, uu = {acc[ai][1][m][n][j], acc[ai][1][m][n][j + 1]};
                          f32x2 e = g * c1v; e[0] = __builtin_amdgcn_exp2f(e[0]); e[1] = __builtin_amdgcn_exp2f(e[1]); e += one;
                          f32x2 sg; sg[0] = __builtin_amdgcn_rcpf(e[0]); sg[1] = __builtin_amdgcn_rcpf(e[1]);
                          const f32x2 h2 = (g * uu) * (sg * r13v); hv[n * 4 + j] = h2[0]; hv[n * 4 + j + 1] = h2[1]; } }
                u32x4 w; w.x = cvt_pk_bf16(hv[0], hv[1]); w.y = cvt_pk_bf16(hv[2], hv[3]); w.z = cvt_pk_bf16(hv[4], hv[5]); w.w = cvt_pk_bf16(hv[6], hv[7]);
                *(PG8_GAS u32x4*)(hid + (size_t)(u.pm * BM + rit) * 1024 + col0) = w; }
    }
};
struct EpiMoeDown {
    static constexpr bool PERM = true; static constexpr int NSTORE = 0;
    bf16_t* xb; float* ss; const int* lists;
    __device__ __forceinline__ void operator()(const f32x4 (&acc)[2][2][4][2], const Unit& u, int wr, int wc, int fr, int fq) const {
        const int pnl = u.x3, col0 = pnl * BM + wc * 32 + 8 * fq;
        const PG8_GAS int* lp = (const PG8_GAS int*)(lists + (size_t)u.x0 * 65536 + u.x1 * 256); const int last = u.x2 - 1;
        int tok[8];
#pragma unroll
        for (int q = 0; q < 8; ++q) { const int rit = (q >> 2) * HALF + wr * 64 + (q & 3) * 16 + fr; tok[q] = lp[rit < last ? rit : last]; }
#pragma unroll
        for (int ai = 0; ai < 2; ++ai) {
            u32x4 rv[4][2];
#pragma unroll
            for (int m = 0; m < 4; ++m)
#pragma unroll
                for (int bj = 0; bj < 2; ++bj) rv[m][bj] = *(const PG8_GAS u32x4*)(xb + (size_t)tok[ai * 4 + m] * 1024 + col0 + bj * HALF);
#pragma unroll
            for (int m = 0; m < 4; ++m) { const int rit = ai * HALF + wr * 64 + m * 16 + fr; const bool valid = rit <= last; float q = 0.f;
                bf16_t* rowp = xb + (size_t)tok[ai * 4 + m] * 1024 + col0;
#pragma unroll
                for (int bj = 0; bj < 2; ++bj) { const u32x4 r = rv[m][bj];
                    const f32x4 a0 = acc[ai][bj][m][0], a1 = acc[ai][bj][m][1];
                    const float v0 = bf_lo(r.x) + a0[0], v1 = bf_hi(r.x) + a0[1], v2 = bf_lo(r.y) + a0[2], v3 = bf_hi(r.y) + a0[3];
                    const float v4 = bf_lo(r.z) + a1[0], v5 = bf_hi(r.z) + a1[1], v6 = bf_lo(r.w) + a1[2], v7 = bf_hi(r.w) + a1[3];
                    q += ((v0 * v0 + v1 * v1) + (v2 * v2 + v3 * v3)) + ((v4 * v4 + v5 * v5) + (v6 * v6 + v7 * v7));
                    u32x4 w; w.x = cvt_pk_bf16(v0, v1); w.y = cvt_pk_bf16(v2, v3); w.z = cvt_pk_bf16(v4, v5); w.w = cvt_pk_bf16(v6, v7);
                    if (valid) *(PG8_GAS u32x4*)(rowp + bj * HALF) = w; }
                q += xor_lt32<16>(q); q = sum_halves(q); if (valid && fq == 0) ((PG8_GAS float*)ss)[(size_t)tok[ai * 4 + m] * 16 + pnl * 4 + wc] = q; }
        }
    }
};

template <class Epi, class Sched, bool ALIGN_EPI, bool GATHER, bool BSPLIT = false>
__device__ __forceinline__ void gemm_phase(PG8_LAS unsigned char* lds, const Gemm g, const Sched& S, const Epi& E) {
    const int tid = otid(), wid = __builtin_amdgcn_readfirstlane(tid >> 6), lane = tid & 63, wr = wid >> 2, wc = wid & 3, fr = lane & 15, fq = lane >> 4;
    const int K = g.K, nt = K / BK;
    unsigned voffA[2], voffB[2], cC2[2];
#pragma unroll
    for (int i = 0; i < 2; ++i) { int R, C; stage_rc(tid * 16 + i * 8192, R, C); const int Rb = Epi::PERM ? ((R & ~31) + perm32(R & 31)) : R;
        voffA[i] = (unsigned)(R * g.lda + C) * 2u; voffB[i] = (unsigned)(Rb * g.ldb + C) * 2u; cC2[i] = (unsigned)C * 2u; }
#define PG8_RR(i) ({ int R_, C_; stage_rc(tid * 16 + (i) * 8192, R_, C_); R_; })
    const size_t kstep = (size_t)(BK * 2);
    const size_t hstep = (size_t)HALF * g.lda * 2, hstepB = (size_t)HALF * g.ldb * 2;
    const size_t tstep = 2 * hstep, tstepB = 2 * hstepB;
    const unsigned ldsw = (unsigned)wid * 1024u;
    const int aoff = lds_byte(wr * 64 + fr, fq * 8), boff = lds_byte(wc * 32 + fr, fq * 8);
#define PG8_SA(b, h) (((b) * 2 + (h)) * HTB)
#define PG8_SB(b, h) ((4 + (b) * 2 + (h)) * HTB)
#define PG8_STAGE(bufoff, gbase, voff) do { _Pragma("unroll") for (int _i = 0; _i < 2; ++_i) \
        __builtin_amdgcn_global_load_lds((const unsigned*)((const char*)(gbase) + (voff)[_i]), (PG8_LAS unsigned*)(lds + (bufoff) + ldsw + _i * 8192), 16, 0, 0); } while (0)
#define PG8_STAGE_A(bufoff, h, kb, NX) do { if constexpr (GATHER) { const unsigned _p = (NX) ? nvA[h] : cvA[h]; unsigned _v[2]; _v[0] = (_p & 0xffffu) * (unsigned)(g.lda * 2) + cC2[0]; _v[1] = (_p >> 16) * (unsigned)(g.lda * 2) + cC2[1]; PG8_STAGE(bufoff, (const char*)g.A + (kb), _v); } \
        else { PG8_STAGE(bufoff, ((NX) ? nA : cA) + (h) * hstep + (kb), voffA); } } while (0)
#define PG8_LDA(dst, b, h) do { _Pragma("unroll") for (int m = 0; m < 4; ++m) _Pragma("unroll") for (int k = 0; k < 2; ++k) dst[m][k] = *(const PG8_LAS bf16x8*)(lds + PG8_SA(b, h) + aoff + m * 2048 + k * 1024); } while (0)
#define PG8_LDB(dst, b, h) do { _Pragma("unroll") for (int n = 0; n < 2; ++n) _Pragma("unroll") for (int k = 0; k < 2; ++k) dst[n][k] = *(const PG8_LAS bf16x8*)(lds + PG8_SB(b, h) + boff + n * 2048 + k * 1024); } while (0)
#define PG8_MMA(ai, bj, At, Bt) do { __builtin_amdgcn_s_setprio(1); _Pragma("unroll") for (int m = 0; m < 4; ++m) _Pragma("unroll") for (int n = 0; n < 2; ++n) _Pragma("unroll") for (int k = 0; k < 2; ++k) \
        acc[ai][bj][m][n] = __builtin_amdgcn_mfma_f32_16x16x32_bf16(Bt[n][k], At[m][k], acc[ai][bj][m][n], 0, 0, 0); __builtin_amdgcn_s_setprio(0); } while (0)
#define PG8_WAIT_V(n) asm volatile("s_waitcnt vmcnt(" #n ")" ::: "memory")
#define PG8_WAIT_L(n) asm volatile("s_waitcnt lgkmcnt(" #n ")" ::: "memory")
#define PG8_BAR __builtin_amdgcn_s_barrier()
#define PG8_SCHED __builtin_amdgcn_sched_barrier(0)
    Unit cur, nxt; int ui = 0;
    if constexpr (Sched::PRELOAD) { S.preload(tid); asm volatile("s_waitcnt vmcnt(0) lgkmcnt(0)" ::: "memory"); __builtin_amdgcn_s_barrier(); asm volatile("" ::: "memory"); }
    if (!S.next(0, cur)) return;
    cur.ui = 0;
    f32x4 acc[2][2][4][2];
#pragma unroll
    for (int a = 0; a < 2; ++a)
#pragma unroll
        for (int b = 0; b < 2; ++b)
#pragma unroll
            for (int m = 0; m < 4; ++m)
#pragma unroll
                for (int n = 0; n < 2; ++n) acc[a][b][m][n] = (f32x4){0.f, 0.f, 0.f, 0.f};
    bf16x8 At[4][2], B0[2][2], B1[2][2];
    unsigned cvA[2], nvA[2];
    const char* cA = (const char*)g.A + (GATHER ? (size_t)0 : (size_t)cur.pm * tstep); const char* cB = (const char*)g.Bt + (size_t)cur.pn * tstepB;
    const char* nA = cA;
    if constexpr (GATHER) {
#pragma unroll
        for (int h = 0; h < 2; ++h) { cvA[h] = S.rowoff(0, h * HALF + PG8_RR(0)) | (S.rowoff(0, h * HALF + PG8_RR(1)) << 16); nvA[h] = cvA[h]; }
    }
    PG8_STAGE(PG8_SB(0, 0), cB, voffB); PG8_STAGE(PG8_SB(0, 1), cB + hstepB, voffB); PG8_STAGE_A(PG8_SA(0, 0), 0, 0, false); PG8_STAGE_A(PG8_SA(0, 1), 1, 0, false);
    if (wr == 1) PG8_BAR;
    PG8_WAIT_V(2); PG8_BAR;
    PG8_STAGE(PG8_SB(1, 0), cB + kstep, voffB); PG8_STAGE_A(PG8_SA(1, 0), 0, kstep, false); PG8_STAGE(PG8_SB(1, 1), cB + hstepB + kstep, voffB);
    PG8_WAIT_V(6); PG8_BAR;
    for (;;) {
        const bool has_next = S.next(ui + 1, nxt);
        const char* nB = has_next ? (const char*)g.Bt + (size_t)nxt.pn * tstepB : cB;
        if constexpr (GATHER) {
            if (has_next) {
#pragma unroll
                for (int h = 0; h < 2; ++h) nvA[h] = S.rowoff(ui + 1, h * HALF + PG8_RR(0)) | (S.rowoff(ui + 1, h * HALF + PG8_RR(1)) << 16);
            } else { nvA[0] = cvA[0]; nvA[1] = cvA[1]; }
        } else { nA = has_next ? (const char*)g.A + (size_t)nxt.pm * tstep : cA; }
#pragma unroll 1
        for (int t = 0; t < nt; t += 2) {
            const bool last = (t == nt - 2);
            const size_t k1 = (size_t)(t + 1) * kstep;
            const size_t k2 = last ? (size_t)0 : (size_t)(t + 2) * kstep, k3 = k2 + kstep;
            const char* b2 = last ? nB : cB + (size_t)(t + 2) * kstep; if (BSPLIT) { if (!last && 2 * (t + 2) >= nt) b2 += cur.bd; }
            const char* b3 = b2 + kstep;
            const bool rlx = (Epi::NSTORE >= 16) && (t == 0) && (ui > 0);
            PG8_LDB(B0, 0, 0); PG8_LDB(B1, 0, 1); PG8_SCHED; PG8_LDA(At, 0, 0); PG8_STAGE_A(PG8_SA(1, 1), 1, k1, false);
            if (rlx) PG8_WAIT_V(24); else PG8_WAIT_V(8); PG8_WAIT_L(0); PG8_BAR; PG8_MMA(0, 0, At, B0); PG8_MMA(0, 1, At, B1); PG8_BAR; PG8_SCHED;
            PG8_LDA(At, 0, 1); PG8_STAGE(PG8_SB(0, 0), b2, voffB); PG8_STAGE(PG8_SB(0, 1), b2 + hstepB, voffB); PG8_STAGE_A(PG8_SA(0, 0), 0, k2, last);
            if (rlx) PG8_WAIT_V(24); else PG8_WAIT_V(8); PG8_WAIT_L(0); PG8_BAR; PG8_MMA(1, 0, At, B0); PG8_MMA(1, 1, At, B1); PG8_BAR; PG8_SCHED;
            PG8_LDB(B0, 1, 0); PG8_LDB(B1, 1, 1); PG8_SCHED; PG8_LDA(At, 1, 0); PG8_STAGE_A(PG8_SA(0, 1), 1, k2, last);
            PG8_WAIT_V(8); PG8_WAIT_L(0); PG8_BAR; PG8_MMA(0, 0, At, B0); PG8_MMA(0, 1, At, B1); PG8_BAR; PG8_SCHED;
            PG8_LDA(At, 1, 1); PG8_STAGE(PG8_SB(1, 0), b3, voffB); PG8_STAGE(PG8_SB(1, 1), b3 + hstepB, voffB); PG8_STAGE_A(PG8_SA(1, 0), 0, k3, last);
            PG8_WAIT_V(8); PG8_WAIT_L(0); PG8_BAR; PG8_MMA(1, 0, At, B0); PG8_MMA(1, 1, At, B1); PG8_BAR; PG8_SCHED;
        }
        if constexpr (ALIGN_EPI) { if (wr == 0) PG8_BAR; }
        E(acc, cur, wr, wc, fr, fq);
        if (!has_next) break;
#pragma unroll
        for (int a = 0; a < 2; ++a)
#pragma unroll
            for (int b = 0; b < 2; ++b)
#pragma unroll
                for (int m = 0; m < 4; ++m)
#pragma unroll
                    for (int n = 0; n < 2; ++n) acc[a][b][m][n] = (f32x4){0.f, 0.f, 0.f, 0.f};
        cur = nxt; cA = nA; cB = nB; ++ui; cur.ui = ui;
        if constexpr (GATHER) { cvA[0] = nvA[0]; cvA[1] = nvA[1]; }
        if constexpr (ALIGN_EPI) { if (wr == 1) PG8_BAR; }
    }
    PG8_WAIT_V(0);
    if constexpr (!ALIGN_EPI) { if (wr == 0) PG8_BAR; }
    PG8_BAR;
#undef PG8_SA
#undef PG8_RR
#undef PG8_SB
#undef PG8_STAGE
#undef PG8_STAGE_A
#undef PG8_LDA
#undef PG8_LDB
#undef PG8_MMA
#undef PG8_WAIT_V
#undef PG8_WAIT_L
#undef PG8_BAR
#undef PG8_SCHED
}
}
constexpr int NB = 16, SEQ = 4096, DM = 1024, T = NB * SEQ, MEML = 256, MT = NB * MEML;
constexpr int NWAVES = 8, NTHR = 512;
constexpr float EPS = 1e-6f, LOG2E = 1.4426950408889634f;
constexpr size_t MiB = 1u << 20;
constexpr size_t WS_CTL = 0, CTL_ZERO_BYTES = 1 * MiB;
constexpr size_t WS_SS = 2 * MiB;
constexpr size_t WS_ROUTE = 6 * MiB;
constexpr size_t WS_WR = 7 * MiB;
constexpr size_t WS_DCH = 8 * MiB;
constexpr size_t WS_LISTS = 10 * MiB;
constexpr size_t WS_MEMN = 18 * MiB;
constexpr size_t WS_KV = 26 * MiB;
constexpr size_t WS_W = 90 * MiB;
constexpr size_t W_IN = 0, W_OUT = 6 * MiB, W_XQ = 8 * MiB, W_XO = 10 * MiB, W_LAYER = 12 * MiB, W_KV = 48 * MiB;
constexpr size_t WS_WM = 154 * MiB;
constexpr size_t WM_W2 = 32 * MiB;
constexpr size_t WS_XB = 202 * MiB;
constexpr size_t WS_MIX = 330 * MiB;
constexpr size_t WS_PROJ = 458 * MiB;
constexpr size_t WS_HID = WS_PROJ + 128 * MiB;
constexpr size_t WS_FOLD = 842 * MiB;
constexpr size_t WS_END = 906 * MiB;
constexpr int CW_TMO = 0, CW_BAR = 4096, CW_CNT = 8192;
constexpr int LDS_BYTES = 160 * 1024, MISC_OFF = LDS_BYTES - 2048;

#define GAS __attribute__((address_space(1)))
#define LAS __attribute__((address_space(3)))
typedef unsigned short bf16;
typedef unsigned v4u __attribute__((ext_vector_type(4)));
typedef unsigned v2u __attribute__((ext_vector_type(2)));
typedef float f32x4 __attribute__((ext_vector_type(4)));
typedef float f32x16 __attribute__((ext_vector_type(16)));
typedef short bf16x8 __attribute__((ext_vector_type(8)));
typedef short s16x4 __attribute__((ext_vector_type(4)));
typedef GAS unsigned gu32;
#define RLX_AGENT __ATOMIC_RELAXED, __HIP_MEMORY_SCOPE_AGENT
#define LDS_WAIT() asm volatile("s_waitcnt lgkmcnt(0)" ::: "memory")
#define VM_WAIT() asm volatile("s_waitcnt vmcnt(0)" ::: "memory")
#define MFMA32(a, b, c) __builtin_amdgcn_mfma_f32_32x32x16_bf16((a), (b), (c), 0, 0, 0)
#define MFMA16(a, b, c) __builtin_amdgcn_mfma_f32_16x16x32_bf16((a), (b), (c), 0, 0, 0)
typedef float f32x2_t __attribute__((ext_vector_type(2))); typedef __bf16 bf16x2_t __attribute__((ext_vector_type(2)));
__device__ __forceinline__ unsigned pk2(float lo, float hi) { f32x2_t v = {lo, hi}; bf16x2_t b = __builtin_convertvector(v, bf16x2_t); return __builtin_bit_cast(unsigned, b); }
__device__ __forceinline__ unsigned f2bf(float f) { return pk2(f, 0.f) & 0xffffu; }
__device__ __forceinline__ float bf2f(unsigned short b) { return __builtin_bit_cast(float, (unsigned)b << 16); }
__device__ __forceinline__ float bflo(unsigned w) { return __builtin_bit_cast(float, w << 16); }
__device__ __forceinline__ float bfhi(unsigned w) { return __builtin_bit_cast(float, w & 0xffff0000u); }
__device__ __forceinline__ float sigmoidf_(float x) { return __builtin_amdgcn_rcpf(1.0f + __expf(-x)); }
__device__ __forceinline__ float wave_sum(float v) {
    v += xor_lt32<1>(v); v += xor_lt32<2>(v); v += xor_lt32<4>(v); v += xor_lt32<8>(v); v += xor_lt32<16>(v);
    return sum_halves(v);
}
__device__ __forceinline__ int crow(int r, int hi) { return (r & 3) + 8 * (r >> 2) + 4 * hi; }

#define XB_TMO      128
#define XB_XCNT(j)  (256  + 64 * (j))
#define XB_XSUB(j)  (1280 + 64 * (j))
#define XB_XGEN(j)  (2304 + 64 * (j))
#define XB_TOP      3328
#define XB_TOPGEN   3392
#define XCD_BAR_WORDS 3456
#define XB_SPIN_CAP (1u << 20)
__device__ __forceinline__ unsigned xb_ld(unsigned* p)              { return __hip_atomic_load(p, __ATOMIC_RELAXED, __HIP_MEMORY_SCOPE_AGENT); }
__device__ __forceinline__ unsigned xb_add(unsigned* p, unsigned v) { return __hip_atomic_fetch_add(p, v, __ATOMIC_RELAXED, __HIP_MEMORY_SCOPE_AGENT); }
__device__ __forceinline__ unsigned xb_xcc_id() { return (unsigned)__builtin_amdgcn_s_getreg((3 << 11) | 20) & 0xFu; }
#define XB_SPIN(cond, bar) do { unsigned _sp = 0; while (cond) { __builtin_amdgcn_s_sleep(1); \
    if ((++_sp & 255u) == 0u) { if (xb_ld(&(bar)[XB_TMO])) break; if (_sp > XB_SPIN_CAP) { atomicAdd(&(bar)[XB_TMO], 1u); break; } } } } while (0)
struct XcdBarrier { unsigned* bar; unsigned x; volatile LAS unsigned* st; };
__device__ __forceinline__ XcdBarrier xcd_barrier_post(unsigned* bar, volatile LAS unsigned* st) {
    XcdBarrier b; b.bar = bar; b.x = xb_xcc_id(); b.st = st;
    if (otid() == 0) (void)xb_add(&bar[XB_XCNT(b.x)], 1u);
    return b;
}
__device__ __forceinline__ void xcd_barrier_complete(unsigned* bar, unsigned x, unsigned& nloc, unsigned& nx) {
    const unsigned G = gridDim.x * gridDim.y * gridDim.z;
    unsigned sum, cnt, mine, sp = 0u;
    for (;;) {
        sum = 0u; cnt = 0u; mine = 0u;
#pragma unroll 1
        for (unsigned j = 0; j < 16; ++j) { const unsigned c = xb_ld(&bar[XB_XCNT(j)]); sum += c; cnt += (c > 0u) ? 1u : 0u; mine = (j == x) ? c : mine; }
        if (sum == G) break;
        __builtin_amdgcn_s_sleep(1);
        if ((++sp & 255u) == 0u) { if (xb_ld(&bar[XB_TMO])) break; if (sp > XB_SPIN_CAP) { atomicAdd(&bar[XB_TMO], 1u); break; } }
    }
    nloc = mine > 0u ? mine : 1u; nx = cnt > 0u ? cnt : 1u;
}
__device__ __attribute__((noinline)) void xcd_barrier_impl(unsigned* bbar, unsigned bx, volatile LAS unsigned* bst, bool leader) {
    XcdBarrier b; b.bar = bbar; b.x = bx; b.st = bst;
    asm volatile("s_waitcnt vmcnt(0)" ::: "memory");
    __syncthreads();
    if (leader) {
        unsigned* bar = b.bar;
        __builtin_amdgcn_s_waitcnt(0);
        unsigned nloc = b.st[0], nx = b.st[1];
        if (nloc == 0u) { xcd_barrier_complete(bar, b.x, nloc, nx); b.st[0] = nloc; b.st[1] = nx; }
        const unsigned old = xb_add(&bar[XB_XSUB(b.x)], 1u);
        const unsigned gen = old / nloc;
        if (old + 1u == (gen + 1u) * nloc) {
            __builtin_amdgcn_fence(__ATOMIC_RELEASE, "agent");
            asm volatile("s_waitcnt vmcnt(0)" ::: "memory");
            const unsigned og = xb_add(&bar[XB_TOP], 1u);
            const unsigned tg = og / nx;
            if (og + 1u == (tg + 1u) * nx) xb_add(&bar[XB_TOPGEN], 1u);
            else XB_SPIN(xb_ld(&bar[XB_TOPGEN]) == tg, bar);
            __builtin_amdgcn_fence(__ATOMIC_ACQUIRE, "agent");
            xb_add(&bar[XB_XGEN(b.x)], 1u);
            asm volatile("s_waitcnt vmcnt(0)" ::: "memory");
        } else {
            XB_SPIN(xb_ld(&bar[XB_XGEN(b.x)]) == gen, bar);
            __builtin_amdgcn_fence(__ATOMIC_ACQUIRE, "agent");
            asm volatile("s_waitcnt vmcnt(0)" ::: "memory");
        }
    }
    __syncthreads();
}

__device__ __forceinline__ void xcd_barrier(const XcdBarrier& b) { xcd_barrier_impl(b.bar, b.x, b.st, otid() == 0); }

struct Params {
    const float* in[33]; float* out; unsigned char* ws;
    float lam_init[2];
    unsigned char bucket[128];
};
__device__ __forceinline__ void transpose_item(const float* W, int N, int k0, int n0, bf16* WT, int KT, int orow0, const float* gain, float scale, LAS float* scr, int lane) {
    float wv[32];
#pragma unroll
    for (int i = 0; i < 32; ++i) wv[i] = ((const GAS float*)W)[(size_t)(k0 + 2 * i + (lane >> 5)) * N + n0 + (lane & 31)];
#pragma unroll
    for (int i = 0; i < 32; ++i) scr[(2 * i + (lane >> 5)) * 33 + (lane & 31)] = wv[i];
    LDS_WAIT(); asm volatile("" ::: "memory");
    const int c = lane & 7;
    float g[8];
#pragma unroll
    for (int j = 0; j < 8; ++j) g[j] = (gain ? ((const GAS float*)gain)[k0 + 8 * c + j] : 1.0f) * scale;
#pragma unroll
    for (int j = 0; j < 4; ++j) { const int n = (lane >> 3) + 8 * j; const LAS float* s = scr + (8 * c) * 33 + n;
        v4u o; o.x = pk2(s[0 * 33] * g[0], s[1 * 33] * g[1]); o.y = pk2(s[2 * 33] * g[2], s[3 * 33] * g[3]); o.z = pk2(s[4 * 33] * g[4], s[5 * 33] * g[5]); o.w = pk2(s[6 * 33] * g[6], s[7 * 33] * g[7]);
        *(GAS v4u*)(WT + (size_t)(orow0 + n) * KT + k0 + 8 * c) = o; }
    LDS_WAIT(); asm volatile("" ::: "memory");
}
__device__ __forceinline__ void convert_matrix(const float* W, int K, int N, bf16* WT, const float* gain, float scale_lo, int n_lo, int gw, int NGW, LAS float* scr, int lane, int glu_lo = 0) {
    const int nblk = N / 32, nit = (K / 64) * nblk;
    for (int it = gw; it < nit; it += NGW) { const int kb = it / nblk, nb = it % nblk; int orow0 = 32 * nb;
        if (glu_lo > 0 && orow0 >= glu_lo) { const int s_ = orow0 - glu_lo, c_ = s_ & 511; orow0 = glu_lo + (c_ >> 7) * 256 + (s_ >> 9) * 128 + (c_ & 127); }
        transpose_item(W, N, 64 * kb, 32 * nb, WT, K, orow0, gain, (32 * nb < n_lo) ? scale_lo : 1.0f, scr, lane); }
}
__device__ __forceinline__ void convert_moe(const float* w1, const float* w3, const float* w2, bf16* w13t, bf16* w2t, const float* gain, int gw, int NGW, LAS float* scr, int lane) {
    for (int it = gw; it < 3 * 4096; it += NGW) {
        const int which = it >> 12, r = it & 4095, e = r >> 8, q = r & 255;
        if (which < 2) { const int kb = q >> 4, nb = q & 15, n0 = 32 * nb;
            const float* W = (which == 0 ? w1 : w3) + (size_t)e * 1024 * 512;
            const int orow0 = e * 1024 + (n0 >> 7) * 256 + which * 128 + (n0 & 127);
            transpose_item(W, 512, 64 * kb, n0, w13t, 1024, orow0, gain, 1.0f, scr, lane);
        } else { const int kb = q >> 5, nb = q & 31;
            transpose_item(w2 + (size_t)e * 512 * 1024, 1024, 64 * kb, 32 * nb, w2t, 512, e * 1024 + 32 * nb, nullptr, 1.0f, scr, lane); }
    }
}
__device__ __forceinline__ void rows4_to_xb(const float* x, bf16* xbp, float* ss, int m0, int mstride, int lane) {
    f32x4 v[4][4];
#pragma unroll
    for (int q = 0; q < 4; ++q) { const GAS f32x4* xr = (const GAS f32x4*)(x + (size_t)(m0 + q * mstride) * 1024) + lane;
#pragma unroll
        for (int j = 0; j < 4; ++j) v[q][j] = xr[64 * j]; }
#pragma unroll
    for (int q = 0; q < 4; ++q) { float s = 0.f;
#pragma unroll
        for (int j = 0; j < 4; ++j) s += (v[q][j].x * v[q][j].x + v[q][j].y * v[q][j].y) + (v[q][j].z * v[q][j].z + v[q][j].w * v[q][j].w);
        s = wave_sum(s);
        GAS unsigned long long* o8 = (GAS unsigned long long*)(xbp + (size_t)(m0 + q * mstride) * 1024) + lane;
#pragma unroll
        for (int j = 0; j < 4; ++j) o8[64 * j] = (unsigned long long)pk2(v[q][j].x, v[q][j].y) | ((unsigned long long)pk2(v[q][j].z, v[q][j].w) << 32);
        if (lane < 16) ss[(size_t)(m0 + q * mstride) * 16 + lane] = (lane == 0) ? s : 0.f; }
}
__device__ __forceinline__ void row_norm_bf16(const float* xrow, const float* g, bf16* orow, int lane) {
    const GAS f32x4* xr = (const GAS f32x4*)xrow + lane; const GAS f32x4* gr = (const GAS f32x4*)g + lane;
    f32x4 v[4]; float s = 0.f;
#pragma unroll
    for (int j = 0; j < 4; ++j) { v[j] = xr[64 * j]; s += (v[j].x * v[j].x + v[j].y * v[j].y) + (v[j].z * v[j].z + v[j].w * v[j].w); }
    const float rr = __builtin_amdgcn_rsqf(wave_sum(s) * (1.0f / 1024.0f) + EPS);
    GAS unsigned long long* o8 = (GAS unsigned long long*)orow + lane;
#pragma unroll
    for (int j = 0; j < 4; ++j) { const f32x4 gg = gr[64 * j]; o8[64 * j] = (unsigned long long)pk2(v[j].x * rr * gg.x, v[j].y * rr * gg.y) | ((unsigned long long)pk2(v[j].z * rr * gg.z, v[j].w * rr * gg.w) << 32); }
}
__device__ __forceinline__ void rows4_final(const bf16* xbp, float* out, const float* ss, const f32x4 (&gg)[4], int m0, int mstride, int lane) {
    v2u w[4][4]; float rr[4];
#pragma unroll
    for (int q = 0; q < 4; ++q) { const GAS v2u* xr = (const GAS v2u*)(xbp + (size_t)(m0 + q * mstride) * 1024) + lane;
#pragma unroll
        for (int j = 0; j < 4; ++j) w[q][j] = xr[64 * j];
        rr[q] = pg8::row_rs(ss, m0 + q * mstride); }
#pragma unroll
    for (int q = 0; q < 4; ++q) { GAS f32x4* orr = (GAS f32x4*)(out + (size_t)(m0 + q * mstride) * 1024) + lane;
#pragma unroll
        for (int j = 0; j < 4; ++j) { f32x4 v; v.x = bflo(w[q][j].x) * rr[q] * gg[j].x; v.y = bfhi(w[q][j].x) * rr[q] * gg[j].y; v.z = bflo(w[q][j].y) * rr[q] * gg[j].z; v.w = bfhi(w[q][j].y) * rr[q] * gg[j].w; orr[64 * j] = v; } }
}

constexpr int HA_FS = 132, HA_Q = 0, HA_KK = 33792, HA_BL = 67584, HA_TOT = 101376, HA_KI = 103424, HA_VI = 123904, HA_AM = 144384, HA_END = 153600, HA_BS = 72, HA_IS = 160;
typedef short v4i16_t __attribute__((ext_vector_type(4)));
__device__ __forceinline__ bf16x8 tr_frag(const LAS bf16* img, int s0, int x0, int lane) {
    const LAS bf16* p = img + (s0 + ((lane & 15) >> 2)) * HA_IS + x0 + 16 * ((lane >> 4) & 1) + 4 * (lane & 3);
    const s16x4 lo = __builtin_bit_cast(s16x4, __builtin_amdgcn_ds_read_tr16_b64_v4i16((LAS v4i16_t*)p));
    const s16x4 hh = __builtin_bit_cast(s16x4, __builtin_amdgcn_ds_read_tr16_b64_v4i16((LAS v4i16_t*)(p + 4 * HA_IS)));
    return __builtin_shufflevector(lo, hh, 0, 1, 2, 3, 4, 5, 6, 7);
}
constexpr int HA_TAB = HA_END;
__device__ __forceinline__ void hgrn_phaseA(LAS unsigned char* lds, int first, int G, bf16* proj, bf16* mix, float* dch, const float* hgrn_lb, int j_even) {
    const int tid = otid(), lane = tid & 63, wid = __builtin_amdgcn_readfirstlane(tid >> 6);
    LAS float* Q = (LAS float*)(lds + HA_Q); LAS float* KK = (LAS float*)(lds + HA_KK); LAS float* BL = (LAS float*)(lds + HA_BL); LAS float* TOT = (LAS float*)(lds + HA_TOT); LAS float* TAB = (LAS float*)(lds + HA_TAB);
    LAS bf16* KI = (LAS bf16*)(lds + HA_KI); LAS bf16* VI = (LAS bf16*)(lds + HA_VI); LAS bf16* AM = (LAS bf16*)(lds + HA_AM);
    const int row = tid >> 3, cg = tid & 7, k0 = cg * 16;
    v4u zq0, zq1, zf0, zf1, zi0, zi1;
#define HA_LOAD(uu) do { const int b_ = (uu) >> 8, h_ = ((uu) >> 6) & 3, c_ = (uu) & 63; const bf16* pr_ = proj + ((size_t)b_ * SEQ + c_ * 64 + row) * 3072 + h_ * 128 + k0; \
        zq0 = *(const GAS v4u*)(pr_); zq1 = *(const GAS v4u*)(pr_ + 8); zf0 = *(const GAS v4u*)(pr_ + 512); zf1 = *(const GAS v4u*)(pr_ + 520); zi0 = *(const GAS v4u*)(pr_ + 1024); zi1 = *(const GAS v4u*)(pr_ + 1032); } while (0)
    if (first < 4096) HA_LOAD(first);
    float lbv[16]; int hprev = -1;
#pragma unroll
    for (int e = 0; e < 16; ++e) lbv[e] = 0.f;
    for (int u = first; u < 4096; u += G) {
        const int b = u >> 8, h = (u >> 6) & 3, c = u & 63; const size_t t0 = (size_t)b * SEQ + c * 64;
        {
            const unsigned zq[8] = {zq0.x, zq0.y, zq0.z, zq0.w, zq1.x, zq1.y, zq1.z, zq1.w};
            const unsigned zf[8] = {zf0.x, zf0.y, zf0.z, zf0.w, zf1.x, zf1.y, zf1.z, zf1.w};
            *(LAS v4u*)(VI + row * HA_IS + k0) = zi0; *(LAS v4u*)(VI + row * HA_IS + k0 + 8) = zi1;
            if (h != hprev) { hprev = h;
                const GAS f32x4* l0 = (const GAS f32x4*)(hgrn_lb + h * 128 + k0); const GAS f32x4* l1 = (const GAS f32x4*)(hgrn_lb + 512 + h * 128 + k0);
#pragma unroll
                for (int q4 = 0; q4 < 4; ++q4) { const f32x4 a = l0[q4], bq = l1[q4];
#pragma unroll
                    for (int e = 0; e < 4; ++e) lbv[4 * q4 + e] = (j_even == 1) ? sigmoidf_(bq[e] - a[e]) : 0.f; } }
#pragma unroll
            for (int q4 = 0; q4 < 4; ++q4) { f32x4 qv, kv, lv;
#pragma unroll
                for (int e = 0; e < 4; ++e) { const int jj = 4 * q4 + e; const unsigned wq = zq[jj >> 1], wf = zf[jj >> 1];
                    const float q_ = (jj & 1) ? bfhi(wq) : bflo(wq), f_ = (jj & 1) ? bfhi(wf) : bflo(wf);
                    const float lb = lbv[jj];
                    const float f = lb + (1.0f - lb) * sigmoidf_(f_);
                    qv[e] = q_ * sigmoidf_(q_); kv[e] = 1.0f - f; lv[e] = __logf(fmaxf(f, 1e-30f)); }
                *(LAS f32x4*)(Q + row * HA_FS + k0 + 4 * q4) = qv; *(LAS f32x4*)(KK + row * HA_FS + k0 + 4 * q4) = kv; *(LAS f32x4*)(BL + row * HA_FS + k0 + 4 * q4) = lv; }
        }
        if (u + G < 4096) HA_LOAD(u + G);
        __syncthreads();
        { const int k = tid & 127, sub = tid >> 7; float run = 0.f;
#pragma unroll
          for (int j = 0; j < 16; ++j) { const int rw = 16 * sub + j; run += BL[rw * HA_FS + k]; BL[rw * HA_FS + k] = run; }
          TOT[sub * 128 + k] = run; }
        __syncthreads();
        {
#pragma unroll
            for (int q4 = 0; q4 < 4; ++q4) { const f32x4 bl = *(const LAS f32x4*)(BL + row * HA_FS + k0 + 4 * q4); f32x4 qv = *(const LAS f32x4*)(Q + row * HA_FS + k0 + 4 * q4), kv = *(const LAS f32x4*)(KK + row * HA_FS + k0 + 4 * q4);
#pragma unroll
                for (int e = 0; e < 4; ++e) { qv[e] *= __expf(bl[e]); kv[e] *= __expf(fminf(-bl[e], 80.0f)); }
                *(LAS f32x4*)(Q + row * HA_FS + k0 + 4 * q4) = qv; *(LAS f32x4*)(KK + row * HA_FS + k0 + 4 * q4) = kv; }
            for (int e = tid; e < 1280; e += NTHR) { const int w = e >> 7, k = e & 127; const float t0_ = TOT[k], t1_ = TOT[128 + k], t2_ = TOT[256 + k], t3_ = TOT[384 + k];
                const float x = (w == 0) ? t0_ : (w == 1) ? t1_ : (w == 2) ? t2_ : (w == 3) ? t3_ : (w == 4) ? t1_ + t2_ : (w == 5) ? t0_ + t1_ : (w == 6) ? (t0_ + t1_) + t2_ : (w == 7) ? (t0_ + t1_) + (t2_ + t3_) : (w == 8) ? t1_ + (t2_ + t3_) : t2_ + t3_;
                TAB[e] = __expf(x); }
        }
        __syncthreads();
        for (int task = wid; task < 10; task += 8) {
            int it, is; int ga = -1;
            if (task < 4) { it = task; is = task; }
            else { const int pq = task - 4; it = (pq == 0) ? 1 : (pq <= 2 ? 2 : 3); is = (pq == 0) ? 0 : (pq == 1 ? 0 : (pq == 2 ? 1 : pq - 3));
                   ga = (it - is == 1) ? -1 : (it == 2 ? 1 : (is == 1 ? 2 : 4)); }
            const int r = lane & 15, quad = lane >> 4; f32x4 acc = {0.f, 0.f, 0.f, 0.f};
#pragma unroll
            for (int ks = 0; ks < 4; ++ks) { unsigned pa[4], pb[4]; const int kb = 32 * ks + 8 * quad;
#pragma unroll
                for (int q4 = 0; q4 < 2; ++q4) { f32x4 qv = *(const LAS f32x4*)(Q + (16 * it + r) * HA_FS + kb + 4 * q4), kv = *(const LAS f32x4*)(KK + (16 * is + r) * HA_FS + kb + 4 * q4);
                    if (task >= 4) { kv *= *(const LAS f32x4*)(TAB + is * 128 + kb + 4 * q4); if (ga >= 0) qv *= *(const LAS f32x4*)(TAB + ga * 128 + kb + 4 * q4); }
                    pa[2 * q4] = pk2(qv[0], qv[1]); pa[2 * q4 + 1] = pk2(qv[2], qv[3]); pb[2 * q4] = pk2(kv[0], kv[1]); pb[2 * q4 + 1] = pk2(kv[2], kv[3]); }
                const v4u va = {pa[0], pa[1], pa[2], pa[3]}, vb = {pb[0], pb[1], pb[2], pb[3]};
                acc = MFMA16(__builtin_bit_cast(bf16x8, va), __builtin_bit_cast(bf16x8, vb), acc); }
#pragma unroll
            for (int j = 0; j < 4; ++j) { const int tl = 4 * quad + j;
                if (task < 4) AM[(16 * it + tl) * HA_BS + 16 * is + r] = (r <= tl) ? (bf16)f2bf(acc[j]) : (bf16)0;
                else { AM[(16 * it + tl) * HA_BS + 16 * is + r] = (bf16)f2bf(acc[j]); AM[(16 * is + tl) * HA_BS + 16 * it + r] = (bf16)0; } }
        }
        {
            const int sc = row >> 4; unsigned qo[8], ko[8];
#pragma unroll
            for (int q4 = 0; q4 < 4; ++q4) { f32x4 qv = *(const LAS f32x4*)(Q + row * HA_FS + k0 + 4 * q4), kv = *(const LAS f32x4*)(KK + row * HA_FS + k0 + 4 * q4);
                if (sc > 0) qv *= *(const LAS f32x4*)(TAB + ((sc == 1) ? 0 : (sc == 2) ? 5 : 6) * 128 + k0 + 4 * q4);
                kv *= *(const LAS f32x4*)(TAB + ((sc == 0) ? 7 : (sc == 1) ? 8 : (sc == 2) ? 9 : 3) * 128 + k0 + 4 * q4);
                qo[2 * q4] = pk2(qv[0], qv[1]); qo[2 * q4 + 1] = pk2(qv[2], qv[3]); ko[2 * q4] = pk2(kv[0], kv[1]); ko[2 * q4 + 1] = pk2(kv[2], kv[3]); }
            bf16* pq = proj + (t0 + row) * 3072 + h * 128 + k0;
            *(GAS v4u*)(pq) = (v4u){qo[0], qo[1], qo[2], qo[3]}; *(GAS v4u*)(pq + 8) = (v4u){qo[4], qo[5], qo[6], qo[7]};
            *(LAS v4u*)(KI + row * HA_IS + k0) = (v4u){ko[0], ko[1], ko[2], ko[3]}; *(LAS v4u*)(KI + row * HA_IS + k0 + 8) = (v4u){ko[4], ko[5], ko[6], ko[7]};
            if (tid < 128) dch[(size_t)u * 128 + tid] = TAB[7 * 128 + tid];
        }
        __syncthreads();
        { const int r = lane & 31, hi = lane >> 5, tm = wid >> 2, tn = wid & 3; f32x16 acc = {};
#pragma unroll
          for (int ks = 0; ks < 4; ++ks) { const bf16x8 a = tr_frag(VI, 16 * ks + 8 * hi, 32 * tn, lane); const bf16x8 bb = *(const LAS bf16x8*)(AM + (32 * tm + r) * HA_BS + 16 * ks + 8 * hi); acc = MFMA32(a, bb, acc); }
          bf16* po = mix + (t0 + 32 * tm + r) * 1024 + h * 128 + 32 * tn + 4 * hi;
#pragma unroll
          for (int g4 = 0; g4 < 4; ++g4) { v2u w; w.x = pk2(acc[4 * g4], acc[4 * g4 + 1]); w.y = pk2(acc[4 * g4 + 2], acc[4 * g4 + 3]); *(GAS v2u*)(po + 8 * g4) = w; }
        }
        { const int r = lane & 31, hi = lane >> 5, tk = wid >> 1;
#pragma unroll
          for (int tv2 = 0; tv2 < 2; ++tv2) { const int tv = 2 * (wid & 1) + tv2; f32x16 acc = {};
#pragma unroll
              for (int ks = 0; ks < 4; ++ks) { const bf16x8 a = tr_frag(KI, 16 * ks + 8 * hi, 32 * tk, lane); const bf16x8 bb = tr_frag(VI, 16 * ks + 8 * hi, 32 * tv, lane); acc = MFMA32(a, bb, acc); }
              const int v = 32 * tv + r;
              bf16* pu = proj + (t0 + (v & 63)) * 3072 + (v < 64 ? 512 : 1024) + h * 128 + 32 * tk + 4 * hi;
#pragma unroll
              for (int g4 = 0; g4 < 4; ++g4) { v2u w; w.x = pk2(acc[4 * g4], acc[4 * g4 + 1]); w.y = pk2(acc[4 * g4 + 2], acc[4 * g4 + 3]); *(GAS v2u*)(pu + 8 * g4) = w; } }
        }
        __syncthreads();
    }
#undef HA_LOAD
}

__device__ __forceinline__ void hgrn_phaseB(bf16* proj, const float* dch, int G) {
    const int tid = otid();
    for (int rid = blockIdx.x * 32 + (tid >> 4); rid < 8192; rid += G * 32) {
        const int bh = rid >> 7, v = rid & 127, b = bh >> 2, h = bh & 3, ks = (tid & 15) * 8;
        bf16* base = proj + ((size_t)b * SEQ + (v & 63)) * 3072 + (v < 64 ? 512 : 1024) + h * 128 + ks;
        const float* dbase = dch + (size_t)bh * 64 * 128 + ks;
        float st[8];
#pragma unroll
        for (int j = 0; j < 8; ++j) st[j] = 0.f;
        v4u ub[8]; f32x4 d0[8], d1[8];
#pragma unroll
        for (int j = 0; j < 8; ++j) { ub[j] = *(const GAS v4u*)(base + (size_t)j * 64 * 3072); d0[j] = *(const GAS f32x4*)(dbase + j * 128); d1[j] = *(const GAS f32x4*)(dbase + j * 128 + 4); }
        for (int c0 = 0; c0 < 64; c0 += 8) {
#pragma unroll
            for (int j = 0; j < 8; ++j) { const int c = c0 + j; bf16* p = base + (size_t)c * 64 * 3072;
                const v4u uu = ub[j]; const f32x4 da = d0[j], db = d1[j];
                v4u so; so.x = pk2(st[0], st[1]); so.y = pk2(st[2], st[3]); so.z = pk2(st[4], st[5]); so.w = pk2(st[6], st[7]);
                *(GAS v4u*)p = so;
                st[0] = da[0] * st[0] + bflo(uu.x); st[1] = da[1] * st[1] + bfhi(uu.x); st[2] = da[2] * st[2] + bflo(uu.y); st[3] = da[3] * st[3] + bfhi(uu.y);
                st[4] = db[0] * st[4] + bflo(uu.z); st[5] = db[1] * st[5] + bfhi(uu.z); st[6] = db[2] * st[6] + bflo(uu.w); st[7] = db[3] * st[7] + bfhi(uu.w);
                if (c + 8 < 64) { ub[j] = *(const GAS v4u*)(base + (size_t)(c + 8) * 64 * 3072); d0[j] = *(const GAS f32x4*)(dbase + (c + 8) * 128); d1[j] = *(const GAS f32x4*)(dbase + (c + 8) * 128 + 4); } }
        }
    }
}

__device__ __forceinline__ void hgrn_phaseC(LAS unsigned char* lds, int first, int G, const bf16* proj, bf16* mix, const float* gnorm) {
    const int tid = otid(), lane = tid & 63, wid = __builtin_amdgcn_readfirstlane(tid >> 6);
    LAS float* OF = (LAS float*)lds;
    constexpr int CI = 136; LAS bf16* SI = (LAS bf16*)(lds + 64 * 132 * 4); LAS bf16* QI = SI + 128 * CI;
    const int r = lane & 31, hi = lane >> 5, tm = wid >> 2, tn = wid & 3;
    const int row = tid >> 3, cg = tid & 7, v0 = cg * 16;
    const int crow_ = tid >> 4, ckc = tid & 15;
    v4u sc[4], qc[2]; v2u ol[4]; v4u g0, g1;
#define HC_LOAD(uu) do { const int b_ = (uu) >> 8, h_ = ((uu) >> 6) & 3, c_ = (uu) & 63; const size_t t0_ = (size_t)b_ * SEQ + c_ * 64; \
        _Pragma("unroll") for (int j = 0; j < 4; ++j) { const int v_ = crow_ + 32 * j; sc[j] = *(const GAS v4u*)(proj + (t0_ + (v_ & 63)) * 3072 + (v_ < 64 ? 512 : 1024) + h_ * 128 + 8 * ckc); } \
        _Pragma("unroll") for (int j = 0; j < 2; ++j) qc[j] = *(const GAS v4u*)(proj + (t0_ + crow_ + 32 * j) * 3072 + h_ * 128 + 8 * ckc); \
        const bf16* pl_ = mix + (t0_ + 32 * tm + r) * 1024 + h_ * 128 + 32 * tn + 4 * hi; _Pragma("unroll") for (int g4 = 0; g4 < 4; ++g4) ol[g4] = *(const GAS v2u*)(pl_ + 8 * g4); \
        const bf16* pg_ = proj + (t0_ + row) * 3072 + 1536 + h_ * 128 + v0; g0 = *(const GAS v4u*)pg_; g1 = *(const GAS v4u*)(pg_ + 8); } while (0)
    if (first < 4096) HC_LOAD(first);
    float gn[16];
#pragma unroll
    for (int j = 0; j < 16; ++j) gn[j] = gnorm[v0 + j];
    for (int u = first; u < 4096; u += G) {
        const int b = u >> 8, h = (u >> 6) & 3, c = u & 63; const size_t t0 = (size_t)b * SEQ + c * 64;
#pragma unroll
        for (int j = 0; j < 4; ++j) *(LAS v4u*)(SI + (crow_ + 32 * j) * CI + 8 * ckc) = sc[j];
#pragma unroll
        for (int j = 0; j < 2; ++j) *(LAS v4u*)(QI + (crow_ + 32 * j) * CI + 8 * ckc) = qc[j];
        __syncthreads();
        { f32x16 acc = {}; bf16x8 af[8], bfr[8];
#pragma unroll
          for (int ks = 0; ks < 8; ++ks) { af[ks] = *(const LAS bf16x8*)(SI + (32 * tn + r) * CI + 16 * ks + 8 * hi); bfr[ks] = *(const LAS bf16x8*)(QI + (32 * tm + r) * CI + 16 * ks + 8 * hi); }
#pragma unroll
          for (int ks = 0; ks < 8; ++ks) acc = MFMA32(af[ks], bfr[ks], acc);
#pragma unroll
          for (int g4 = 0; g4 < 4; ++g4) { const v2u w = ol[g4];
              f32x4 o; o[0] = acc[4 * g4] + bflo(w.x); o[1] = acc[4 * g4 + 1] + bfhi(w.x); o[2] = acc[4 * g4 + 2] + bflo(w.y); o[3] = acc[4 * g4 + 3] + bfhi(w.y);
              *(LAS f32x4*)(OF + (32 * tm + r) * 132 + 32 * tn + 8 * g4 + 4 * hi) = o; }
        }
        const unsigned zg[8] = {g0.x, g0.y, g0.z, g0.w, g1.x, g1.y, g1.z, g1.w};
        if (u + G < 4096) HC_LOAD(u + G);
        __syncthreads();
        { float o[16]; float s2 = 0.f;
#pragma unroll
          for (int j = 0; j < 4; ++j) { const f32x4 x = *(const LAS f32x4*)(OF + row * 132 + v0 + 4 * j); o[4 * j] = x[0]; o[4 * j + 1] = x[1]; o[4 * j + 2] = x[2]; o[4 * j + 3] = x[3]; s2 += (x[0] * x[0] + x[1] * x[1]) + (x[2] * x[2] + x[3] * x[3]); }
          s2 += xor_lt32<1>(s2); s2 += xor_lt32<2>(s2); s2 += xor_lt32<4>(s2);
          const float rr = __builtin_amdgcn_rsqf(s2 * (1.0f / 128.0f) + EPS);
          unsigned w[8];
#pragma unroll
          for (int p = 0; p < 8; ++p) { const float a = o[2 * p] * rr * gn[2 * p] * sigmoidf_(bflo(zg[p])); const float bq = o[2 * p + 1] * rr * gn[2 * p + 1] * sigmoidf_(bfhi(zg[p])); w[p] = pk2(a, bq); }
          bf16* po = mix + (t0 + row) * 1024 + h * 128 + v0;
          *(GAS v4u*)po = (v4u){w[0], w[1], w[2], w[3]}; *(GAS v4u*)(po + 8) = (v4u){w[4], w[5], w[6], w[7]};
        }
        __syncthreads();
    }
#undef HC_LOAD
}

constexpr int CV_R = 64;
__device__ __forceinline__ void conv_unit(LAS unsigned char* lds, int u, const bf16* proj, bf16* mix, const float* dw, const float* db, const float* lng, const float* lnb) {
    const int tid = otid(), lane = tid & 63, wid = __builtin_amdgcn_readfirstlane(tid >> 6);
    constexpr int UPS = SEQ / CV_R;
    const int b = u / UPS, tb = u % UPS, ch = tid;
    LAS float* CB = (LAS float*)lds;
    LAS float* STAT = (LAS float*)(lds + CV_R * 516 * 4);
    float uu[CV_R + 30];
#pragma unroll
    for (int j = 0; j < CV_R + 30; ++j) { const int tt = tb * CV_R - 30 + j; float val = 0.f;
        { const int tc = tt < 0 ? 0 : tt; const GAS bf16* p = (const GAS bf16*)(proj + ((size_t)b * SEQ + tc) * 3072 + 2048 + ch); val = bf2f(p[0]); }
        uu[j] = (tt >= 0) ? val : 0.f; }
    float w[31];
#pragma unroll
    for (int j = 0; j < 31; ++j) w[j] = ((const GAS float*)dw)[j * 512 + ch];
    const float bias = db[ch];
    float cv[CV_R];
#pragma unroll
    for (int i = 0; i < CV_R; ++i) { float a = bias;
#pragma unroll
        for (int j = 0; j < 31; ++j) a += w[j] * uu[i + j];
        cv[i] = a; CB[i * 516 + ch] = a; }
    __syncthreads();
#pragma unroll
    for (int rr = 0; rr < CV_R / 8; ++rr) { const int row = wid * (CV_R / 8) + rr; float s = 0.f; float x[8];
#pragma unroll
        for (int j = 0; j < 8; ++j) { x[j] = CB[row * 516 + lane + 64 * j]; s += x[j]; }
        const float mean = wave_sum(s) * (1.0f / 512.0f); float q = 0.f;
#pragma unroll
        for (int j = 0; j < 8; ++j) { const float d = x[j] - mean; q += d * d; }
        const float var = wave_sum(q) * (1.0f / 512.0f);
        if (lane == 0) { STAT[row * 2] = mean; STAT[row * 2 + 1] = __builtin_amdgcn_rsqf(var + EPS); } }
    __syncthreads();
    const float g = lng[ch], bb = lnb[ch];
#pragma unroll
    for (int i = 0; i < CV_R; ++i) { const float y = (cv[i] - STAT[i * 2]) * STAT[i * 2 + 1] * g + bb; ((GAS bf16*)mix)[((size_t)b * SEQ + tb * CV_R + i) * 1024 + 512 + ch] = (bf16)f2bf(y * sigmoidf_(y)); }
    __syncthreads();
}

__device__ __forceinline__ void router_tile256(LAS unsigned char* lds, int tile, const bf16* xb, const float* ss, const bf16* wr, const float* b_grp, const float* b_exp,
                                               unsigned* route, int* lists, unsigned* gcnt  , bool commit = true) {
    const int tid = otid(), lane = tid & 63, wid = __builtin_amdgcn_readfirstlane(tid >> 6);
    LAS float* LG = (LAS float*)lds + wid * (32 * 33);
    LAS int* LC = (LAS int*)(lds + 8 * 32 * 33 * 4);
    if (tid < 64) LC[tid] = 0;
    __syncthreads();
    const int r = lane & 31, hi = lane >> 5; const int tok0 = tile * 256 + wid * 32;
    f32x16 acc = {};
    const bf16* pa = wr + (size_t)r * 1024 + 8 * hi;
    const bf16* pb = xb + (size_t)(tok0 + r) * 1024 + 8 * hi;
    for (int k0 = 0; k0 < 64; k0 += 16) { bf16x8 av[16], bv[16];
#pragma unroll
        for (int ks = 0; ks < 16; ++ks) { av[ks] = *(const GAS bf16x8*)(pa + 16 * (k0 + ks)); bv[ks] = *(const GAS bf16x8*)(pb + 16 * (k0 + ks)); }
#pragma unroll
        for (int ks = 0; ks < 16; ++ks) acc = MFMA32(av[ks], bv[ks], acc); }
    const float rr = pg8::row_rs(ss, tok0 + r);
#pragma unroll
    for (int i = 0; i < 16; ++i) LG[r * 33 + crow(i, hi)] = acc[i] * rr;
    LDS_WAIT(); asm volatile("" ::: "memory");
    int ea = 0, eb = 0, pa_ = 0, pb_ = 0; float wa = 0.f, wb = 0.f; const int tok = tok0 + r;
    if (hi == 0) {
        float gl[4];
#pragma unroll
        for (int j = 0; j < 4; ++j) gl[j] = LG[r * 33 + j] + b_grp[j];
        int gs = 0; float gm = gl[0];
#pragma unroll
        for (int j = 1; j < 4; ++j) if (gl[j] > gm) { gm = gl[j]; gs = j; }
        float den = 0.f;
#pragma unroll
        for (int j = 0; j < 4; ++j) den += __expf(gl[j] - gm);
        const float gw = __builtin_amdgcn_rcpf(den);
        float el[4];
#pragma unroll
        for (int j = 0; j < 4; ++j) el[j] = LG[r * 33 + 4 + gs * 4 + j] + b_exp[gs * 4 + j];
        int i1 = 0; float v1 = el[0];
#pragma unroll
        for (int j = 1; j < 4; ++j) if (el[j] > v1) { v1 = el[j]; i1 = j; }
        int i2 = -1; float v2 = 0.f;
#pragma unroll
        for (int j = 0; j < 4; ++j) if (j != i1 && (i2 < 0 || el[j] > v2)) { v2 = el[j]; i2 = j; }
        const float e2 = __expf(v2 - v1); { const float ri = __builtin_amdgcn_rcpf(1.0f + e2); wa = gw * ri; wb = gw * e2 * ri; }
        const int plo = i1 < i2 ? i1 : i2, phi = i1 < i2 ? i2 : i1;
        ea = gs * 6 + ((plo * (7 - plo)) >> 1) + (phi - plo - 1); eb = 0;
        const float wlo = (i1 < i2) ? wa : wb, whi = (i1 < i2) ? wb : wa;
        if (commit) pa_ = __hip_atomic_fetch_add(&LC[ea], 1, __ATOMIC_RELAXED, __HIP_MEMORY_SCOPE_WORKGROUP);
        *(GAS v4u*)(route + (size_t)tok * 4) = (v4u){(unsigned)((gs * 4 + plo) | ((gs * 4 + phi) << 8)), pk2(rr, rr * wlo), pk2(rr, rr * whi), __builtin_bit_cast(unsigned, rr)};
    }
    __syncthreads();
    if (tid < 32 && commit) LC[32 + tid] = (int)__hip_atomic_fetch_add(gcnt + 32 * tid, (unsigned)LC[tid], RLX_AGENT);
    __syncthreads();
    if (hi == 0 && commit) lists[(size_t)ea * 65536 + LC[32 + ea] + pa_] = tok;
    __syncthreads();
}
typedef short v4i16_att_t __attribute__((ext_vector_type(4)));
constexpr int ATT_TPS = 1;
template <int KW> struct AttnLdsR {
    static constexpr int KSTR = KW + 8, KBYTES = 64 * KSTR * 2, VBYTES = 64 * 256;
    static constexpr int K0 = 0, V0 = 2 * ATT_TPS * KBYTES, LUT = V0 + 2 * ATT_TPS * VBYTES, END = LUT + 512;
};
template <int KW, int DK, bool CAUSAL, bool PREFETCH>
__device__ __forceinline__ void attn_block_reg(LAS unsigned char* lds, const bf16* Qw  , int qpitch,
                                           const bf16* Kg, int kpitch, const bf16* Vg, int vpitch, int ntiles, int kmapoff, int qpos0  ,
                                           f32x16 (&o)[4], float& m_run, float& l_run) {
    typedef AttnLdsR<KW> L;
    const int tid = otid(), lane = tid & 63, wid = __builtin_amdgcn_readfirstlane(tid >> 6), r = lane & 31, hi = lane >> 5;
    bf16x8 qf[DK / 16];
#pragma unroll
    for (int ks = 0; ks < DK / 16; ++ks) qf[ks] = *(const GAS bf16x8*)(Qw + (size_t)r * qpitch + 16 * ks + 8 * hi);
#pragma unroll
    for (int vt = 0; vt < 4; ++vt) o[vt] = (f32x16){};
    m_run = -1e30f; l_run = 0.f;
    constexpr int KCH = KW / 64;
    const int vkey = tid >> 4, vc = tid & 15;
    v4u kreg[ATT_TPS][KCH], vreg[ATT_TPS][2];
    const LAS float* lut = (const LAS float*)(lds + L::LUT);
    unsigned koff[KCH];
#pragma unroll
    for (int i_ = 0; i_ < KCH; ++i_) { const int c_ = tid + i_ * NTHR, key_ = c_ / (KW / 8), kc_ = c_ % (KW / 8); koff[i_] = (unsigned)(key_ * kpitch + 8 * kc_) * 2u; }
    const unsigned voff0 = (unsigned)(vkey * vpitch + 8 * vc) * 2u, voff1 = voff0 + (unsigned)(32 * vpitch) * 2u;
    const int vst0 = ((vkey >> 3) * 4 + (vc >> 2)) * 512 + (vkey & 7) * 64 + (vc & 3) * 16;
    const int vbase = (4 * hi + ((lane & 15) >> 2)) * 64 + 32 * ((lane >> 4) & 1) + 8 * (lane & 3);
#define ATT_LOADK(t, sl) do { const char* kt_ = (const char*)Kg + (size_t)(t) * 64 * kpitch * 2; _Pragma("unroll") for (int i_ = 0; i_ < KCH; ++i_) kreg[sl][i_] = *(const GAS v4u*)(kt_ + koff[i_]); } while (0)
#define ATT_LOADV(t, sl) do { const char* vt2_ = (const char*)Vg + (size_t)(t) * 64 * vpitch * 2; vreg[sl][0] = *(const GAS v4u*)(vt2_ + voff0); vreg[sl][1] = *(const GAS v4u*)(vt2_ + voff1); } while (0)
#define ATT_STORE(buf, sl) do { _Pragma("unroll") for (int i_ = 0; i_ < KCH; ++i_) { const int c_ = tid + i_ * NTHR, key_ = c_ / (KW / 8), kc_ = c_ % (KW / 8); \
        *(LAS v4u*)(lds + L::K0 + (buf) * L::KBYTES + (key_ * L::KSTR + 8 * kc_) * 2) = kreg[sl][i_]; } \
        { LAS unsigned char* vt_ = lds + L::V0 + (buf) * L::VBYTES + vst0; *(LAS v4u*)vt_ = vreg[sl][0]; *(LAS v4u*)(vt_ + 8192) = vreg[sl][1]; } } while (0)
#pragma unroll
    for (int j_ = 0; j_ < ATT_TPS; ++j_) { ATT_LOADK(j_, j_); ATT_LOADV(j_, j_); }
#pragma unroll
    for (int j_ = 0; j_ < ATT_TPS; ++j_) ATT_STORE(j_, j_);
    __syncthreads();
    const int nsteps = ntiles / ATT_TPS;
    for (int st = 0; st < nsteps; ++st) {
        const int cur = st & 1;
        if (st + 1 < nsteps) {
#pragma unroll
            for (int j_ = 0; j_ < ATT_TPS; ++j_) { ATT_LOADK(ATT_TPS * (st + 1) + j_, j_); ATT_LOADV(ATT_TPS * (st + 1) + j_, j_); } }
#pragma unroll
        for (int sub = 0; sub < ATT_TPS; ++sub) {
        const int t = ATT_TPS * st + sub, buf = cur * ATT_TPS + sub;
        const bool active = !CAUSAL || (64 * t <= qpos0 + 31);
        if (active) {
            const LAS unsigned char* kb = lds + L::K0 + buf * L::KBYTES;
            const LAS unsigned char* vb = lds + L::V0 + buf * L::VBYTES;
            f32x16 s0 = {}, s1 = {};
            {
                constexpr int NG = DK / 64;
                const LAS unsigned char* ka0 = kb + ((r) * L::KSTR + kmapoff + 8 * hi) * 2;
                const LAS unsigned char* ka1 = ka0 + 32 * L::KSTR * 2;
                bf16x8 kf[2][8];
#pragma unroll
                for (int j = 0; j < 4; ++j) { kf[0][2 * j] = *(const LAS bf16x8*)(ka0 + 32 * j); kf[0][2 * j + 1] = *(const LAS bf16x8*)(ka1 + 32 * j); }
#pragma unroll
                for (int g = 0; g < NG; ++g) {
                    if (g + 1 < NG) {
#pragma unroll
                        for (int j = 0; j < 4; ++j) { kf[(g + 1) & 1][2 * j] = *(const LAS bf16x8*)(ka0 + 128 * (g + 1) + 32 * j); kf[(g + 1) & 1][2 * j + 1] = *(const LAS bf16x8*)(ka1 + 128 * (g + 1) + 32 * j); }
                    }
#pragma unroll
                    for (int j = 0; j < 4; ++j) { s0 = MFMA32(kf[g & 1][2 * j], qf[4 * g + j], s0); s1 = MFMA32(kf[g & 1][2 * j + 1], qf[4 * g + j], s1); }
                    __builtin_amdgcn_sched_barrier(0);
                }
            }
            if (CAUSAL && (qpos0 - (64 * t + 63) < 128)) {
                const int qp = qpos0 + r;
#pragma unroll
                for (int i = 0; i < 16; ++i) { const int n0 = qp - (64 * t + crow(i, hi)), n1 = n0 - 32;
                    const float b0 = lut[min(max(n0, 0), 127)], b1 = lut[min(max(n1, 0), 127)];
                    s0[i] = (n0 < 0) ? -1e30f : s0[i] + b0;
                    s1[i] = (n1 < 0) ? -1e30f : s1[i] + b1; }
            }
            float mx = fmaxf(s0[0], s1[0]);
#pragma unroll
            for (int i = 1; i < 16; ++i) mx = __builtin_fmaxf(__builtin_fmaxf(mx, s0[i]), s1[i]);
            mx = fmaxf(mx, __shfl_xor(mx, 32));
            const float mnc = fmaxf(m_run, mx);
            const bool resc = __any(mnc > m_run + 8.0f);
            const float mn = resc ? mnc : m_run;
            float ps = 0.f;
#pragma unroll
            for (int i = 0; i < 16; ++i) { s0[i] = __builtin_amdgcn_exp2f(s0[i] - mn); s1[i] = __builtin_amdgcn_exp2f(s1[i] - mn); ps += s0[i] + s1[i]; }
            if (resc) {
                const float alpha = __builtin_amdgcn_exp2f(m_run - mn); l_run *= alpha;
#pragma unroll
                for (int vt = 0; vt < 4; ++vt)
#pragma unroll
                    for (int i = 0; i < 16; ++i) o[vt][i] *= alpha;
            }
            m_run = mn; l_run += ps;
            bf16x8 pf[4];
#pragma unroll
            for (int s = 0; s < 2; ++s) {
                v4u w0, w1;
                w0.x = pk2(s0[8 * s], s0[8 * s + 1]); w0.y = pk2(s0[8 * s + 2], s0[8 * s + 3]); w0.z = pk2(s0[8 * s + 4], s0[8 * s + 5]); w0.w = pk2(s0[8 * s + 6], s0[8 * s + 7]);
                w1.x = pk2(s1[8 * s], s1[8 * s + 1]); w1.y = pk2(s1[8 * s + 2], s1[8 * s + 3]); w1.z = pk2(s1[8 * s + 4], s1[8 * s + 5]); w1.w = pk2(s1[8 * s + 6], s1[8 * s + 7]);
                pf[s] = __builtin_bit_cast(bf16x8, w0); pf[2 + s] = __builtin_bit_cast(bf16x8, w1); }
            {
                const LAS unsigned char* vp0 = vb + vbase;
                s16x4 vl[2][4], vh[2][4];
#define ATT_TR(p_) __builtin_bit_cast(s16x4, __builtin_amdgcn_ds_read_tr16_b64_v4i16((LAS v4i16_t*)(p_)))
#pragma unroll
                for (int vt = 0; vt < 4; ++vt) { vl[0][vt] = ATT_TR(vp0 + vt * 512); vh[0][vt] = ATT_TR(vp0 + vt * 512 + 2048); }
#pragma unroll
                for (int f = 0; f < 4; ++f) {
                    if (f + 1 < 4) {
#pragma unroll
                        for (int vt = 0; vt < 4; ++vt) { vl[(f + 1) & 1][vt] = ATT_TR(vp0 + ((2 * (f + 1)) * 4 + vt) * 512); vh[(f + 1) & 1][vt] = ATT_TR(vp0 + ((2 * (f + 1)) * 4 + vt) * 512 + 2048); }
                    }
                    __builtin_amdgcn_s_setprio(1);
#pragma unroll
                    for (int vt = 0; vt < 4; ++vt) { const bf16x8 a = __builtin_shufflevector(vl[f & 1][vt], vh[f & 1][vt], 0, 1, 2, 3, 4, 5, 6, 7); o[vt] = MFMA32(a, pf[f], o[vt]); }
                    __builtin_amdgcn_s_setprio(0);
                    __builtin_amdgcn_sched_barrier(0);
                }
            }
        }
        }
        if (st + 1 < nsteps) {
#pragma unroll
            for (int j_ = 0; j_ < ATT_TPS; ++j_) ATT_STORE((cur ^ 1) * ATT_TPS + j_, j_); }
        __syncthreads();
    }
#undef ATT_LOADK
#undef ATT_LOADV
#undef ATT_STORE
#undef ATT_TR
}

__device__ __forceinline__ void diffattn_unit(LAS unsigned char* lds, int b, int h, int qb, const bf16* proj, bf16* mix, float lam, float lam_init, const float* subg,
                                              const float* rel_bias, const LAS unsigned char* bucket) {
    typedef AttnLdsR<128> L;
    const int tid = otid(), lane = tid & 63, wid = __builtin_amdgcn_readfirstlane(tid >> 6), r = lane & 31, hi = lane >> 5;
    const int map = wid >> 2, wq = wid & 3, q0 = qb * 128 + wq * 32;
    if (tid < 128) { const float c31 = rel_bias[31 * 8 + h]; ((LAS float*)(lds + L::LUT))[tid] = (rel_bias[bucket[tid] * 8 + h] - c31) * LOG2E; }
    const size_t rb = (size_t)b * SEQ;
    f32x16 o[4]; float m_run, l_run;
    attn_block_reg<128, 64, true, true>(lds, proj + (rb + q0) * 3072 + h * 128 + map * 64, 3072, proj + rb * 3072 + 1024 + h * 128, 3072, proj + rb * 3072 + 2048 + h * 128, 3072,
                              (qb * 128 + 128) / 64, map * 64, q0, o, m_run, l_run);
    const float lt = sum_halves(l_run), inv = __builtin_amdgcn_rcpf(lt);
    LAS float* XO = (LAS float*)lds;
    if (map == 1) {
#pragma unroll
        for (int vt = 0; vt < 4; ++vt)
#pragma unroll
            for (int g4 = 0; g4 < 4; ++g4) { f32x4 x; x[0] = o[vt][4 * g4] * inv; x[1] = o[vt][4 * g4 + 1] * inv; x[2] = o[vt][4 * g4 + 2] * inv; x[3] = o[vt][4 * g4 + 3] * inv;
                *(LAS f32x4*)(XO + (wq * 32 + r) * 132 + 32 * vt + 8 * g4 + 4 * hi) = x; }
    }
    __syncthreads();
    if (map == 0) {
        float ssq = 0.f;
#pragma unroll
        for (int vt = 0; vt < 4; ++vt)
#pragma unroll
            for (int g4 = 0; g4 < 4; ++g4) { const f32x4 x2 = *(const LAS f32x4*)(XO + (wq * 32 + r) * 132 + 32 * vt + 8 * g4 + 4 * hi);
#pragma unroll
                for (int j = 0; j < 4; ++j) { const float v = o[vt][4 * g4 + j] * inv - lam * x2[j]; o[vt][4 * g4 + j] = v; ssq += v * v; } }
        ssq = sum_halves(ssq);
        const float sc = (1.0f - lam_init) * __builtin_amdgcn_rsqf(ssq * (1.0f / 128.0f) + EPS);
        bf16* po = mix + (rb + q0 + r) * 1024 + h * 128 + 4 * hi; const GAS float* sgp = (const GAS float*)subg;
#pragma unroll
        for (int vt = 0; vt < 4; ++vt)
#pragma unroll
            for (int g4 = 0; g4 < 4; ++g4) { const int v0 = 32 * vt + 8 * g4 + 4 * hi;
                v2u w; w.x = pk2(o[vt][4 * g4] * sc * sgp[v0], o[vt][4 * g4 + 1] * sc * sgp[v0 + 1]); w.y = pk2(o[vt][4 * g4 + 2] * sc * sgp[v0 + 2], o[vt][4 * g4 + 3] * sc * sgp[v0 + 3]);
                *(GAS v2u*)(po + 32 * vt + 8 * g4) = w; }
    }
    __syncthreads();
}

__device__ __forceinline__ const float* pin_ptr(LAS unsigned char* lds, int k) {
    int ko = k * 8; asm volatile("" : "+v"(ko));
    const unsigned long long v = *(const LAS unsigned long long*)(lds + MISC_OFF + 512 + ko);
    const unsigned lo = __builtin_amdgcn_readfirstlane((unsigned)v), hi = __builtin_amdgcn_readfirstlane((unsigned)(v >> 32));
    return (const float*)(((unsigned long long)hi << 32) | lo);
}
__global__ void __launch_bounds__(NTHR, 2) mk_fwd(Params P) {
    static_assert(WAVE_TAB_OFF == MISC_OFF + 1024 && HA_TAB + 5120 <= MISC_OFF, "LDS map");
    if ((threadIdx.x & 63) == 0) ((LAS int*)((LAS unsigned char*)lds_raw + WAVE_TAB_OFF))[hw_slot()] = (int)(threadIdx.x >> 6);
    __syncthreads();
    unsigned ldsb = (unsigned)(size_t)(LAS unsigned char*)lds_raw;
    asm volatile("" : "+s"(ldsb));
#define lds ((LAS unsigned char*)ldsb)
    volatile LAS unsigned* MISC = (volatile LAS unsigned*)(lds + MISC_OFF);
    const int G = gridDim.x, blk = blockIdx.x;
#define FL const int tid = otid(), lane = tid & 63, wave = __builtin_amdgcn_readfirstlane(tid >> 6), gw = blk * NWAVES + wave, NGW = G * NWAVES; LAS float* scr = (LAS float*)(lds + wave * 16384); (void)lane; (void)gw; (void)NGW; (void)scr;
    { FL for (int u = tid; u < 256; u += NTHR) MISC[u] = 0u; }
    __syncthreads();
    { FL if (tid < 128) ((LAS unsigned char*)(lds + MISC_OFF + 784))[tid] = P.bucket[tid];
    if (tid < 33) ((LAS unsigned long long*)(lds + MISC_OFF + 512))[tid] = (unsigned long long)P.in[tid]; }
    __syncthreads();
#define PIN(k) pin_ptr(lds, (k))
    unsigned char* ws = P.ws;
    gu32* ctl = (gu32*)(ws + WS_CTL);
    XcdBarrier bar = xcd_barrier_post((unsigned*)(ctl + CW_BAR), MISC + 8);
#define GRID_BAR() do { xcd_barrier(bar); NEWPH(); } while (0)
    float* const xout = P.out;
    unsigned char* wsl = ws;
#define NEWPH() asm volatile("" : "+s"(wsl), "+s"(ldsb))
#define ssb ((float*)(wsl + WS_SS))
#define route ((unsigned*)(wsl + WS_ROUTE))
#define wr_all ((bf16*)(wsl + WS_WR))
#define dch ((float*)(wsl + WS_DCH))
#define lists ((int*)(wsl + WS_LISTS))
#define memn ((bf16*)(wsl + WS_MEMN))
#define kvb ((bf16*)(wsl + WS_KV))
#define xb ((bf16*)(wsl + WS_XB))
#define mix ((bf16*)(wsl + WS_MIX))
#define proj ((bf16*)(wsl + WS_PROJ))
#define xq ((bf16*)(wsl + WS_PROJ))
#define hid ((bf16*)(wsl + WS_HID))
#define w13t ((bf16*)(wsl + WS_WM))
#define w2t ((bf16*)(wsl + WS_WM + WM_W2))

    { FL
    for (int i = 0; i < 4; ++i) {
        const int j = i >> 1; unsigned char* wl = wsl + WS_W + (size_t)i * W_LAYER;
        if ((i & 1) == 0) {
            convert_matrix(PIN(9) + (size_t)j * 1024 * 3072, 1024, 3072, (bf16*)(wl + W_IN), PIN(6) + i * 1024, 1.0f, 0, gw, NGW, scr, lane, 2048);
            convert_matrix(PIN(10) + (size_t)j * 1024 * 1024, 1024, 1024, (bf16*)(wl + W_OUT), nullptr, 1.0f, 0, gw, NGW, scr, lane);
        } else {
            convert_matrix(PIN(16) + (size_t)j * 1024 * 3072, 1024, 3072, (bf16*)(wl + W_IN), PIN(6) + i * 1024, 0.125f * LOG2E, 1024, gw, NGW, scr, lane);
            convert_matrix(PIN(17) + (size_t)j * 1024 * 1024, 1024, 1024, (bf16*)(wl + W_OUT), nullptr, 1.0f, 0, gw, NGW, scr, lane);
        }
        for (int e = (gw * 64 + lane) * 8; e < 1024 * 1024; e += NGW * 64 * 8) { const int k = e >> 10, n = e & 1023; const float* src = PIN(23) + (size_t)i * 1024 * 1024 + e; const float gk = PIN(7)[i * 1024 + k] * (0.0625f * LOG2E);
            const f32x4 a = *(const GAS f32x4*)src, bq = *(const GAS f32x4*)(src + 4);
            *(GAS v4u*)((bf16*)(wl + W_XQ) + (size_t)(n >> 8) * 262144 + k * 256 + (n & 255)) = (v4u){pk2(a[0] * gk, a[1] * gk), pk2(a[2] * gk, a[3] * gk), pk2(bq[0] * gk, bq[1] * gk), pk2(bq[2] * gk, bq[3] * gk)}; }
        for (int hh = 0; hh < 4; ++hh) convert_matrix(PIN(25) + (size_t)i * 1024 * 1024 + (size_t)hh * 256 * 1024, 256, 1024, (bf16*)(wl + W_XO) + (size_t)hh * 262144, nullptr, 1.0f, 0, gw, NGW, scr, lane);
        convert_matrix(PIN(24) + (size_t)i * 1024 * 2048, 1024, 2048, (bf16*)(wsl + WS_W + W_KV) + (size_t)i * 2048 * 1024, nullptr, 1.0f, 0, gw, NGW, scr, lane);
    }
    for (int e = blk * NTHR + tid; e < 4 * 32 * 1024; e += G * NTHR) { const int l = e >> 15, jr = (e >> 10) & 31, k = e & 1023; float v = 0.f;
        if (jr < 4) v = PIN(26)[((size_t)l * 1024 + k) * 4 + jr]; else if (jr < 20) v = PIN(28)[((size_t)l * 1024 + k) * 16 + (jr - 4)];
        wr_all[e] = (bf16)f2bf(v * PIN(8)[l * 1024 + k]); }
    for (int m = gw; m < MT; m += NGW) row_norm_bf16(PIN(1) + (size_t)m * 1024, PIN(3), memn + (size_t)m * 1024, lane);
    for (int m = gw; m < T; m += 4 * NGW) rows4_to_xb(PIN(0), xb, ssb, m, NGW, lane);
    }
    GRID_BAR();
    { pg8::Gemm g{memn, (const bf16*)(wsl + WS_W + W_KV), 1024, 1024, 1024}; pg8::StaticOrder S; S.init(MT, 8192, G, blk);
      pg8::EpiBlocks256 E{kvb};
      pg8::gemm_phase<pg8::EpiBlocks256, pg8::StaticOrder, true, false>(lds, g, S, E); }


    for (int i = 0; i < 4; ++i) {
        const int j = i >> 1; unsigned char* wl = wsl + WS_W + (size_t)i * W_LAYER;
        __syncthreads();
        { FL convert_moe(PIN(30) + (size_t)i * 16 * 1024 * 512, PIN(31) + (size_t)i * 16 * 1024 * 512, PIN(32) + (size_t)i * 16 * 512 * 1024, w13t, w2t, PIN(8) + i * 1024, gw, NGW, scr, lane); }
        __syncthreads();
        {
        { pg8::Gemm g{xb, (const bf16*)(wl + W_IN), 1024, 1024, 1024}; pg8::StaticOrder S; S.init(T, 3072, G, blk);
          const bool tb = pg8::build_rs_table(S, ssb); __syncthreads();
          pg8::EpiNormBf16 E{proj, 3072, ssb, 0, tb, (i & 1) ? (1 << 30) : 8};
          pg8::gemm_phase<pg8::EpiNormBf16, pg8::StaticOrder, true, false>(lds, g, S, E); }
        GRID_BAR();
        if ((i & 1) == 0) {
            hgrn_phaseA(lds, blk, G, proj, mix, dch, PIN(5), j);
            GRID_BAR();
            hgrn_phaseB(proj, dch, G);
            for (int u = blk; u < NB * (SEQ / CV_R); u += G) conv_unit(lds, u, proj, mix, PIN(12) + (size_t)j * 31 * 512, PIN(13) + j * 512, PIN(14) + j * 512, PIN(15) + j * 512);
            GRID_BAR();
            hgrn_phaseC(lds, blk, G, proj, mix, PIN(11) + j * 128);
        } else {
            float d1 = 0.f, d2 = 0.f;
            for (int k = 0; k < 64; ++k) { d1 += PIN(18)[j * 64 + k] * PIN(19)[j * 64 + k]; d2 += PIN(20)[j * 64 + k] * PIN(21)[j * 64 + k]; }
            const float lam_init = (j == 0) ? P.lam_init[0] : P.lam_init[1], lam = __expf(d1) - __expf(d2) + lam_init;
            const int vcu = (G % 8 == 0) ? (blk % 8) * (G / 8) + blk / 8 : blk;
            for (int idx = vcu; idx < 2048; idx += G) { const int bh = idx >> 4, pr = idx & 15, b = bh >> 3, h = bh & 7;
                diffattn_unit(lds, b, h, pr, proj, mix, lam, lam_init, PIN(22) + j * 128, PIN(2), (const LAS unsigned char*)(lds + MISC_OFF + 784));
                diffattn_unit(lds, b, h, 31 - pr, proj, mix, lam, lam_init, PIN(22) + j * 128, PIN(2), (const LAS unsigned char*)(lds + MISC_OFF + 784)); }
        }
        }
        GRID_BAR();
        { pg8::Gemm g{mix, (const bf16*)(wl + W_OUT), 1024, 1024, 1024}; pg8::StaticOrder S; S.init(T, 1024, G, blk);
          pg8::EpiResidual E{xb, ssb};
          pg8::gemm_phase<pg8::EpiResidual, pg8::StaticOrder, true, false>(lds, g, S, E); }
        { const bf16* kvl = kvb + (size_t)i * 16 * 8 * 65536;
          for (int mode = 0; mode < 2; ++mode) {
              pg8::Gemm g{mode ? (const bf16*)(wl + W_XO) : kvl, mode ? kvl : (const bf16*)(wl + W_XQ), 256, 256, 256}; pg8::FoldOrder S{G, blk, mode};
              pg8::EpiNormBf16 E{(bf16*)(wsl + WS_FOLD + (mode ? 32 * MiB : 0)), 1024, nullptr, 1, false, 1 << 30};
              pg8::gemm_phase<pg8::EpiNormBf16, pg8::FoldOrder, true, false>(lds, g, S, E); } }
        GRID_BAR();
        { pg8::Gemm g{xb, (const bf16*)(wsl + WS_FOLD), 1024, 1024, 1024}; pg8::BatchOrder S; S.init(T, 1024, G, blk);
          const bool tb = pg8::build_rs_table(S, ssb); __syncthreads();
          pg8::EpiSoftmaxBf16 E{xq, ssb, (LAS float*)(lds + 131072), tb};
          pg8::gemm_phase<pg8::EpiSoftmaxBf16, pg8::BatchOrder, true, false>(lds, g, S, E); }
        GRID_BAR();
        { pg8::Gemm g{xq, (const bf16*)(wsl + WS_FOLD + 32 * MiB), 1024, 1024, 1024}; pg8::BatchOrder S; S.init(T, 1024, G, blk);
          pg8::EpiResidual E{xb, ssb};
          pg8::gemm_phase<pg8::EpiResidual, pg8::BatchOrder, true, false>(lds, g, S, E); }
        GRID_BAR();
        for (int tile = blk; tile < T / 256; tile += G)
            router_tile256(lds, tile, xb, ssb, wr_all + (size_t)i * 32 * 1024, PIN(27) + i * 4, PIN(29) + i * 16, route, lists, (unsigned*)(ctl + CW_CNT + 32 * (i * 32)));
        GRID_BAR();
        LAS int* tab = (LAS int*)(lds + MISC_OFF) + 32;
        const int mvc = (G % 8 == 0) ? (blk % 8) * (G / 8) + blk / 8 : blk;
        { FL if (tid < 32) tab[33 + tid] = (int)__hip_atomic_load(ctl + CW_CNT + 32 * (i * 32 + tid), RLX_AGENT);
        __syncthreads();
        if (tid == 0) { int a = 0; tab[0] = 0; for (int q = 0; q < 32; ++q) { a += (tab[33 + q] + 255) >> 8; tab[q + 1] = a; } } }
        __syncthreads();
        { pg8::Gemm g{xb, w13t, 1024, 1024, 1024}; pg8::MoeOrder S{G, mvc, 0, tab[32], tab, lists, (LAS unsigned short*)(lds + 131072), 8};
          pg8::EpiSwiglu E{hid, lists, (const float*)route, (LAS unsigned short*)(lds + 131072)};
          pg8::gemm_phase<pg8::EpiSwiglu, pg8::MoeOrder, true, true>(lds, g, S, E); }
        GRID_BAR();
        { pg8::Gemm g{hid, w2t, 1024, 1024, 512}; pg8::MoeOrder S{G, mvc, 0, tab[32], tab, lists, (LAS unsigned short*)(lds + 131072), 4};
          pg8::EpiMoeDown E{xb, ssb, lists};
          pg8::gemm_phase<pg8::EpiMoeDown, pg8::MoeOrder, true, false, true>(lds, g, S, E); }
        GRID_BAR();
    }
    { FL f32x4 gg[4]; { const GAS f32x4* gr = (const GAS f32x4*)PIN(4) + lane;
#pragma unroll
      for (int j = 0; j < 4; ++j) gg[j] = gr[64 * j]; }
      for (int m = gw; m < T; m += 4 * NGW) rows4_final(xb, xout, ssb, gg, m, NGW, lane); }
}

extern "C" void kernel_launch(void* const* d_in, const int* in_sizes, int n_in, void* d_out, int out_size, void* d_ws, size_t ws_size, hipStream_t stream) {
    static int grid = 0;
    if (grid == 0) {
        if (n_in != 33 || out_size != T * DM || ws_size < WS_END) { fprintf(stderr, "kernel_launch: unexpected problem (n_in %d out %d ws %zu)\n", n_in, out_size, ws_size); grid = -1; return; }
        int dev = 0, cus = 0, per_cu = 0;
        if (hipGetDevice(&dev) != hipSuccess || hipDeviceGetAttribute(&cus, hipDeviceAttributeMultiprocessorCount, dev) != hipSuccess) { grid = -1; return; }
        if (hipFuncSetAttribute((const void*)mk_fwd, hipFuncAttributeMaxDynamicSharedMemorySize, LDS_BYTES) != hipSuccess) { fprintf(stderr, "kernel_launch: hipFuncSetAttribute failed\n"); grid = -1; return; }
        if (hipOccupancyMaxActiveBlocksPerMultiprocessor(&per_cu, (const void*)mk_fwd, NTHR, LDS_BYTES) != hipSuccess || per_cu < 1) { fprintf(stderr, "kernel_launch: occupancy query says %d\n", per_cu); }
        (void)hipGetLastError();
        grid = cus;
        while (grid > 1 && (T % (32 * grid)) != 0) --grid;
    }
    if (grid < 0) return;
    if (hipMemsetAsync((char*)d_ws + WS_CTL, 0, CTL_ZERO_BYTES, stream) != hipSuccess) return;
    Params p; memset(&p, 0, sizeof(p));
    for (int i = 0; i < 33; ++i) p.in[i] = (const float*)d_in[i];
    p.out = (float*)d_out; p.ws = (unsigned char*)d_ws;
    p.lam_init[0] = (float)(0.8 - 0.6 * exp(-0.3 * 1.0)); p.lam_init[1] = (float)(0.8 - 0.6 * exp(-0.3 * 3.0));
    for (int n = 0; n < 128; ++n) { int bk; if (n < 16) bk = n; else { bk = 16 + (int)(log((double)n / 16.0) / log(8.0) * 16.0); if (bk > 31) bk = 31; if (bk < 0) bk = 0; } p.bucket[n] = (unsigned char)bk; }
    hipLaunchKernelGGL(mk_fwd, dim3(grid), dim3(NTHR), LDS_BYTES, stream, p);
}
```

```cpp
#include <hip/hip_runtime.h>
#include <cstdio>
#include <cstdint>
#include <cmath>
#include <cstring>
extern __shared__ __attribute__((aligned(16))) unsigned char lds_raw[];
constexpr int WAVE_TAB_OFF = 160 * 1024 - 1024;
__device__ __forceinline__ int hw_slot() { return (int)(__builtin_amdgcn_s_getreg((5 << 11) | 4) & 0x3f); }
__device__ __forceinline__ int otid() {
    const int wv = __builtin_amdgcn_readfirstlane(((const __attribute__((address_space(3))) int*)((const __attribute__((address_space(3))) unsigned char*)lds_raw + WAVE_TAB_OFF))[hw_slot()]);
    int t = wv * 64 + (int)__builtin_amdgcn_mbcnt_hi(~0u, __builtin_amdgcn_mbcnt_lo(~0u, 0u)); asm volatile("" : "+v"(t)); return t; }
#ifndef SHFL_SAFE
#define SHFL_SAFE 1
#endif
#if SHFL_SAFE
template <int M> __device__ __forceinline__ float xor_lt32(float v) { return __shfl_xor(v, M); }
__device__ __forceinline__ float sum_halves(float v) { return v + __shfl_xor(v, 32); }
__device__ __forceinline__ float max_halves(float v) { return __builtin_fmaxf(v, __shfl_xor(v, 32)); }
#else
template <int M> __device__ __forceinline__ float xor_lt32(float v) { return __builtin_bit_cast(float, __builtin_amdgcn_ds_swizzle(__builtin_bit_cast(int, v), 0x1f | (M << 10))); }
__device__ __forceinline__ float sum_halves(float v) { auto rr = __builtin_amdgcn_permlane32_swap(__builtin_bit_cast(unsigned, v), __builtin_bit_cast(unsigned, v), false, false); return __builtin_bit_cast(float, rr[0]) + __builtin_bit_cast(float, rr[1]); }
__device__ __forceinline__ float max_halves(float v) { auto rr = __builtin_amdgcn_permlane32_swap(__builtin_bit_cast(unsigned, v), __builtin_bit_cast(unsigned, v), false, false); return __builtin_fmaxf(__builtin_bit_cast(float, rr[0]), __builtin_bit_cast(float, rr[1])); }
#endif
namespace pg8 {
#define PG8_LAS __attribute__((address_space(3)))
#define PG8_GAS __attribute__((address_space(1)))
typedef unsigned short bf16_t;
typedef short bf16x8 __attribute__((ext_vector_type(8)));
typedef float f32x4 __attribute__((ext_vector_type(4)));
typedef float f32x2 __attribute__((ext_vector_type(2)));
typedef unsigned u32x4 __attribute__((ext_vector_type(4)));
typedef unsigned u32x2 __attribute__((ext_vector_type(2)));
constexpr int BM = 256, BK = 64, HALF = 128, HTB = HALF * BK * 2, STAGE_BYTES = 8 * HTB, NXCD = 8, WGM = 8;

__host__ __device__ __forceinline__ int lds_byte(int r, int c) { const int st = (r >> 4) * 2 + (c >> 5), rr = r & 15, cc = c & 31, ob = rr * 64 + cc * 2; return st * 1024 + (ob ^ (((ob >> 9) & 1) << 5)); }
__host__ __device__ __forceinline__ void stage_rc(int b, int& R, int& C) { const int st = b / 1024, sb = b % 1024, swz = sb ^ (((sb >> 9) & 1) << 5); R = (st >> 1) * 16 + swz / 64; C = (st & 1) * 32 + (swz % 64) / 2; }
__host__ __device__ __forceinline__ int perm32(int rho) { const int n = rho >> 4, i = rho & 15; return 8 * (i >> 2) + 4 * n + (i & 3); }

struct Unit { int pm, pn, x0, x1, x2, x3, ui; long bd; };
constexpr int RS_TAB_OFF = 131072 + 8192, RS_TAB_UNITS = 12;
struct Gemm { const bf16_t* A; const bf16_t* Bt; int K, lda, ldb; long abatch = 0; };

struct StaticOrder {
    static constexpr bool PRELOAD = false;
    int nM, nN, nwg, G, c;
    __device__ __forceinline__ void init(int M, int N, int G_, int c_) { nM = M / BM; nN = N / BM; nwg = nM * nN; G = G_; c = c_; }
    __device__ __forceinline__ bool next(int i, Unit& u) const {
        const long L = (long)i * G + c; if (L >= nwg) return false;
        int wgid = (int)L; { const int q = nwg / NXCD, r = nwg % NXCD, xcd = wgid % NXCD, off = wgid / NXCD; wgid = (xcd < r ? xcd * (q + 1) : r * (q + 1) + (xcd - r) * q) + off; }
        const int nig = WGM * nN, gid = wgid / nig, fm = gid * WGM, gsz = (nM - fm) < WGM ? (nM - fm) : WGM;
        u.pm = fm + ((wgid % nig) % gsz); u.pn = (wgid % nig) / gsz; u.x0 = u.pn; u.x1 = 0; u.x2 = 256; u.x3 = 0; u.bd = 0; return true;
    }
    __device__ __forceinline__ void preload(int) const {}
    __device__ __forceinline__ unsigned rowoff(int, int) const { return 0u; }
};

struct BatchOrder : StaticOrder {
    __device__ __forceinline__ bool next(int i, Unit& u) const { if (!StaticOrder::next(i, u)) return false; u.pn = (u.pm >> 4) * 4 + u.x0; return true; }
};
struct FoldOrder {
    static constexpr bool PRELOAD = false;
    int G, c, mode;
    __device__ __forceinline__ bool next(int i, Unit& u) const { const int L = i * G + c; if (L >= 256) return false; const int bh = L >> 2, q = L & 3, b = bh >> 2, h = bh & 3;
        if (mode == 0) { u.pm = b * 8 + h; u.pn = h * 4 + q; u.x0 = q; u.x1 = b * 4 + h; } else { u.pm = h * 4 + q; u.pn = b * 8 + 4 + h; u.x0 = h; u.x1 = b * 4 + q; }
        u.x2 = 256; u.x3 = 0; u.bd = 0; return true; }
    __device__ __forceinline__ void preload(int) const {}
    __device__ __forceinline__ unsigned rowoff(int, int) const { return 0u; }
};
struct MoeOrder {
    static constexpr bool PRELOAD = true;
    int G, c, t0, t1; const PG8_LAS int* tab; const int* lists; PG8_LAS unsigned short* tokl; int ncol;
    __device__ __forceinline__ PG8_LAS unsigned* uinfo() const { return (PG8_LAS unsigned*)(lds_raw + (160 * 1024 - 2048) + 1280); }
    __device__ __forceinline__ bool tile_of(int i, int& tile, int& col) const { const int L = i * G + c; const int sh = (ncol == 8) ? 3 : 2; tile = t0 + (L >> sh); col = L & (ncol - 1); return tile < t1; }
    __device__ __forceinline__ unsigned scan(int tile) const {
        int idx = 0;
        for (int j = 0; j < 32; ++j) { if (tab[j + 1] > tile) { idx = j; break; } }
        const int mt = tile - tab[idx]; int nv = tab[33 + idx] - mt * 256; nv = nv > 256 ? 256 : nv;
        return (unsigned)idx | ((unsigned)(nv - 1) << 8) | ((unsigned)mt << 16); }
    __device__ __forceinline__ bool next(int i, Unit& u) const {
        int tile, col; if (!tile_of(i, tile, col)) return false;
        const unsigned w = uinfo()[i]; const int idx = w & 31, nv = ((w >> 8) & 255) + 1, mt = w >> 16;
        const int gs = idx / 6, q = idx - gs * 6, lo = gs * 4 + ((0x211000 >> (4 * q)) & 15), hi = gs * 4 + ((0x332321 >> (4 * q)) & 15);
        u.pm = tile; u.x0 = idx; u.x1 = mt; u.x2 = nv; u.x3 = col;
        if (ncol == 8) { u.pn = ((col < 4) ? lo : hi) * 4 + (col & 3); u.bd = 0; }
        else { u.pn = lo * 4 + col; u.bd = (long)(hi - lo) * 4 * (256 * 512 * 2) - 8 * (BK * 2); }
        return true;
    }
    __device__ __forceinline__ void preload(int tid) const {
        { int tile, col; if (tid < 32 && tile_of(tid, tile, col)) uinfo()[tid] = scan(tile); }
        if (ncol != 8) return;
        const int half = tid >> 8, r = tid & 255;
#pragma unroll 1
        for (int i0 = 0; ; i0 += 4) { int tile, col; if (!tile_of(i0, tile, col)) break;
            unsigned w[2]; bool ok[2]; int tok[2];
#pragma unroll
            for (int j = 0; j < 2; ++j) { const int ii = i0 + 2 * j + half; ok[j] = tile_of(ii, tile, col); tok[j] = 0; w[j] = 0u;
                if (ok[j]) { w[j] = scan(tile); if (r <= (int)((w[j] >> 8) & 255)) tok[j] = ((const PG8_GAS int*)lists)[(size_t)(w[j] & 31) * 65536 + (w[j] >> 16) * 256 + r]; } }
#pragma unroll
            for (int j = 0; j < 2; ++j) { const int ii = i0 + 2 * j + half; if (ok[j]) tokl[ii * 256 + r] = (unsigned short)tok[j]; }
        } }
    __device__ __forceinline__ unsigned rowoff(int ui, int row) const { return (unsigned)tokl[ui * 256 + row]; }
};

__device__ __forceinline__ unsigned cvt_pk_bf16(float lo, float hi) { unsigned r; asm volatile("v_cvt_pk_bf16_f32 %0, %1, %2" : "=v"(r) : "v"(lo), "v"(hi)); return r; }

__device__ __forceinline__ float row_rs(const float* ss, int row) {
    const PG8_GAS f32x4* sp = (const PG8_GAS f32x4*)(ss + (size_t)row * 16); const f32x4 a = sp[0], b = sp[1], c = sp[2], d = sp[3];
    const float s = ((a[0] + a[1]) + (a[2] + a[3])) + ((b[0] + b[1]) + (b[2] + b[3])) + ((c[0] + c[1]) + (c[2] + c[3])) + ((d[0] + d[1]) + (d[2] + d[3]));
    return __builtin_amdgcn_rsqf(s * (1.0f / 1024.0f) + 1e-6f);
}
__device__ __forceinline__ void rows8_rs(const float* ss, int row0, float (&rr)[8]) {
#pragma unroll
    for (int q = 0; q < 8; q += 2) { rr[q] = row_rs(ss, row0 + (q >> 2) * HALF + (q & 3) * 16); rr[q + 1] = row_rs(ss, row0 + ((q + 1) >> 2) * HALF + ((q + 1) & 3) * 16); asm volatile("" : "+v"(rr[q]), "+v"(rr[q + 1]) :: "memory"); }
}
__device__ __forceinline__ void rows8_tab(int ui, int wr, int fr, float (&rr)[8]) {
    const PG8_LAS float* tp = (const PG8_LAS float*)(lds_raw + RS_TAB_OFF) + ui * 256 + wr * 64 + fr;
#pragma unroll
    for (int q = 0; q < 8; ++q) rr[q] = tp[(q >> 2) * HALF + (q & 3) * 16];
}
template <class Sched>
__device__ __forceinline__ bool build_rs_table(const Sched& S, const float* ss) {
    { Unit t; if (S.next(RS_TAB_UNITS, t)) return false; }
    const int tid = otid(), r = tid >> 1, hf = tid & 1; PG8_LAS float* tab = (PG8_LAS float*)(lds_raw + RS_TAB_OFF);
#pragma unroll 1
    for (int i0 = 0; i0 < RS_TAB_UNITS; i0 += 4) {
        f32x4 a[4][2]; bool ok[4];
#pragma unroll
        for (int j = 0; j < 4; ++j) { Unit u; ok[j] = S.next(i0 + j, u); if (ok[j]) { const PG8_GAS f32x4* sp = (const PG8_GAS f32x4*)(ss + ((size_t)u.pm * BM + r) * 16 + 8 * hf); a[j][0] = sp[0]; a[j][1] = sp[1]; } }
#pragma unroll
        for (int j = 0; j < 4; ++j) if (ok[j]) { float s_ = ((a[j][0][0] + a[j][0][1]) + (a[j][0][2] + a[j][0][3])) + ((a[j][1][0] + a[j][1][1]) + (a[j][1][2] + a[j][1][3])); s_ += __shfl_xor(s_, 1);
            if (hf == 0) tab[(i0 + j) * 256 + r] = __builtin_amdgcn_rsqf(s_ * (1.0f / 1024.0f) + 1e-6f); }
        if (!ok[3]) break;
    }
    return true;
}
struct EpiNormBf16 {
    static constexpr bool PERM = true; static constexpr int NSTORE = 8;
    bf16_t* O; int ldc; const float* ss; int rowsel; bool tab; int glu_from;
    __device__ __forceinline__ void operator()(const f32x4 (&acc)[2][2][4][2], const Unit& u, int wr, int wc, int fr, int fq) const {
        const int row0 = (rowsel ? u.x1 : u.pm) * BM + wr * 64 + fr, col0 = u.x0 * BM + wc * 32 + 8 * fq;
        float rr8[8];
        if (tab) rows8_tab(u.ui, wr, fr, rr8); else if (ss) rows8_rs(ss, row0, rr8); else {
#pragma unroll
            for (int q = 0; q < 8; ++q) rr8[q] = 1.0f; }
        if (u.x0 >= glu_from) {
            const int gcol = glu_from * BM + (u.x0 - glu_from) * HALF + wc * 32 + 8 * fq;
#pragma unroll
            for (int ai = 0; ai < 2; ++ai)
#pragma unroll
                for (int m = 0; m < 4; ++m) { const int row = row0 + ai * HALF + m * 16; const float rr = rr8[ai * 4 + m]; const float c1 = -1.44269504f * rr; const f32x2 c1v = {c1, c1}, rrv = {rr, rr}, one = {1.0f, 1.0f};
                    float hv[8];
#pragma unroll
                    for (int n = 0; n < 2; ++n)
#pragma unroll
                        for (int j = 0; j < 4; j += 2) { const f32x2 vv = {acc[ai][0][m][n][j], acc[ai][0][m][n][j + 1]}, gg = {acc[ai][1][m][n][j], acc[ai][1][m][n][j + 1]};
                            f32x2 e = gg * c1v; e[0] = __builtin_amdgcn_exp2f(e[0]); e[1] = __builtin_amdgcn_exp2f(e[1]); e += one;
                            f32x2 sg; sg[0] = __builtin_amdgcn_rcpf(e[0]); sg[1] = __builtin_amdgcn_rcpf(e[1]);
                            const f32x2 h2 = (vv * rrv) * sg; hv[n * 4 + j] = h2[0]; hv[n * 4 + j + 1] = h2[1]; }
                    u32x4 w; w.x = cvt_pk_bf16(hv[0], hv[1]); w.y = cvt_pk_bf16(hv[2], hv[3]); w.z = cvt_pk_bf16(hv[4], hv[5]); w.w = cvt_pk_bf16(hv[6], hv[7]);
                    *(PG8_GAS u32x4*)(O + (size_t)row * ldc + gcol) = w; }
            return; }
#pragma unroll
        for (int ai = 0; ai < 2; ++ai)
#pragma unroll
            for (int m = 0; m < 4; ++m) { const int row = row0 + ai * HALF + m * 16; const float rr = rr8[ai * 4 + m]; bf16_t* rowp = O + (size_t)row * ldc + col0;
#pragma unroll
                for (int bj = 0; bj < 2; ++bj) { const f32x4 v0 = acc[ai][bj][m][0] * rr, v1 = acc[ai][bj][m][1] * rr;
                    u32x4 w; w.x = cvt_pk_bf16(v0[0], v0[1]); w.y = cvt_pk_bf16(v0[2], v0[3]); w.z = cvt_pk_bf16(v1[0], v1[1]); w.w = cvt_pk_bf16(v1[2], v1[3]);
                    *(PG8_GAS u32x4*)(rowp + bj * HALF) = w; } }
    }
};
struct EpiBlocks256 {
    static constexpr bool PERM = true; static constexpr int NSTORE = 16;
    bf16_t* O;
    __device__ __forceinline__ void operator()(const f32x4 (&acc)[2][2][4][2], const Unit& u, int wr, int wc, int fr, int fq) const {
        bf16_t* base = O + (size_t)(((u.x0 >> 3) * 16 + u.pm) * 8 + (u.x0 & 7)) * 65536 + (wr * 64 + fr) * 256 + wc * 32 + 8 * fq;
#pragma unroll
        for (int ai = 0; ai < 2; ++ai)
#pragma unroll
            for (int m = 0; m < 4; ++m) { bf16_t* rowp = base + (ai * HALF + m * 16) * 256;
#pragma unroll
                for (int bj = 0; bj < 2; ++bj) { const f32x4 v0 = acc[ai][bj][m][0], v1 = acc[ai][bj][m][1];
                    u32x4 w; w.x = cvt_pk_bf16(v0[0], v0[1]); w.y = cvt_pk_bf16(v0[2], v0[3]); w.z = cvt_pk_bf16(v1[0], v1[1]); w.w = cvt_pk_bf16(v1[2], v1[3]);
                    *(PG8_GAS u32x4*)(rowp + bj * HALF) = w; } }
    }
};
__device__ __forceinline__ float bf_lo(unsigned w) { return __builtin_bit_cast(float, w << 16); }
__device__ __forceinline__ float bf_hi(unsigned w) { return __builtin_bit_cast(float, w & 0xffff0000u); }
struct EpiResidual {
    static constexpr bool PERM = true; static constexpr int NSTORE = 16;
    bf16_t* xb; float* ss;
    __device__ __forceinline__ void operator()(const f32x4 (&acc)[2][2][4][2], const Unit& u, int wr, int wc, int fr, int fq) const {
        const int row0 = u.pm * BM + wr * 64 + fr, col0 = u.x0 * BM + wc * 32 + 8 * fq;
#pragma unroll
        for (int ai = 0; ai < 2; ++ai) {
            u32x4 rv[4][2];
#pragma unroll
            for (int m = 0; m < 4; ++m)
#pragma unroll
                for (int bj = 0; bj < 2; ++bj) rv[m][bj] = *(const __attribute__((address_space(1))) u32x4*)(xb + (size_t)(row0 + ai * HALF + m * 16) * 1024 + col0 + bj * HALF);
#pragma unroll
            for (int m = 0; m < 4; ++m) { const int row = row0 + ai * HALF + m * 16; float q = 0.f; bf16_t* rowp = xb + (size_t)row * 1024 + col0;
#pragma unroll
                for (int bj = 0; bj < 2; ++bj) { const u32x4 r = rv[m][bj];
                    const f32x4 a0 = acc[ai][bj][m][0], a1 = acc[ai][bj][m][1];
                    const float v0 = bf_lo(r.x) + a0[0], v1 = bf_hi(r.x) + a0[1], v2 = bf_lo(r.y) + a0[2], v3 = bf_hi(r.y) + a0[3];
                    const float v4 = bf_lo(r.z) + a1[0], v5 = bf_hi(r.z) + a1[1], v6 = bf_lo(r.w) + a1[2], v7 = bf_hi(r.w) + a1[3];
                    q += ((v0 * v0 + v1 * v1) + (v2 * v2 + v3 * v3)) + ((v4 * v4 + v5 * v5) + (v6 * v6 + v7 * v7));
                    u32x4 w; w.x = cvt_pk_bf16(v0, v1); w.y = cvt_pk_bf16(v2, v3); w.z = cvt_pk_bf16(v4, v5); w.w = cvt_pk_bf16(v6, v7);
                    *(PG8_GAS u32x4*)(rowp + bj * HALF) = w; }
                q += xor_lt32<16>(q); q = sum_halves(q);
                if (fq == 0) ((PG8_GAS float*)ss)[(size_t)row * 16 + u.x0 * 4 + wc] = q; } }
    }
};
struct EpiSoftmaxBf16 {
    static constexpr bool PERM = true, MUTABLE = true; static constexpr int NSTORE = 16;
    bf16_t* O; const float* ss; PG8_LAS float* xch; bool tab; long obatch;
    __device__ __forceinline__ void operator()(f32x4 (&acc)[2][2][4][2], const Unit& u, int wr, int wc, int fr, int fq) const {
        const int row0 = u.pm * BM + wr * 64 + fr, col0 = u.x0 * BM + wc * 32 + 8 * fq;
        float mw[8], rr8[8]; if (tab) rows8_tab(u.ui, wr, fr, rr8); else rows8_rs(ss, row0, rr8);
#pragma unroll
        for (int ai = 0; ai < 2; ++ai)
#pragma unroll
            for (int m = 0; m < 4; ++m) { const float rr = rr8[ai * 4 + m]; float mx = -3.0e38f;
#pragma unroll
                for (int bj = 0; bj < 2; ++bj)
#pragma unroll
                    for (int n = 0; n < 2; ++n) { acc[ai][bj][m][n] *= rr; const f32x4 v = acc[ai][bj][m][n]; mx = __builtin_fmaxf(mx, __builtin_fmaxf(__builtin_fmaxf(v[0], v[1]), __builtin_fmaxf(v[2], v[3]))); }
                mx = __builtin_fmaxf(mx, xor_lt32<16>(mx)); mx = max_halves(mx); float sm = 0.f;
#pragma unroll
                for (int bj = 0; bj < 2; ++bj)
#pragma unroll
                    for (int n = 0; n < 2; ++n) { f32x4 v = acc[ai][bj][m][n];
#pragma unroll
                        for (int j = 0; j < 4; ++j) { v[j] = __builtin_amdgcn_exp2f(v[j] - mx); sm += v[j]; }
                        acc[ai][bj][m][n] = v; }
                sm += xor_lt32<16>(sm); sm = sum_halves(sm); mw[ai * 4 + m] = mx;
                if (fq == 0) { const int rit = ai * HALF + wr * 64 + m * 16 + fr; xch[(rit * 4 + wc) * 2] = mx; xch[(rit * 4 + wc) * 2 + 1] = sm; } }
        asm volatile("s_waitcnt lgkmcnt(0)" ::: "memory"); __builtin_amdgcn_s_barrier(); asm volatile("" ::: "memory");
#pragma unroll
        for (int ai = 0; ai < 2; ++ai)
#pragma unroll
            for (int m = 0; m < 4; ++m) { const int rit = ai * HALF + wr * 64 + m * 16 + fr; const int row = row0 + ai * HALF + m * 16;
                const f32x4 e0 = *(const PG8_LAS f32x4*)(xch + rit * 8), e1 = *(const PG8_LAS f32x4*)(xch + rit * 8 + 4);
                const float M = __builtin_fmaxf(__builtin_fmaxf(e0[0], e0[2]), __builtin_fmaxf(e1[0], e1[2]));
                const float tot = e0[1] * __builtin_amdgcn_exp2f(e0[0] - M) + e0[3] * __builtin_amdgcn_exp2f(e0[2] - M) + e1[1] * __builtin_amdgcn_exp2f(e1[0] - M) + e1[3] * __builtin_amdgcn_exp2f(e1[2] - M);
                const float f = __builtin_amdgcn_exp2f(mw[ai * 4 + m] - M) * __builtin_amdgcn_rcpf(tot); bf16_t* rowp = O + (size_t)(row >> 12) * (size_t)obatch + (size_t)(row & 4095) * 1024 + col0;
#pragma unroll
                for (int bj = 0; bj < 2; ++bj) { const f32x4 v0 = acc[ai][bj][m][0] * f, v1 = acc[ai][bj][m][1] * f;
                    u32x4 w; w.x = cvt_pk_bf16(v0[0], v0[1]); w.y = cvt_pk_bf16(v0[2], v0[3]); w.z = cvt_pk_bf16(v1[0], v1[1]); w.w = cvt_pk_bf16(v1[2], v1[3]);
                    *(PG8_GAS u32x4*)(rowp + bj * HALF) = w; } }
        asm volatile("s_waitcnt lgkmcnt(0)" ::: "memory");
    }
};
struct EpiSwiglu {
    static constexpr bool PERM = true; static constexpr int NSTORE = 0;
    bf16_t* hid; const int* lists; const float* route; const PG8_LAS unsigned short* tokl;
    __device__ __forceinline__ void operator()(const f32x4 (&acc)[2][2][4][2], const Unit& u, int wr, int wc, int fr, int fq) const {
        const int which = u.x3 >> 2, col0 = which * 512 + (u.x3 & 3) * 128 + wc * 32 + 8 * fq;
        unsigned pw[8];
#pragma unroll
        for (int q = 0; q < 8; ++q) { const int rit = (q >> 2) * HALF + wr * 64 + (q & 3) * 16 + fr; const unsigned tk = tokl[u.ui * 256 + rit]; pw[q] = ((const PG8_GAS unsigned*)route)[(size_t)tk * 4 + 1 + which]; }
#pragma unroll
        for (int ai = 0; ai < 2; ++ai)
#pragma unroll
            for (int m = 0; m < 4; ++m) { const int rit = ai * HALF + wr * 64 + m * 16 + fr; const float r1 = bf_lo(pw[ai * 4 + m]), r3 = bf_hi(pw[ai * 4 + m]);
                float hv[8];
                { typedef float f32x2 __attribute__((ext_vector_type(2))); const float c1 = -1.44269504f * r1, r13 = r1 * r3; const f32x2 c1v = {c1, c1}, r13v = {r13, r13}, one = {1.0f, 1.0f};
#pragma unroll
                  for (int n = 0; n < 2; ++n)
#pragma unroll
                      for (int j = 0; j < 4; j += 2) { const f32x2 g = {acc[ai][0][m][n][j], acc[ai][0][m][n][j + 1]}, uu = {acc[ai][1][m][n][j], acc[ai][1][m][n][j + 1]};
                          f32x2 e = g * c1v; e[0] = __builtin_amdgcn_exp2f(e[0]); e[1] = __builtin_amdgcn_exp2f(e[1]); e += one;
                          f32x2 sg; sg[0] = __builtin_amdgcn_rcpf(e[0]); sg[1] = __builtin_amdgcn_rcpf(e[1]);
                          const f32x2 h2 = (g * uu) * (sg * r13v); hv[n * 4 + j] = h2[0]; hv[n * 4 + j + 1] = h2[1]; } }
                u32x4 w; w.x = cvt_pk_bf16(hv[0], hv[1]); w.y = cvt_pk_bf16(hv[2], hv[3]); w.z = cvt_pk_bf16(hv[4], hv[5]); w.w = cvt_pk_bf16(hv[6], hv[7]);
                *(PG8_GAS u32x4*)(hid + (size_t)(u.pm * BM + rit) * 1024 + col0) = w; }
    }
};
struct EpiMoeDown {
    static constexpr bool PERM = true; static constexpr int NSTORE = 0;
    bf16_t* xb; float* ss; const int* lists;
    __device__ __forceinline__ void operator()(const f32x4 (&acc)[2][2][4][2], const Unit& u, int wr, int wc, int fr, int fq) const {
        const int pnl = u.x3, col0 = pnl * BM + wc * 32 + 8 * fq;
        const PG8_GAS int* lp = (const PG8_GAS int*)(lists + (size_t)u.x0 * 65536 + u.x1 * 256); const int last = u.x2 - 1;
        int tok[8];
#pragma unroll
        for (int q = 0; q < 8; ++q) { const int rit = (q >> 2) * HALF + wr * 64 + (q & 3) * 16 + fr; tok[q] = lp[rit < last ? rit : last]; }
#pragma unroll
        for (int ai = 0; ai < 2; ++ai) {
            u32x4 rv[4][2];
#pragma unroll
            for (int m = 0; m < 4; ++m)
#pragma unroll
                for (int bj = 0; bj < 2; ++bj) rv[m][bj] = *(const PG8_GAS u32x4*)(xb + (size_t)tok[ai * 4 + m] * 1024 + col0 + bj * HALF);
#pragma unroll
            for (int m = 0; m < 4; ++m) { const int rit = ai * HALF + wr * 64 + m * 16 + fr; const bool valid = rit <= last; float q = 0.f;
                bf16_t* rowp = xb + (size_t)tok[ai * 4 + m] * 1024 + col0;
#pragma unroll
                for (int bj = 0; bj < 2; ++bj) { const u32x4 r = rv[m][bj];
                    const f32x4 a0 = acc[ai][bj][m][0], a1 = acc[ai][bj][m][1];
                    const float v0 = bf_lo(r.x) + a0[0], v1 = bf_hi(r.x) + a0[1], v2 = bf_lo(r.y) + a0[2], v3 = bf_hi(r.y) + a0[3];
                    const float v4 = bf_lo(r.z) + a1[0], v5 = bf_hi(r.z) + a1[1], v6 = bf_lo(r.w) + a1[2], v7 = bf_hi(r.w) + a1[3];
                    q += ((v0 * v0 + v1 * v1) + (v2 * v2 + v3 * v3)) + ((v4 * v4 + v5 * v5) + (v6 * v6 + v7 * v7));
                    u32x4 w; w.x = cvt_pk_bf16(v0, v1); w.y = cvt_pk_bf16(v2, v3); w.z = cvt_pk_bf16(v4, v5); w.w = cvt_pk_bf16(v6, v7);
                    if (valid) *(PG8_GAS u32x4*)(rowp + bj * HALF) = w; }
                q += xor_lt32<16>(q); q = sum_halves(q); if (valid && fq == 0) ((PG8_GAS float*)ss)[(size_t)tok[ai * 4 + m] * 16 + pnl * 4 + wc] = q; }
        }
    }
};

template <class Epi, class Sched, bool ALIGN_EPI, bool GATHER, bool BSPLIT = false>
__device__ __forceinline__ void gemm_phase(PG8_LAS unsigned char* lds, const Gemm g, const Sched& S, const Epi& E) {
    const int tid = otid(), wid = __builtin_amdgcn_readfirstlane(tid >> 6), lane = tid & 63, wr = wid >> 2, wc = wid & 3, fr = lane & 15, fq = lane >> 4;
    const int K = g.K, nt = K / BK;
    unsigned voffA[2], voffB[2], cC2[2];
#pragma unroll
    for (int i = 0; i < 2; ++i) { int R, C; stage_rc(tid * 16 + i * 8192, R, C); const int Rb = Epi::PERM ? ((R & ~31) + perm32(R & 31)) : R;
        voffA[i] = (unsigned)(R * g.lda + C) * 2u; voffB[i] = (unsigned)(Rb * g.ldb + C) * 2u; cC2[i] = (unsigned)C * 2u; }
#define PG8_RR(i) ({ int R_, C_; stage_rc(tid * 16 + (i) * 8192, R_, C_); R_; })
    const size_t kstep = (size_t)(BK * 2);
    const size_t hstep = (size_t)HALF * g.lda * 2, hstepB = (size_t)HALF * g.ldb * 2;
    const size_t tstep = 2 * hstep, tstepB = 2 * hstepB;
    const unsigned ldsw = (unsigned)wid * 1024u;
    const int aoff = lds_byte(wr * 64 + fr, fq * 8), boff = lds_byte(wc * 32 + fr, fq * 8);
#define PG8_SA(b, h) (((b) * 2 + (h)) * HTB)
#define PG8_SB(b, h) ((4 + (b) * 2 + (h)) * HTB)
#define PG8_STAGE(bufoff, gbase, voff) do { _Pragma("unroll") for (int _i = 0; _i < 2; ++_i) \
        __builtin_amdgcn_global_load_lds((const unsigned*)((const char*)(gbase) + (voff)[_i]), (PG8_LAS unsigned*)(lds + (bufoff) + ldsw + _i * 8192), 16, 0, 0); } while (0)
#define PG8_STAGE_A(bufoff, h, kb, NX) do { if constexpr (GATHER) { const unsigned _p = (NX) ? nvA[h] : cvA[h]; unsigned _v[2]; _v[0] = (_p & 0xffffu) * (unsigned)(g.lda * 2) + cC2[0]; _v[1] = (_p >> 16) * (unsigned)(g.lda * 2) + cC2[1]; PG8_STAGE(bufoff, (const char*)g.A + (kb), _v); } \
        else { PG8_STAGE(bufoff, ((NX) ? nA : cA) + (h) * hstep + (kb), voffA); } } while (0)
#define PG8_LDA(dst, b, h) do { _Pragma("unroll") for (int m = 0; m < 4; ++m) _Pragma("unroll") for (int k = 0; k < 2; ++k) dst[m][k] = *(const PG8_LAS bf16x8*)(lds + PG8_SA(b, h) + aoff + m * 2048 + k * 1024); } while (0)
#define PG8_LDB(dst, b, h) do { _Pragma("unroll") for (int n = 0; n < 2; ++n) _Pragma("unroll") for (int k = 0; k < 2; ++k) dst[n][k] = *(const PG8_LAS bf16x8*)(lds + PG8_SB(b, h) + boff + n * 2048 + k * 1024); } while (0)
#define PG8_MMA(ai, bj, At, Bt) do { __builtin_amdgcn_s_setprio(1); _Pragma("unroll") for (int m = 0; m < 4; ++m) _Pragma("unroll") for (int n = 0; n < 2; ++n) _Pragma("unroll") for (int k = 0; k < 2; ++k) \
        acc[ai][bj][m][n] = __builtin_amdgcn_mfma_f32_16x16x32_bf16(Bt[n][k], At[m][k], acc[ai][bj][m][n], 0, 0, 0); __builtin_amdgcn_s_setprio(0); } while (0)
#define PG8_WAIT_V(n) asm volatile("s_waitcnt vmcnt(" #n ")" ::: "memory")
#define PG8_WAIT_L(n) asm volatile("s_waitcnt lgkmcnt(" #n ")" ::: "memory")
#define PG8_BAR __builtin_amdgcn_s_barrier()
#define PG8_SCHED __builtin_amdgcn_sched_barrier(0)
    Unit cur, nxt; int ui = 0;
    if constexpr (Sched::PRELOAD) { S.preload(tid); asm volatile("s_waitcnt vmcnt(0) lgkmcnt(0)" ::: "memory"); __builtin_amdgcn_s_barrier(); asm volatile("" ::: "memory"); }
    if (!S.next(0, cur)) return;
    cur.ui = 0;
    f32x4 acc[2][2][4][2];
#pragma unroll
    for (int a = 0; a < 2; ++a)
#pragma unroll
        for (int b = 0; b < 2; ++b)
#pragma unroll
            for (int m = 0; m < 4; ++m)
#pragma unroll
                for (int n = 0; n < 2; ++n) acc[a][b][m][n] = (f32x4){0.f, 0.f, 0.f, 0.f};
    bf16x8 At[4][2], B0[2][2], B1[2][2];
    unsigned cvA[2], nvA[2];
#define PG8_AOFF(pm_) (g.abatch ? (size_t)((pm_) >> 4) * (size_t)g.abatch + (size_t)((pm_) & 15) * tstep : (size_t)(pm_) * tstep)
    const char* cA = (const char*)g.A + (GATHER ? (size_t)0 : PG8_AOFF(cur.pm)); const char* cB = (const char*)g.Bt + (size_t)cur.pn * tstepB;
    const char* nA = cA;
    if constexpr (GATHER) {
#pragma unroll
        for (int h = 0; h < 2; ++h) { cvA[h] = S.rowoff(0, h * HALF + PG8_RR(0)) | (S.rowoff(0, h * HALF + PG8_RR(1)) << 16); nvA[h] = cvA[h]; }
    }
    PG8_STAGE(PG8_SB(0, 0), cB, voffB); PG8_STAGE(PG8_SB(0, 1), cB + hstepB, voffB); PG8_STAGE_A(PG8_SA(0, 0), 0, 0, false); PG8_STAGE_A(PG8_SA(0, 1), 1, 0, false);
    if (wr == 1) PG8_BAR;
    PG8_WAIT_V(2); PG8_BAR;
    PG8_STAGE(PG8_SB(1, 0), cB + kstep, voffB); PG8_STAGE_A(PG8_SA(1, 0), 0, kstep, false); PG8_STAGE(PG8_SB(1, 1), cB + hstepB + kstep, voffB);
    PG8_WAIT_V(6); PG8_BAR;
    for (;;) {
        const bool has_next = S.next(ui + 1, nxt);
        const char* nB = has_next ? (const char*)g.Bt + (size_t)nxt.pn * tstepB : cB;
        if constexpr (GATHER) {
            if (has_next) {
#pragma unroll
                for (int h = 0; h < 2; ++h) nvA[h] = S.rowoff(ui + 1, h * HALF + PG8_RR(0)) | (S.rowoff(ui + 1, h * HALF + PG8_RR(1)) << 16);
            } else { nvA[0] = cvA[0]; nvA[1] = cvA[1]; }
        } else { nA = has_next ? (const char*)g.A + PG8_AOFF(nxt.pm) : cA; }
#pragma unroll 1
        for (int t = 0; t < nt; t += 2) {
            const bool last = (t == nt - 2);
            const size_t k1 = (size_t)(t + 1) * kstep;
            const size_t k2 = last ? (size_t)0 : (size_t)(t + 2) * kstep, k3 = k2 + kstep;
            const char* b2 = last ? nB : cB + (size_t)(t + 2) * kstep; if (BSPLIT) { if (!last && 2 * (t + 2) >= nt) b2 += cur.bd; }
            const char* b3 = b2 + kstep;
            const bool rlx = (Epi::NSTORE >= 16) && (t == 0) && (ui > 0);
            PG8_LDB(B0, 0, 0); PG8_LDB(B1, 0, 1); PG8_SCHED; PG8_LDA(At, 0, 0); PG8_STAGE_A(PG8_SA(1, 1), 1, k1, false);
            if (rlx) PG8_WAIT_V(24); else PG8_WAIT_V(8); PG8_WAIT_L(0); PG8_BAR; PG8_MMA(0, 0, At, B0); PG8_MMA(0, 1, At, B1); PG8_BAR; PG8_SCHED;
            PG8_LDA(At, 0, 1); PG8_STAGE(PG8_SB(0, 0), b2, voffB); PG8_STAGE(PG8_SB(0, 1), b2 + hstepB, voffB); PG8_STAGE_A(PG8_SA(0, 0), 0, k2, last);
            if (rlx) PG8_WAIT_V(24); else PG8_WAIT_V(8); PG8_WAIT_L(0); PG8_BAR; PG8_MMA(1, 0, At, B0); PG8_MMA(1, 1, At, B1); PG8_BAR; PG8_SCHED;
            PG8_LDB(B0, 1, 0); PG8_LDB(B1, 1, 1); PG8_SCHED; PG8_LDA(At, 1, 0); PG8_STAGE_A(PG8_SA(0, 1), 1, k2, last);
            PG8_WAIT_V(8); PG8_WAIT_L(0); PG8_BAR; PG8_MMA(0, 0, At, B0); PG8_MMA(0, 1, At, B1); PG8_BAR; PG8_SCHED;
            PG8_LDA(At, 1, 1); PG8_STAGE(PG8_SB(1, 0), b3, voffB); PG8_STAGE(PG8_SB(1, 1), b3 + hstepB, voffB); PG8_STAGE_A(PG8_SA(1, 0), 0, k3, last);
            PG8_WAIT_V(8); PG8_WAIT_L(0); PG8_BAR; PG8_MMA(1, 0, At, B0); PG8_MMA(1, 1, At, B1); PG8_BAR; PG8_SCHED;
        }
        if constexpr (ALIGN_EPI) { if (wr == 0) PG8_BAR; }
        E(acc, cur, wr, wc, fr, fq);
        if (!has_next) break;
#pragma unroll
        for (int a = 0; a < 2; ++a)
#pragma unroll
            for (int b = 0; b < 2; ++b)
#pragma unroll
                for (int m = 0; m < 4; ++m)
#pragma unroll
                    for (int n = 0; n < 2; ++n) acc[a][b][m][n] = (f32x4){0.f, 0.f, 0.f, 0.f};
        cur = nxt; cA = nA; cB = nB; ++ui; cur.ui = ui;
        if constexpr (GATHER) { cvA[0] = nvA[0]; cvA[1] = nvA[1]; }
        if constexpr (ALIGN_EPI) { if (wr == 1) PG8_BAR; }
    }
    PG8_WAIT_V(0);
    if constexpr (!ALIGN_EPI) { if (wr == 0) PG8_BAR; }
    PG8_BAR;
#undef PG8_AOFF
#undef PG8_SA
#undef PG8_RR
#undef PG8_SB
#undef PG8_STAGE
#undef PG8_STAGE_A
#undef PG8_LDA
#undef PG8_LDB
#undef PG8_MMA
#undef PG8_WAIT_V
#undef PG8_WAIT_L
#undef PG8_BAR
#undef PG8_SCHED
}
}
constexpr int NB = 16, SEQ = 4096, DM = 1024, T = NB * SEQ, MEML = 256, MT = NB * MEML;
constexpr int NWAVES = 8, NTHR = 512;
constexpr float EPS = 1e-6f, LOG2E = 1.4426950408889634f;
constexpr size_t MiB = 1u << 20;
constexpr size_t WS_CTL = 0, CTL_ZERO_BYTES = 1 * MiB;
constexpr size_t WS_SS = 2 * MiB;
constexpr size_t WS_ROUTE = 6 * MiB;
constexpr size_t WS_WR = 7 * MiB;
constexpr size_t WS_DCH = 8 * MiB;
constexpr size_t WS_LISTS = 10 * MiB;
constexpr size_t WS_MEMN = 18 * MiB;
constexpr size_t WS_KV = 26 * MiB;
constexpr size_t WS_W = 90 * MiB;
constexpr size_t W_IN = 0, W_OUT = 6 * MiB, W_XQ = 8 * MiB, W_XO = 10 * MiB, W_LAYER = 12 * MiB, W_KV = 48 * MiB;
constexpr size_t WS_WM = 154 * MiB;
constexpr size_t WM_W2 = 32 * MiB;
constexpr size_t WS_XB = 202 * MiB;
constexpr size_t WS_MIX = 330 * MiB;
constexpr size_t WS_PROJ = 458 * MiB;
constexpr size_t WS_HID = WS_PROJ + 128 * MiB;
constexpr size_t WS_FOLD = 842 * MiB;
constexpr size_t WS_END = 906 * MiB;
constexpr int CW_TMO = 0, CW_BAR = 4096, CW_CNT = 8192;
constexpr int LDS_BYTES = 160 * 1024, MISC_OFF = LDS_BYTES - 2048;

#define GAS __attribute__((address_space(1)))
#define LAS __attribute__((address_space(3)))
typedef unsigned short bf16;
typedef unsigned v4u __attribute__((ext_vector_type(4)));
typedef unsigned v2u __attribute__((ext_vector_type(2)));
typedef float f32x4 __attribute__((ext_vector_type(4)));
typedef float f32x16 __attribute__((ext_vector_type(16)));
typedef short bf16x8 __attribute__((ext_vector_type(8)));
typedef short s16x4 __attribute__((ext_vector_type(4)));
typedef GAS unsigned gu32;
#define RLX_AGENT __ATOMIC_RELAXED, __HIP_MEMORY_SCOPE_AGENT
#define LDS_WAIT() asm volatile("s_waitcnt lgkmcnt(0)" ::: "memory")
#define VM_WAIT() asm volatile("s_waitcnt vmcnt(0)" ::: "memory")
#define MFMA32(a, b, c) __builtin_amdgcn_mfma_f32_32x32x16_bf16((a), (b), (c), 0, 0, 0)
#define MFMA16(a, b, c) __builtin_amdgcn_mfma_f32_16x16x32_bf16((a), (b), (c), 0, 0, 0)
typedef float f32x2_t __attribute__((ext_vector_type(2))); typedef __bf16 bf16x2_t __attribute__((ext_vector_type(2)));
__device__ __forceinline__ unsigned pk2(float lo, float hi) { f32x2_t v = {lo, hi}; bf16x2_t b = __builtin_convertvector(v, bf16x2_t); return __builtin_bit_cast(unsigned, b); }
__device__ __forceinline__ unsigned f2bf(float f) { return pk2(f, 0.f) & 0xffffu; }
__device__ __forceinline__ float bf2f(unsigned short b) { return __builtin_bit_cast(float, (unsigned)b << 16); }
__device__ __forceinline__ float bflo(unsigned w) { return __builtin_bit_cast(float, w << 16); }
__device__ __forceinline__ float bfhi(unsigned w) { return __builtin_bit_cast(float, w & 0xffff0000u); }
__device__ __forceinline__ float sigmoidf_(float x) { return __builtin_amdgcn_rcpf(1.0f + __expf(-x)); }
__device__ __forceinline__ float wave_sum(float v) {
    v += xor_lt32<1>(v); v += xor_lt32<2>(v); v += xor_lt32<4>(v); v += xor_lt32<8>(v); v += xor_lt32<16>(v);
    return sum_halves(v);
}
__device__ __forceinline__ int crow(int r, int hi) { return (r & 3) + 8 * (r >> 2) + 4 * hi; }

#define XB_TMO      128
#define XB_XCNT(j)  (256  + 64 * (j))
#define XB_XSUB(j)  (1280 + 64 * (j))
#define XB_XGEN(j)  (2304 + 64 * (j))
#define XB_TOP      3328
#define XB_TOPGEN   3392
#define XCD_BAR_WORDS 3456
#define XB_LCNT(j)  (3456 + 16 * (j))
#define XB_LGEN(j)  (3712 + 16 * (j))
#define XB_SPIN_CAP (1u << 20)
__device__ __forceinline__ unsigned xb_ld(unsigned* p)              { return __hip_atomic_load(p, __ATOMIC_RELAXED, __HIP_MEMORY_SCOPE_AGENT); }
__device__ __forceinline__ unsigned xb_add(unsigned* p, unsigned v) { return __hip_atomic_fetch_add(p, v, __ATOMIC_RELAXED, __HIP_MEMORY_SCOPE_AGENT); }
__device__ __forceinline__ unsigned xb_xcc_id() { return (unsigned)__builtin_amdgcn_s_getreg((3 << 11) | 20) & 0xFu; }
#define XB_SPIN(cond, bar) do { unsigned _sp = 0; while (cond) { __builtin_amdgcn_s_sleep(1); \
    if ((++_sp & 255u) == 0u) { if (xb_ld(&(bar)[XB_TMO])) break; if (_sp > XB_SPIN_CAP) { atomicAdd(&(bar)[XB_TMO], 1u); break; } } } } while (0)
struct XcdBarrier { unsigned* bar; unsigned x; volatile LAS unsigned* st; };
__device__ __forceinline__ XcdBarrier xcd_barrier_post(unsigned* bar, volatile LAS unsigned* st) {
    XcdBarrier b; b.bar = bar; b.x = xb_xcc_id(); b.st = st;
    if (otid() == 0) st[3] = xb_add(&bar[XB_XCNT(b.x)], 1u);
    return b;
}
__device__ __forceinline__ void xcd_barrier_complete(unsigned* bar, unsigned x, unsigned& nloc, unsigned& nx, unsigned& uni) {
    const unsigned G = gridDim.x * gridDim.y * gridDim.z;
    unsigned sum, cnt, mine, bad = 0u, sp = 0u;
    for (;;) {
        sum = 0u; cnt = 0u; mine = 0u;
        bad = 0u;
#pragma unroll 1
        for (unsigned j = 0; j < 16; ++j) { const unsigned c = xb_ld(&bar[XB_XCNT(j)]); sum += c; cnt += (c > 0u) ? 1u : 0u; mine = (j == x) ? c : mine; bad |= (c != 0u && (c * 8u != G || j >= 8u)) ? 1u : 0u; }
        if (sum == G) break;
        __builtin_amdgcn_s_sleep(1);
        if ((++sp & 255u) == 0u) { if (xb_ld(&bar[XB_TMO])) break; if (sp > XB_SPIN_CAP) { atomicAdd(&bar[XB_TMO], 1u); break; } }
    }
    nloc = mine > 0u ? mine : 1u; nx = cnt > 0u ? cnt : 1u; uni = (bad == 0u && cnt == 8u && sum == G) ? 1u : 0u;
}
__device__ __attribute__((noinline)) void xcd_barrier_impl(unsigned* bbar, unsigned bx, volatile LAS unsigned* bst, bool leader) {
    XcdBarrier b; b.bar = bbar; b.x = bx; b.st = bst;
    asm volatile("s_waitcnt vmcnt(0)" ::: "memory");
    __syncthreads();
    if (leader) {
        unsigned* bar = b.bar;
        __builtin_amdgcn_s_waitcnt(0);
        unsigned nloc = b.st[0], nx = b.st[1];
        if (nloc == 0u) { unsigned uni; xcd_barrier_complete(bar, b.x, nloc, nx, uni); b.st[0] = nloc; b.st[1] = nx; b.st[2] = uni; }
        const unsigned old = xb_add(&bar[XB_XSUB(b.x)], 1u);
        const unsigned gen = old / nloc;
        if (old + 1u == (gen + 1u) * nloc) {
            __builtin_amdgcn_fence(__ATOMIC_RELEASE, "agent");
            asm volatile("s_waitcnt vmcnt(0)" ::: "memory");
            const unsigned og = xb_add(&bar[XB_TOP], 1u);
            const unsigned tg = og / nx;
            if (og + 1u == (tg + 1u) * nx) xb_add(&bar[XB_TOPGEN], 1u);
            else XB_SPIN(xb_ld(&bar[XB_TOPGEN]) == tg, bar);
            __builtin_amdgcn_fence(__ATOMIC_ACQUIRE, "agent");
            xb_add(&bar[XB_XGEN(b.x)], 1u);
            asm volatile("s_waitcnt vmcnt(0)" ::: "memory");
        } else {
            XB_SPIN(xb_ld(&bar[XB_XGEN(b.x)]) == gen, bar);
            __builtin_amdgcn_fence(__ATOMIC_ACQUIRE, "agent");
            asm volatile("s_waitcnt vmcnt(0)" ::: "memory");
        }
    }
    __syncthreads();
}

__device__ __forceinline__ void xcd_barrier(const XcdBarrier& b) { xcd_barrier_impl(b.bar, b.x, b.st, otid() == 0); }
__device__ __attribute__((noinline)) void xcd_local_impl(unsigned* bar, unsigned x, volatile LAS unsigned* st, bool leader) {
    asm volatile("s_waitcnt vmcnt(0)" ::: "memory");
    __syncthreads();
    if (leader) {
        __builtin_amdgcn_s_waitcnt(0);
        const unsigned nloc = st[0];
        const unsigned old = xb_add(&bar[XB_LCNT(x)], 1u);
        const unsigned gen = old / nloc;
        if (old + 1u == (gen + 1u) * nloc) xb_add(&bar[XB_LGEN(x)], 1u);
        else XB_SPIN(xb_ld(&bar[XB_LGEN(x)]) == gen, bar);
        __builtin_amdgcn_fence(__ATOMIC_ACQUIRE, "agent");
        asm volatile("s_waitcnt vmcnt(0)" ::: "memory");
    }
    __syncthreads();
}
__device__ __forceinline__ void xcd_local_barrier(const XcdBarrier& b) { xcd_local_impl(b.bar, b.x, b.st, otid() == 0); }

struct Params {
    const float* in[33]; float* out; unsigned char* ws;
    float lam_init[2];
    unsigned char bucket[128];
};
__device__ __forceinline__ void transpose_item(const float* W, int N, int k0, int n0, bf16* WT, int KT, int orow0, const float* gain, float scale, LAS float* scr, int lane) {
    float wv[32];
#pragma unroll
    for (int i = 0; i < 32; ++i) wv[i] = ((const GAS float*)W)[(size_t)(k0 + 2 * i + (lane >> 5)) * N + n0 + (lane & 31)];
#pragma unroll
    for (int i = 0; i < 32; ++i) scr[(2 * i + (lane >> 5)) * 33 + (lane & 31)] = wv[i];
    LDS_WAIT(); asm volatile("" ::: "memory");
    const int c = lane & 7;
    float g[8];
#pragma unroll
    for (int j = 0; j < 8; ++j) g[j] = (gain ? ((const GAS float*)gain)[k0 + 8 * c + j] : 1.0f) * scale;
#pragma unroll
    for (int j = 0; j < 4; ++j) { const int n = (lane >> 3) + 8 * j; const LAS float* s = scr + (8 * c) * 33 + n;
        v4u o; o.x = pk2(s[0 * 33] * g[0], s[1 * 33] * g[1]); o.y = pk2(s[2 * 33] * g[2], s[3 * 33] * g[3]); o.z = pk2(s[4 * 33] * g[4], s[5 * 33] * g[5]); o.w = pk2(s[6 * 33] * g[6], s[7 * 33] * g[7]);
        *(GAS v4u*)(WT + (size_t)(orow0 + n) * KT + k0 + 8 * c) = o; }
    LDS_WAIT(); asm volatile("" ::: "memory");
}
__device__ __forceinline__ void convert_matrix(const float* W, int K, int N, bf16* WT, const float* gain, float scale_lo, int n_lo, int gw, int NGW, LAS float* scr, int lane, int glu_lo = 0) {
    const int nblk = N / 32, nit = (K / 64) * nblk;
    for (int it = gw; it < nit; it += NGW) { const int kb = it / nblk, nb = it % nblk; int orow0 = 32 * nb;
        if (glu_lo > 0 && orow0 >= glu_lo) { const int s_ = orow0 - glu_lo, c_ = s_ & 511; orow0 = glu_lo + (c_ >> 7) * 256 + (s_ >> 9) * 128 + (c_ & 127); }
        transpose_item(W, N, 64 * kb, 32 * nb, WT, K, orow0, gain, (32 * nb < n_lo) ? scale_lo : 1.0f, scr, lane); }
}
__device__ __forceinline__ void convert_moe(const float* w1, const float* w3, const float* w2, bf16* w13t, bf16* w2t, const float* gain, int gw, int NGW, LAS float* scr, int lane) {
    for (int it = gw; it < 3 * 4096; it += NGW) {
        const int which = it >> 12, r = it & 4095, e = r >> 8, q = r & 255;
        if (which < 2) { const int kb = q >> 4, nb = q & 15, n0 = 32 * nb;
            const float* W = (which == 0 ? w1 : w3) + (size_t)e * 1024 * 512;
            const int orow0 = e * 1024 + (n0 >> 7) * 256 + which * 128 + (n0 & 127);
            transpose_item(W, 512, 64 * kb, n0, w13t, 1024, orow0, gain, 1.0f, scr, lane);
        } else { const int kb = q >> 5, nb = q & 31;
            transpose_item(w2 + (size_t)e * 512 * 1024, 1024, 64 * kb, 32 * nb, w2t, 512, e * 1024 + 32 * nb, nullptr, 1.0f, scr, lane); }
    }
}
__device__ __forceinline__ void rows4_to_xb(const float* x, bf16* xbp, float* ss, int m0, int mstride, int lane) {
    f32x4 v[4][4];
#pragma unroll
    for (int q = 0; q < 4; ++q) { const GAS f32x4* xr = (const GAS f32x4*)(x + (size_t)(m0 + q * mstride) * 1024) + lane;
#pragma unroll
        for (int j = 0; j < 4; ++j) v[q][j] = xr[64 * j]; }
#pragma unroll
    for (int q = 0; q < 4; ++q) { float s = 0.f;
#pragma unroll
        for (int j = 0; j < 4; ++j) s += (v[q][j].x * v[q][j].x + v[q][j].y * v[q][j].y) + (v[q][j].z * v[q][j].z + v[q][j].w * v[q][j].w);
        s = wave_sum(s);
        GAS unsigned long long* o8 = (GAS unsigned long long*)(xbp + (size_t)(m0 + q * mstride) * 1024) + lane;
#pragma unroll
        for (int j = 0; j < 4; ++j) o8[64 * j] = (unsigned long long)pk2(v[q][j].x, v[q][j].y) | ((unsigned long long)pk2(v[q][j].z, v[q][j].w) << 32);
        if (lane < 16) ss[(size_t)(m0 + q * mstride) * 16 + lane] = (lane == 0) ? s : 0.f; }
}
__device__ __forceinline__ void row_norm_bf16(const float* xrow, const float* g, bf16* orow, int lane) {
    const GAS f32x4* xr = (const GAS f32x4*)xrow + lane; const GAS f32x4* gr = (const GAS f32x4*)g + lane;
    f32x4 v[4]; float s = 0.f;
#pragma unroll
    for (int j = 0; j < 4; ++j) { v[j] = xr[64 * j]; s += (v[j].x * v[j].x + v[j].y * v[j].y) + (v[j].z * v[j].z + v[j].w * v[j].w); }
    const float rr = __builtin_amdgcn_rsqf(wave_sum(s) * (1.0f / 1024.0f) + EPS);
    GAS unsigned long long* o8 = (GAS unsigned long long*)orow + lane;
#pragma unroll
    for (int j = 0; j < 4; ++j) { const f32x4 gg = gr[64 * j]; o8[64 * j] = (unsigned long long)pk2(v[j].x * rr * gg.x, v[j].y * rr * gg.y) | ((unsigned long long)pk2(v[j].z * rr * gg.z, v[j].w * rr * gg.w) << 32); }
}
__device__ __forceinline__ void rows4_final(const bf16* xbp, float* out, const float* ss, const f32x4 (&gg)[4], int m0, int mstride, int lane) {
    v2u w[4][4]; float rr[4];
#pragma unroll
    for (int q = 0; q < 4; ++q) { const GAS v2u* xr = (const GAS v2u*)(xbp + (size_t)(m0 + q * mstride) * 1024) + lane;
#pragma unroll
        for (int j = 0; j < 4; ++j) w[q][j] = xr[64 * j];
        rr[q] = pg8::row_rs(ss, m0 + q * mstride); }
#pragma unroll
    for (int q = 0; q < 4; ++q) { GAS f32x4* orr = (GAS f32x4*)(out + (size_t)(m0 + q * mstride) * 1024) + lane;
#pragma unroll
        for (int j = 0; j < 4; ++j) { f32x4 v; v.x = bflo(w[q][j].x) * rr[q] * gg[j].x; v.y = bfhi(w[q][j].x) * rr[q] * gg[j].y; v.z = bflo(w[q][j].y) * rr[q] * gg[j].z; v.w = bfhi(w[q][j].y) * rr[q] * gg[j].w; orr[64 * j] = v; } }
}

constexpr int HA_FS = 132, HA_Q = 0, HA_KK = 33792, HA_BL = 67584, HA_TOT = 101376, HA_KI = 103424, HA_VI = 123904, HA_AM = 144384, HA_END = 153600, HA_BS = 72, HA_IS = 160;
typedef short v4i16_t __attribute__((ext_vector_type(4)));
__device__ __forceinline__ bf16x8 tr_frag(const LAS bf16* img, int s0, int x0, int lane) {
    const LAS bf16* p = img + (s0 + ((lane & 15) >> 2)) * HA_IS + x0 + 16 * ((lane >> 4) & 1) + 4 * (lane & 3);
    const s16x4 lo = __builtin_bit_cast(s16x4, __builtin_amdgcn_ds_read_tr16_b64_v4i16((LAS v4i16_t*)p));
    const s16x4 hh = __builtin_bit_cast(s16x4, __builtin_amdgcn_ds_read_tr16_b64_v4i16((LAS v4i16_t*)(p + 4 * HA_IS)));
    return __builtin_shufflevector(lo, hh, 0, 1, 2, 3, 4, 5, 6, 7);
}
constexpr int HA_TAB = HA_END;
__device__ __forceinline__ void hgrn_phaseA(LAS unsigned char* lds, int first, int G, bf16* proj, bf16* mix, float* dch, const float* hgrn_lb, int j_even, bool xm) {
#define HG_XM(u_) (xm ? (512 * ((u_) & 7) + ((u_) >> 3)) : (u_))
    const int tid = otid(), lane = tid & 63, wid = __builtin_amdgcn_readfirstlane(tid >> 6);
    LAS float* Q = (LAS float*)(lds + HA_Q); LAS float* KK = (LAS float*)(lds + HA_KK); LAS float* BL = (LAS float*)(lds + HA_BL); LAS float* TOT = (LAS float*)(lds + HA_TOT); LAS float* TAB = (LAS float*)(lds + HA_TAB);
    LAS bf16* KI = (LAS bf16*)(lds + HA_KI); LAS bf16* VI = (LAS bf16*)(lds + HA_VI); LAS bf16* AM = (LAS bf16*)(lds + HA_AM);
    const int row = tid >> 3, cg = tid & 7, k0 = cg * 16;
    v4u zq0, zq1, zf0, zf1, zi0, zi1;
#define HA_LOAD(uv) do { const int uu = HG_XM(uv); const int b_ = (uu) >> 8, h_ = ((uu) >> 6) & 3, c_ = (uu) & 63; const bf16* pr_ = proj + ((size_t)b_ * SEQ + c_ * 64 + row) * 3072 + h_ * 128 + k0; \
        zq0 = *(const GAS v4u*)(pr_); zq1 = *(const GAS v4u*)(pr_ + 8); zf0 = *(const GAS v4u*)(pr_ + 512); zf1 = *(const GAS v4u*)(pr_ + 520); zi0 = *(const GAS v4u*)(pr_ + 1024); zi1 = *(const GAS v4u*)(pr_ + 1032); } while (0)
    if (first < 4096) HA_LOAD(first);
    float lbv[16]; int hprev = -1;
#pragma unroll
    for (int e = 0; e < 16; ++e) lbv[e] = 0.f;
    for (int uv = first; uv < 4096; uv += G) { const int u = HG_XM(uv);
        const int b = u >> 8, h = (u >> 6) & 3, c = u & 63; const size_t t0 = (size_t)b * SEQ + c * 64;
        {
            const unsigned zq[8] = {zq0.x, zq0.y, zq0.z, zq0.w, zq1.x, zq1.y, zq1.z, zq1.w};
            const unsigned zf[8] = {zf0.x, zf0.y, zf0.z, zf0.w, zf1.x, zf1.y, zf1.z, zf1.w};
            *(LAS v4u*)(VI + row * HA_IS + k0) = zi0; *(LAS v4u*)(VI + row * HA_IS + k0 + 8) = zi1;
            if (h != hprev) { hprev = h;
                const GAS f32x4* l0 = (const GAS f32x4*)(hgrn_lb + h * 128 + k0); const GAS f32x4* l1 = (const GAS f32x4*)(hgrn_lb + 512 + h * 128 + k0);
#pragma unroll
                for (int q4 = 0; q4 < 4; ++q4) { const f32x4 a = l0[q4], bq = l1[q4];
#pragma unroll
                    for (int e = 0; e < 4; ++e) lbv[4 * q4 + e] = (j_even == 1) ? sigmoidf_(bq[e] - a[e]) : 0.f; } }
#pragma unroll
            for (int q4 = 0; q4 < 4; ++q4) { f32x4 qv, kv, lv;
#pragma unroll
                for (int e = 0; e < 4; ++e) { const int jj = 4 * q4 + e; const unsigned wq = zq[jj >> 1], wf = zf[jj >> 1];
                    const float q_ = (jj & 1) ? bfhi(wq) : bflo(wq), f_ = (jj & 1) ? bfhi(wf) : bflo(wf);
                    const float lb = lbv[jj];
                    const float f = lb + (1.0f - lb) * sigmoidf_(f_);
                    qv[e] = q_ * sigmoidf_(q_); kv[e] = 1.0f - f; lv[e] = __logf(fmaxf(f, 1e-30f)); }
                *(LAS f32x4*)(Q + row * HA_FS + k0 + 4 * q4) = qv; *(LAS f32x4*)(KK + row * HA_FS + k0 + 4 * q4) = kv; *(LAS f32x4*)(BL + row * HA_FS + k0 + 4 * q4) = lv; }
        }
        if (uv + G < 4096) HA_LOAD(uv + G);
        __syncthreads();
        { const int k = tid & 127, sub = tid >> 7; float run = 0.f;
#pragma unroll
          for (int j = 0; j < 16; ++j) { const int rw = 16 * sub + j; run += BL[rw * HA_FS + k]; BL[rw * HA_FS + k] = run; }
          TOT[sub * 128 + k] = run; }
        __syncthreads();
        {
#pragma unroll
            for (int q4 = 0; q4 < 4; ++q4) { const f32x4 bl = *(const LAS f32x4*)(BL + row * HA_FS + k0 + 4 * q4); f32x4 qv = *(const LAS f32x4*)(Q + row * HA_FS + k0 + 4 * q4), kv = *(const LAS f32x4*)(KK + row * HA_FS + k0 + 4 * q4);
#pragma unroll
                for (int e = 0; e < 4; ++e) { qv[e] *= __expf(bl[e]); kv[e] *= __expf(fminf(-bl[e], 80.0f)); }
                *(LAS f32x4*)(Q + row * HA_FS + k0 + 4 * q4) = qv; *(LAS f32x4*)(KK + row * HA_FS + k0 + 4 * q4) = kv; }
            for (int e = tid; e < 1280; e += NTHR) { const int w = e >> 7, k = e & 127; const float t0_ = TOT[k], t1_ = TOT[128 + k], t2_ = TOT[256 + k], t3_ = TOT[384 + k];
                const float x = (w == 0) ? t0_ : (w == 1) ? t1_ : (w == 2) ? t2_ : (w == 3) ? t3_ : (w == 4) ? t1_ + t2_ : (w == 5) ? t0_ + t1_ : (w == 6) ? (t0_ + t1_) + t2_ : (w == 7) ? (t0_ + t1_) + (t2_ + t3_) : (w == 8) ? t1_ + (t2_ + t3_) : t2_ + t3_;
                TAB[e] = __expf(x); }
        }
        __syncthreads();
        for (int task = wid; task < 10; task += 8) {
            int it, is; int ga = -1;
            if (task < 4) { it = task; is = task; }
            else { const int pq = task - 4; it = (pq == 0) ? 1 : (pq <= 2 ? 2 : 3); is = (pq == 0) ? 0 : (pq == 1 ? 0 : (pq == 2 ? 1 : pq - 3));
                   ga = (it - is == 1) ? -1 : (it == 2 ? 1 : (is == 1 ? 2 : 4)); }
            const int r = lane & 15, quad = lane >> 4; f32x4 acc = {0.f, 0.f, 0.f, 0.f};
#pragma unroll
            for (int ks = 0; ks < 4; ++ks) { unsigned pa[4], pb[4]; const int kb = 32 * ks + 8 * quad;
#pragma unroll
                for (int q4 = 0; q4 < 2; ++q4) { f32x4 qv = *(const LAS f32x4*)(Q + (16 * it + r) * HA_FS + kb + 4 * q4), kv = *(const LAS f32x4*)(KK + (16 * is + r) * HA_FS + kb + 4 * q4);
                    if (task >= 4) { kv *= *(const LAS f32x4*)(TAB + is * 128 + kb + 4 * q4); if (ga >= 0) qv *= *(const LAS f32x4*)(TAB + ga * 128 + kb + 4 * q4); }
                    pa[2 * q4] = pk2(qv[0], qv[1]); pa[2 * q4 + 1] = pk2(qv[2], qv[3]); pb[2 * q4] = pk2(kv[0], kv[1]); pb[2 * q4 + 1] = pk2(kv[2], kv[3]); }
                const v4u va = {pa[0], pa[1], pa[2], pa[3]}, vb = {pb[0], pb[1], pb[2], pb[3]};
                acc = MFMA16(__builtin_bit_cast(bf16x8, va), __builtin_bit_cast(bf16x8, vb), acc); }
#pragma unroll
            for (int j = 0; j < 4; ++j) { const int tl = 4 * quad + j;
                if (task < 4) AM[(16 * it + tl) * HA_BS + 16 * is + r] = (r <= tl) ? (bf16)f2bf(acc[j]) : (bf16)0;
                else { AM[(16 * it + tl) * HA_BS + 16 * is + r] = (bf16)f2bf(acc[j]); AM[(16 * is + tl) * HA_BS + 16 * it + r] = (bf16)0; } }
        }
        {
            const int sc = row >> 4; unsigned qo[8], ko[8];
#pragma unroll
            for (int q4 = 0; q4 < 4; ++q4) { f32x4 qv = *(const LAS f32x4*)(Q + row * HA_FS + k0 + 4 * q4), kv = *(const LAS f32x4*)(KK + row * HA_FS + k0 + 4 * q4);
                if (sc > 0) qv *= *(const LAS f32x4*)(TAB + ((sc == 1) ? 0 : (sc == 2) ? 5 : 6) * 128 + k0 + 4 * q4);
                kv *= *(const LAS f32x4*)(TAB + ((sc == 0) ? 7 : (sc == 1) ? 8 : (sc == 2) ? 9 : 3) * 128 + k0 + 4 * q4);
                qo[2 * q4] = pk2(qv[0], qv[1]); qo[2 * q4 + 1] = pk2(qv[2], qv[3]); ko[2 * q4] = pk2(kv[0], kv[1]); ko[2 * q4 + 1] = pk2(kv[2], kv[3]); }
            bf16* pq = proj + (t0 + row) * 3072 + h * 128 + k0;
            *(GAS v4u*)(pq) = (v4u){qo[0], qo[1], qo[2], qo[3]}; *(GAS v4u*)(pq + 8) = (v4u){qo[4], qo[5], qo[6], qo[7]};
            *(LAS v4u*)(KI + row * HA_IS + k0) = (v4u){ko[0], ko[1], ko[2], ko[3]}; *(LAS v4u*)(KI + row * HA_IS + k0 + 8) = (v4u){ko[4], ko[5], ko[6], ko[7]};
            if (tid < 128) dch[(size_t)u * 128 + tid] = TAB[7 * 128 + tid];
        }
        __syncthreads();
        { const int r = lane & 31, hi = lane >> 5, tm = wid >> 2, tn = wid & 3; f32x16 acc = {};
#pragma unroll
          for (int ks = 0; ks < 4; ++ks) { const bf16x8 a = tr_frag(VI, 16 * ks + 8 * hi, 32 * tn, lane); const bf16x8 bb = *(const LAS bf16x8*)(AM + (32 * tm + r) * HA_BS + 16 * ks + 8 * hi); acc = MFMA32(a, bb, acc); }
          bf16* po = mix + (t0 + 32 * tm + r) * 1024 + h * 128 + 32 * tn + 4 * hi;
#pragma unroll
          for (int g4 = 0; g4 < 4; ++g4) { v2u w; w.x = pk2(acc[4 * g4], acc[4 * g4 + 1]); w.y = pk2(acc[4 * g4 + 2], acc[4 * g4 + 3]); *(GAS v2u*)(po + 8 * g4) = w; }
        }
        { const int r = lane & 31, hi = lane >> 5, tk = wid >> 1;
#pragma unroll
          for (int tv2 = 0; tv2 < 2; ++tv2) { const int tv = 2 * (wid & 1) + tv2; f32x16 acc = {};
#pragma unroll
              for (int ks = 0; ks < 4; ++ks) { const bf16x8 a = tr_frag(KI, 16 * ks + 8 * hi, 32 * tk, lane); const bf16x8 bb = tr_frag(VI, 16 * ks + 8 * hi, 32 * tv, lane); acc = MFMA32(a, bb, acc); }
              const int v = 32 * tv + r;
              bf16* pu = proj + (t0 + (v & 63)) * 3072 + (v < 64 ? 512 : 1024) + h * 128 + 32 * tk + 4 * hi;
#pragma unroll
              for (int g4 = 0; g4 < 4; ++g4) { v2u w; w.x = pk2(acc[4 * g4], acc[4 * g4 + 1]); w.y = pk2(acc[4 * g4 + 2], acc[4 * g4 + 3]); *(GAS v2u*)(pu + 8 * g4) = w; } }
        }
        __syncthreads();
    }
#undef HA_LOAD
}

__device__ __forceinline__ void hgrn_phaseB(bf16* proj, const float* dch, int G, int slot, bool xm) {
    const int tid = otid();
    for (int wv_ = slot; wv_ < 256; wv_ += G) { const int w_ = xm ? (32 * (wv_ & 7) + (wv_ >> 3)) : wv_; const int rid = w_ * 32 + (tid >> 4);
        const int bh = rid >> 7, v = rid & 127, b = bh >> 2, h = bh & 3, ks = (tid & 15) * 8;
        bf16* base = proj + ((size_t)b * SEQ + (v & 63)) * 3072 + (v < 64 ? 512 : 1024) + h * 128 + ks;
        const float* dbase = dch + (size_t)bh * 64 * 128 + ks;
        float st[8];
#pragma unroll
        for (int j = 0; j < 8; ++j) st[j] = 0.f;
        v4u ub[8]; f32x4 d0[8], d1[8];
#pragma unroll
        for (int j = 0; j < 8; ++j) { ub[j] = *(const GAS v4u*)(base + (size_t)j * 64 * 3072); d0[j] = *(const GAS f32x4*)(dbase + j * 128); d1[j] = *(const GAS f32x4*)(dbase + j * 128 + 4); }
        for (int c0 = 0; c0 < 64; c0 += 8) {
#pragma unroll
            for (int j = 0; j < 8; ++j) { const int c = c0 + j; bf16* p = base + (size_t)c * 64 * 3072;
                const v4u uu = ub[j]; const f32x4 da = d0[j], db = d1[j];
                v4u so; so.x = pk2(st[0], st[1]); so.y = pk2(st[2], st[3]); so.z = pk2(st[4], st[5]); so.w = pk2(st[6], st[7]);
                *(GAS v4u*)p = so;
                st[0] = da[0] * st[0] + bflo(uu.x); st[1] = da[1] * st[1] + bfhi(uu.x); st[2] = da[2] * st[2] + bflo(uu.y); st[3] = da[3] * st[3] + bfhi(uu.y);
                st[4] = db[0] * st[4] + bflo(uu.z); st[5] = db[1] * st[5] + bfhi(uu.z); st[6] = db[2] * st[6] + bflo(uu.w); st[7] = db[3] * st[7] + bfhi(uu.w);
                if (c + 8 < 64) { ub[j] = *(const GAS v4u*)(base + (size_t)(c + 8) * 64 * 3072); d0[j] = *(const GAS f32x4*)(dbase + (c + 8) * 128); d1[j] = *(const GAS f32x4*)(dbase + (c + 8) * 128 + 4); } }
        }
    }
}

__device__ __forceinline__ void hgrn_phaseC(LAS unsigned char* lds, int first, int G, const bf16* proj, bf16* mix, const float* gnorm, bool xm) {
    const int tid = otid(), lane = tid & 63, wid = __builtin_amdgcn_readfirstlane(tid >> 6);
    LAS float* OF = (LAS float*)lds;
    constexpr int CI = 136; LAS bf16* SI = (LAS bf16*)(lds + 64 * 132 * 4); LAS bf16* QI = SI + 128 * CI;
    const int r = lane & 31, hi = lane >> 5, tm = wid >> 2, tn = wid & 3;
    const int row = tid >> 3, cg = tid & 7, v0 = cg * 16;
    const int crow_ = tid >> 4, ckc = tid & 15;
    v4u sc[4], qc[2]; v2u ol[4]; v4u g0, g1;
#define HC_LOAD(uv) do { const int uu = HG_XM(uv); const int b_ = (uu) >> 8, h_ = ((uu) >> 6) & 3, c_ = (uu) & 63; const size_t t0_ = (size_t)b_ * SEQ + c_ * 64; \
        _Pragma("unroll") for (int j = 0; j < 4; ++j) { const int v_ = crow_ + 32 * j; sc[j] = *(const GAS v4u*)(proj + (t0_ + (v_ & 63)) * 3072 + (v_ < 64 ? 512 : 1024) + h_ * 128 + 8 * ckc); } \
        _Pragma("unroll") for (int j = 0; j < 2; ++j) qc[j] = *(const GAS v4u*)(proj + (t0_ + crow_ + 32 * j) * 3072 + h_ * 128 + 8 * ckc); \
        const bf16* pl_ = mix + (t0_ + 32 * tm + r) * 1024 + h_ * 128 + 32 * tn + 4 * hi; _Pragma("unroll") for (int g4 = 0; g4 < 4; ++g4) ol[g4] = *(const GAS v2u*)(pl_ + 8 * g4); \
        const bf16* pg_ = proj + (t0_ + row) * 3072 + 1536 + h_ * 128 + v0; g0 = *(const GAS v4u*)pg_; g1 = *(const GAS v4u*)(pg_ + 8); } while (0)
    if (first < 4096) HC_LOAD(first);
    float gn[16];
#pragma unroll
    for (int j = 0; j < 16; ++j) gn[j] = gnorm[v0 + j];
    for (int uv = first; uv < 4096; uv += G) { const int u = HG_XM(uv);
        const int b = u >> 8, h = (u >> 6) & 3, c = u & 63; const size_t t0 = (size_t)b * SEQ + c * 64;
#pragma unroll
        for (int j = 0; j < 4; ++j) *(LAS v4u*)(SI + (crow_ + 32 * j) * CI + 8 * ckc) = sc[j];
#pragma unroll
        for (int j = 0; j < 2; ++j) *(LAS v4u*)(QI + (crow_ + 32 * j) * CI + 8 * ckc) = qc[j];
        __syncthreads();
        { f32x16 acc = {}; bf16x8 af[8], bfr[8];
#pragma unroll
          for (int ks = 0; ks < 8; ++ks) { af[ks] = *(const LAS bf16x8*)(SI + (32 * tn + r) * CI + 16 * ks + 8 * hi); bfr[ks] = *(const LAS bf16x8*)(QI + (32 * tm + r) * CI + 16 * ks + 8 * hi); }
#pragma unroll
          for (int ks = 0; ks < 8; ++ks) acc = MFMA32(af[ks], bfr[ks], acc);
#pragma unroll
          for (int g4 = 0; g4 < 4; ++g4) { const v2u w = ol[g4];
              f32x4 o; o[0] = acc[4 * g4] + bflo(w.x); o[1] = acc[4 * g4 + 1] + bfhi(w.x); o[2] = acc[4 * g4 + 2] + bflo(w.y); o[3] = acc[4 * g4 + 3] + bfhi(w.y);
              *(LAS f32x4*)(OF + (32 * tm + r) * 132 + 32 * tn + 8 * g4 + 4 * hi) = o; }
        }
        const unsigned zg[8] = {g0.x, g0.y, g0.z, g0.w, g1.x, g1.y, g1.z, g1.w};
        if (uv + G < 4096) HC_LOAD(uv + G);
        __syncthreads();
        { float o[16]; float s2 = 0.f;
#pragma unroll
          for (int j = 0; j < 4; ++j) { const f32x4 x = *(const LAS f32x4*)(OF + row * 132 + v0 + 4 * j); o[4 * j] = x[0]; o[4 * j + 1] = x[1]; o[4 * j + 2] = x[2]; o[4 * j + 3] = x[3]; s2 += (x[0] * x[0] + x[1] * x[1]) + (x[2] * x[2] + x[3] * x[3]); }
          s2 += xor_lt32<1>(s2); s2 += xor_lt32<2>(s2); s2 += xor_lt32<4>(s2);
          const float rr = __builtin_amdgcn_rsqf(s2 * (1.0f / 128.0f) + EPS);
          unsigned w[8];
#pragma unroll
          for (int p = 0; p < 8; ++p) { const float a = o[2 * p] * rr * gn[2 * p] * sigmoidf_(bflo(zg[p])); const float bq = o[2 * p + 1] * rr * gn[2 * p + 1] * sigmoidf_(bfhi(zg[p])); w[p] = pk2(a, bq); }
          bf16* po = mix + (t0 + row) * 1024 + h * 128 + v0;
          *(GAS v4u*)po = (v4u){w[0], w[1], w[2], w[3]}; *(GAS v4u*)(po + 8) = (v4u){w[4], w[5], w[6], w[7]};
        }
        __syncthreads();
    }
#undef HC_LOAD
}

constexpr int CV_R = 64;
__device__ __forceinline__ void conv_unit(LAS unsigned char* lds, int u, const bf16* proj, bf16* mix, const float* dw, const float* db, const float* lng, const float* lnb) {
    const int tid = otid(), lane = tid & 63, wid = __builtin_amdgcn_readfirstlane(tid >> 6);
    constexpr int UPS = SEQ / CV_R;
    const int b = u / UPS, tb = u % UPS, ch = tid;
    LAS float* CB = (LAS float*)lds;
    LAS float* STAT = (LAS float*)(lds + CV_R * 516 * 4);
    float uu[CV_R + 30];
#pragma unroll
    for (int j = 0; j < CV_R + 30; ++j) { const int tt = tb * CV_R - 30 + j; float val = 0.f;
        { const int tc = tt < 0 ? 0 : tt; const GAS bf16* p = (const GAS bf16*)(proj + ((size_t)b * SEQ + tc) * 3072 + 2048 + ch); val = bf2f(p[0]); }
        uu[j] = (tt >= 0) ? val : 0.f; }
    float w[31];
#pragma unroll
    for (int j = 0; j < 31; ++j) w[j] = ((const GAS float*)dw)[j * 512 + ch];
    const float bias = db[ch];
    float cv[CV_R];
#pragma unroll
    for (int i = 0; i < CV_R; ++i) { float a = bias;
#pragma unroll
        for (int j = 0; j < 31; ++j) a += w[j] * uu[i + j];
        cv[i] = a; CB[i * 516 + ch] = a; }
    __syncthreads();
#pragma unroll
    for (int rr = 0; rr < CV_R / 8; ++rr) { const int row = wid * (CV_R / 8) + rr; float s = 0.f; float x[8];
#pragma unroll
        for (int j = 0; j < 8; ++j) { x[j] = CB[row * 516 + lane + 64 * j]; s += x[j]; }
        const float mean = wave_sum(s) * (1.0f / 512.0f); float q = 0.f;
#pragma unroll
        for (int j = 0; j < 8; ++j) { const float d = x[j] - mean; q += d * d; }
        const float var = wave_sum(q) * (1.0f / 512.0f);
        if (lane == 0) { STAT[row * 2] = mean; STAT[row * 2 + 1] = __builtin_amdgcn_rsqf(var + EPS); } }
    __syncthreads();
    const float g = lng[ch], bb = lnb[ch];
#pragma unroll
    for (int i = 0; i < CV_R; ++i) { const float y = (cv[i] - STAT[i * 2]) * STAT[i * 2 + 1] * g + bb; ((GAS bf16*)mix)[((size_t)b * SEQ + tb * CV_R + i) * 1024 + 512 + ch] = (bf16)f2bf(y * sigmoidf_(y)); }
    __syncthreads();
}

__device__ __forceinline__ void router_tile256(LAS unsigned char* lds, int tile, const bf16* xb, const float* ss, const bf16* wr, const float* b_grp, const float* b_exp,
                                               unsigned* route, int* lists, unsigned* gcnt  , bool commit = true) {
    const int tid = otid(), lane = tid & 63, wid = __builtin_amdgcn_readfirstlane(tid >> 6);
    LAS float* LG = (LAS float*)lds + wid * (32 * 33);
    LAS int* LC = (LAS int*)(lds + 8 * 32 * 33 * 4);
    if (tid < 64) LC[tid] = 0;
    __syncthreads();
    const int r = lane & 31, hi = lane >> 5; const int tok0 = tile * 256 + wid * 32;
    f32x16 acc = {};
    const bf16* pa = wr + (size_t)r * 1024 + 8 * hi;
    const bf16* pb = xb + (size_t)(tok0 + r) * 1024 + 8 * hi;
    for (int k0 = 0; k0 < 64; k0 += 16) { bf16x8 av[16], bv[16];
#pragma unroll
        for (int ks = 0; ks < 16; ++ks) { av[ks] = *(const GAS bf16x8*)(pa + 16 * (k0 + ks)); bv[ks] = *(const GAS bf16x8*)(pb + 16 * (k0 + ks)); }
#pragma unroll
        for (int ks = 0; ks < 16; ++ks) acc = MFMA32(av[ks], bv[ks], acc); }
    const float rr = pg8::row_rs(ss, tok0 + r);
#pragma unroll
    for (int i = 0; i < 16; ++i) LG[r * 33 + crow(i, hi)] = acc[i] * rr;
    LDS_WAIT(); asm volatile("" ::: "memory");
    int ea = 0, eb = 0, pa_ = 0, pb_ = 0; float wa = 0.f, wb = 0.f; const int tok = tok0 + r;
    if (hi == 0) {
        float gl[4];
#pragma unroll
        for (int j = 0; j < 4; ++j) gl[j] = LG[r * 33 + j] + b_grp[j];
        int gs = 0; float gm = gl[0];
#pragma unroll
        for (int j = 1; j < 4; ++j) if (gl[j] > gm) { gm = gl[j]; gs = j; }
        float den = 0.f;
#pragma unroll
        for (int j = 0; j < 4; ++j) den += __expf(gl[j] - gm);
        const float gw = __builtin_amdgcn_rcpf(den);
        float el[4];
#pragma unroll
        for (int j = 0; j < 4; ++j) el[j] = LG[r * 33 + 4 + gs * 4 + j] + b_exp[gs * 4 + j];
        int i1 = 0; float v1 = el[0];
#pragma unroll
        for (int j = 1; j < 4; ++j) if (el[j] > v1) { v1 = el[j]; i1 = j; }
        int i2 = -1; float v2 = 0.f;
#pragma unroll
        for (int j = 0; j < 4; ++j) if (j != i1 && (i2 < 0 || el[j] > v2)) { v2 = el[j]; i2 = j; }
        const float e2 = __expf(v2 - v1); { const float ri = __builtin_amdgcn_rcpf(1.0f + e2); wa = gw * ri; wb = gw * e2 * ri; }
        const int plo = i1 < i2 ? i1 : i2, phi = i1 < i2 ? i2 : i1;
        ea = gs * 6 + ((plo * (7 - plo)) >> 1) + (phi - plo - 1); eb = 0;
        const float wlo = (i1 < i2) ? wa : wb, whi = (i1 < i2) ? wb : wa;
        if (commit) pa_ = __hip_atomic_fetch_add(&LC[ea], 1, __ATOMIC_RELAXED, __HIP_MEMORY_SCOPE_WORKGROUP);
        *(GAS v4u*)(route + (size_t)tok * 4) = (v4u){(unsigned)((gs * 4 + plo) | ((gs * 4 + phi) << 8)), pk2(rr, rr * wlo), pk2(rr, rr * whi), __builtin_bit_cast(unsigned, rr)};
    }
    __syncthreads();
    if (tid < 32 && commit) LC[32 + tid] = (int)__hip_atomic_fetch_add(gcnt + 32 * tid, (unsigned)LC[tid], RLX_AGENT);
    __syncthreads();
    if (hi == 0 && commit) lists[(size_t)ea * 65536 + LC[32 + ea] + pa_] = tok;
    __syncthreads();
}
typedef short v4i16_att_t __attribute__((ext_vector_type(4)));
constexpr int ATT_TPS = 1;
template <int KW> struct AttnLdsR {
    static constexpr int KSTR = KW + 8, KBYTES = 64 * KSTR * 2, VBYTES = 64 * 256;
    static constexpr int K0 = 0, V0 = 2 * ATT_TPS * KBYTES, LUT = V0 + 2 * ATT_TPS * VBYTES, END = LUT + 512;
};
template <int KW, int DK, bool CAUSAL, bool PREFETCH>
__device__ __forceinline__ void attn_block_reg(LAS unsigned char* lds, const bf16* Qw  , int qpitch,
                                           const bf16* Kg, int kpitch, const bf16* Vg, int vpitch, int ntiles, int kmapoff, int qpos0  ,
                                           f32x16 (&o)[4], float& m_run, float& l_run) {
    typedef AttnLdsR<KW> L;
    const int tid = otid(), lane = tid & 63, wid = __builtin_amdgcn_readfirstlane(tid >> 6), r = lane & 31, hi = lane >> 5;
    bf16x8 qf[DK / 16];
#pragma unroll
    for (int ks = 0; ks < DK / 16; ++ks) qf[ks] = *(const GAS bf16x8*)(Qw + (size_t)r * qpitch + 16 * ks + 8 * hi);
#pragma unroll
    for (int vt = 0; vt < 4; ++vt) o[vt] = (f32x16){};
    m_run = -1e30f; l_run = 0.f;
    constexpr int KCH = KW / 64;
    const int vkey = tid >> 4, vc = tid & 15;
    v4u kreg[ATT_TPS][KCH], vreg[ATT_TPS][2];
    const LAS float* lut = (const LAS float*)(lds + L::LUT);
    unsigned koff[KCH];
#pragma unroll
    for (int i_ = 0; i_ < KCH; ++i_) { const int c_ = tid + i_ * NTHR, key_ = c_ / (KW / 8), kc_ = c_ % (KW / 8); koff[i_] = (unsigned)(key_ * kpitch + 8 * kc_) * 2u; }
    const unsigned voff0 = (unsigned)(vkey * vpitch + 8 * vc) * 2u, voff1 = voff0 + (unsigned)(32 * vpitch) * 2u;
    const int vst0 = ((vkey >> 3) * 4 + (vc >> 2)) * 512 + (vkey & 7) * 64 + (vc & 3) * 16;
    const int vbase = (4 * hi + ((lane & 15) >> 2)) * 64 + 32 * ((lane >> 4) & 1) + 8 * (lane & 3);
#define ATT_LOADK(t, sl) do { const char* kt_ = (const char*)Kg + (size_t)(t) * 64 * kpitch * 2; _Pragma("unroll") for (int i_ = 0; i_ < KCH; ++i_) kreg[sl][i_] = *(const GAS v4u*)(kt_ + koff[i_]); } while (0)
#define ATT_LOADV(t, sl) do { const char* vt2_ = (const char*)Vg + (size_t)(t) * 64 * vpitch * 2; vreg[sl][0] = *(const GAS v4u*)(vt2_ + voff0); vreg[sl][1] = *(const GAS v4u*)(vt2_ + voff1); } while (0)
#define ATT_STORE(buf, sl) do { _Pragma("unroll") for (int i_ = 0; i_ < KCH; ++i_) { const int c_ = tid + i_ * NTHR, key_ = c_ / (KW / 8), kc_ = c_ % (KW / 8); \
        *(LAS v4u*)(lds + L::K0 + (buf) * L::KBYTES + (key_ * L::KSTR + 8 * kc_) * 2) = kreg[sl][i_]; } \
        { LAS unsigned char* vt_ = lds + L::V0 + (buf) * L::VBYTES + vst0; *(LAS v4u*)vt_ = vreg[sl][0]; *(LAS v4u*)(vt_ + 8192) = vreg[sl][1]; } } while (0)
#pragma unroll
    for (int j_ = 0; j_ < ATT_TPS; ++j_) { ATT_LOADK(j_, j_); ATT_LOADV(j_, j_); }
#pragma unroll
    for (int j_ = 0; j_ < ATT_TPS; ++j_) ATT_STORE(j_, j_);
    __syncthreads();
    const int nsteps = ntiles / ATT_TPS;
    for (int st = 0; st < nsteps; ++st) {
        const int cur = st & 1;
        if (st + 1 < nsteps) {
#pragma unroll
            for (int j_ = 0; j_ < ATT_TPS; ++j_) { ATT_LOADK(ATT_TPS * (st + 1) + j_, j_); ATT_LOADV(ATT_TPS * (st + 1) + j_, j_); } }
#pragma unroll
        for (int sub = 0; sub < ATT_TPS; ++sub) {
        const int t = ATT_TPS * st + sub, buf = cur * ATT_TPS + sub;
        const bool active = !CAUSAL || (64 * t <= qpos0 + 31);
        if (active) {
            const LAS unsigned char* kb = lds + L::K0 + buf * L::KBYTES;
            const LAS unsigned char* vb = lds + L::V0 + buf * L::VBYTES;
            f32x16 s0 = {}, s1 = {};
            {
                constexpr int NG = DK / 64;
                const LAS unsigned char* ka0 = kb + ((r) * L::KSTR + kmapoff + 8 * hi) * 2;
                const LAS unsigned char* ka1 = ka0 + 32 * L::KSTR * 2;
                bf16x8 kf[2][8];
#pragma unroll
                for (int j = 0; j < 4; ++j) { kf[0][2 * j] = *(const LAS bf16x8*)(ka0 + 32 * j); kf[0][2 * j + 1] = *(const LAS bf16x8*)(ka1 + 32 * j); }
#pragma unroll
                for (int g = 0; g < NG; ++g) {
                    if (g + 1 < NG) {
#pragma unroll
                        for (int j = 0; j < 4; ++j) { kf[(g + 1) & 1][2 * j] = *(const LAS bf16x8*)(ka0 + 128 * (g + 1) + 32 * j); kf[(g + 1) & 1][2 * j + 1] = *(const LAS bf16x8*)(ka1 + 128 * (g + 1) + 32 * j); }
                    }
#pragma unroll
                    for (int j = 0; j < 4; ++j) { s0 = MFMA32(kf[g & 1][2 * j], qf[4 * g + j], s0); s1 = MFMA32(kf[g & 1][2 * j + 1], qf[4 * g + j], s1); }
                    __builtin_amdgcn_sched_barrier(0);
                }
            }
            if (CAUSAL && (qpos0 - (64 * t + 63) < 128)) {
                const int qp = qpos0 + r;
#pragma unroll
                for (int i = 0; i < 16; ++i) { const int n0 = qp - (64 * t + crow(i, hi)), n1 = n0 - 32;
                    const float b0 = lut[min(max(n0, 0), 127)], b1 = lut[min(max(n1, 0), 127)];
                    s0[i] = (n0 < 0) ? -1e30f : s0[i] + b0;
                    s1[i] = (n1 < 0) ? -1e30f : s1[i] + b1; }
            }
            float mx = fmaxf(s0[0], s1[0]);
#pragma unroll
            for (int i = 1; i < 16; ++i) mx = __builtin_fmaxf(__builtin_fmaxf(mx, s0[i]), s1[i]);
            mx = fmaxf(mx, __shfl_xor(mx, 32));
            const float mnc = fmaxf(m_run, mx);
            const bool resc = __any(mnc > m_run + 8.0f);
            const float mn = resc ? mnc : m_run;
            float ps = 0.f;
#pragma unroll
            for (int i = 0; i < 16; ++i) { s0[i] = __builtin_amdgcn_exp2f(s0[i] - mn); s1[i] = __builtin_amdgcn_exp2f(s1[i] - mn); ps += s0[i] + s1[i]; }
            if (resc) {
                const float alpha = __builtin_amdgcn_exp2f(m_run - mn); l_run *= alpha;
#pragma unroll
                for (int vt = 0; vt < 4; ++vt)
#pragma unroll
                    for (int i = 0; i < 16; ++i) o[vt][i] *= alpha;
            }
            m_run = mn; l_run += ps;
            bf16x8 pf[4];
#pragma unroll
            for (int s = 0; s < 2; ++s) {
                v4u w0, w1;
                w0.x = pk2(s0[8 * s], s0[8 * s + 1]); w0.y = pk2(s0[8 * s + 2], s0[8 * s + 3]); w0.z = pk2(s0[8 * s + 4], s0[8 * s + 5]); w0.w = pk2(s0[8 * s + 6], s0[8 * s + 7]);
                w1.x = pk2(s1[8 * s], s1[8 * s + 1]); w1.y = pk2(s1[8 * s + 2], s1[8 * s + 3]); w1.z = pk2(s1[8 * s + 4], s1[8 * s + 5]); w1.w = pk2(s1[8 * s + 6], s1[8 * s + 7]);
                pf[s] = __builtin_bit_cast(bf16x8, w0); pf[2 + s] = __builtin_bit_cast(bf16x8, w1); }
            {
                const LAS unsigned char* vp0 = vb + vbase;
                s16x4 vl[2][4], vh[2][4];
#define ATT_TR(p_) __builtin_bit_cast(s16x4, __builtin_amdgcn_ds_read_tr16_b64_v4i16((LAS v4i16_t*)(p_)))
#pragma unroll
                for (int vt = 0; vt < 4; ++vt) { vl[0][vt] = ATT_TR(vp0 + vt * 512); vh[0][vt] = ATT_TR(vp0 + vt * 512 + 2048); }
#pragma unroll
                for (int f = 0; f < 4; ++f) {
                    if (f + 1 < 4) {
#pragma unroll
                        for (int vt = 0; vt < 4; ++vt) { vl[(f + 1) & 1][vt] = ATT_TR(vp0 + ((2 * (f + 1)) * 4 + vt) * 512); vh[(f + 1) & 1][vt] = ATT_TR(vp0 + ((2 * (f + 1)) * 4 + vt) * 512 + 2048); }
                    }
                    __builtin_amdgcn_s_setprio(1);
#pragma unroll
                    for (int vt = 0; vt < 4; ++vt) { const bf16x8 a = __builtin_shufflevector(vl[f & 1][vt], vh[f & 1][vt], 0, 1, 2, 3, 4, 5, 6, 7); o[vt] = MFMA32(a, pf[f], o[vt]); }
                    __builtin_amdgcn_s_setprio(0);
                    __builtin_amdgcn_sched_barrier(0);
                }
            }
        }
        }
        if (st + 1 < nsteps) {
#pragma unroll
            for (int j_ = 0; j_ < ATT_TPS; ++j_) ATT_STORE((cur ^ 1) * ATT_TPS + j_, j_); }
        __syncthreads();
    }
#undef ATT_LOADK
#undef ATT_LOADV
#undef ATT_STORE
#undef ATT_TR
}

__device__ __forceinline__ void diffattn_unit(LAS unsigned char* lds, int b, int h, int qb, const bf16* proj, bf16* mix, float lam, float lam_init, const float* subg,
                                              const float* rel_bias, const LAS unsigned char* bucket) {
    typedef AttnLdsR<128> L;
    const int tid = otid(), lane = tid & 63, wid = __builtin_amdgcn_readfirstlane(tid >> 6), r = lane & 31, hi = lane >> 5;
    const int map = wid >> 2, wq = wid & 3, q0 = qb * 128 + wq * 32;
    if (tid < 128) { const float c31 = rel_bias[31 * 8 + h]; ((LAS float*)(lds + L::LUT))[tid] = (rel_bias[bucket[tid] * 8 + h] - c31) * LOG2E; }
    const size_t rb = (size_t)b * SEQ;
    f32x16 o[4]; float m_run, l_run;
    attn_block_reg<128, 64, true, true>(lds, proj + (rb + q0) * 3072 + h * 128 + map * 64, 3072, proj + rb * 3072 + 1024 + h * 128, 3072, proj + rb * 3072 + 2048 + h * 128, 3072,
                              (qb * 128 + 128) / 64, map * 64, q0, o, m_run, l_run);
    const float lt = sum_halves(l_run), inv = __builtin_amdgcn_rcpf(lt);
    LAS float* XO = (LAS float*)lds;
    if (map == 1) {
#pragma unroll
        for (int vt = 0; vt < 4; ++vt)
#pragma unroll
            for (int g4 = 0; g4 < 4; ++g4) { f32x4 x; x[0] = o[vt][4 * g4] * inv; x[1] = o[vt][4 * g4 + 1] * inv; x[2] = o[vt][4 * g4 + 2] * inv; x[3] = o[vt][4 * g4 + 3] * inv;
                *(LAS f32x4*)(XO + (wq * 32 + r) * 132 + 32 * vt + 8 * g4 + 4 * hi) = x; }
    }
    __syncthreads();
    if (map == 0) {
        float ssq = 0.f;
#pragma unroll
        for (int vt = 0; vt < 4; ++vt)
#pragma unroll
            for (int g4 = 0; g4 < 4; ++g4) { const f32x4 x2 = *(const LAS f32x4*)(XO + (wq * 32 + r) * 132 + 32 * vt + 8 * g4 + 4 * hi);
#pragma unroll
                for (int j = 0; j < 4; ++j) { const float v = o[vt][4 * g4 + j] * inv - lam * x2[j]; o[vt][4 * g4 + j] = v; ssq += v * v; } }
        ssq = sum_halves(ssq);
        const float sc = (1.0f - lam_init) * __builtin_amdgcn_rsqf(ssq * (1.0f / 128.0f) + EPS);
        bf16* po = mix + (rb + q0 + r) * 1024 + h * 128 + 4 * hi; const GAS float* sgp = (const GAS float*)subg;
#pragma unroll
        for (int vt = 0; vt < 4; ++vt)
#pragma unroll
            for (int g4 = 0; g4 < 4; ++g4) { const int v0 = 32 * vt + 8 * g4 + 4 * hi;
                v2u w; w.x = pk2(o[vt][4 * g4] * sc * sgp[v0], o[vt][4 * g4 + 1] * sc * sgp[v0 + 1]); w.y = pk2(o[vt][4 * g4 + 2] * sc * sgp[v0 + 2], o[vt][4 * g4 + 3] * sc * sgp[v0 + 3]);
                *(GAS v2u*)(po + 32 * vt + 8 * g4) = w; }
    }
    __syncthreads();
}

__device__ __forceinline__ const float* pin_ptr(LAS unsigned char* lds, int k) {
    int ko = k * 8; asm volatile("" : "+v"(ko));
    const unsigned long long v = *(const LAS unsigned long long*)(lds + MISC_OFF + 512 + ko);
    const unsigned lo = __builtin_amdgcn_readfirstlane((unsigned)v), hi = __builtin_amdgcn_readfirstlane((unsigned)(v >> 32));
    return (const float*)(((unsigned long long)hi << 32) | lo);
}
__global__ void __launch_bounds__(NTHR, 2) mk_fwd(Params P) {
    static_assert(WAVE_TAB_OFF == MISC_OFF + 1024 && HA_TAB + 5120 <= MISC_OFF, "LDS map");
    if ((threadIdx.x & 63) == 0) ((LAS int*)((LAS unsigned char*)lds_raw + WAVE_TAB_OFF))[hw_slot()] = (int)(threadIdx.x >> 6);
    __syncthreads();
    unsigned ldsb = (unsigned)(size_t)(LAS unsigned char*)lds_raw;
    asm volatile("" : "+s"(ldsb));
#define lds ((LAS unsigned char*)ldsb)
    volatile LAS unsigned* MISC = (volatile LAS unsigned*)(lds + MISC_OFF);
    const int G = gridDim.x, blk = blockIdx.x;
#define FL const int tid = otid(), lane = tid & 63, wave = __builtin_amdgcn_readfirstlane(tid >> 6), gw = blk * NWAVES + wave, NGW = G * NWAVES; LAS float* scr = (LAS float*)(lds + wave * 16384); (void)lane; (void)gw; (void)NGW; (void)scr;
    { FL for (int u = tid; u < 256; u += NTHR) MISC[u] = 0u; }
    __syncthreads();
    { FL if (tid < 128) ((LAS unsigned char*)(lds + MISC_OFF + 784))[tid] = P.bucket[tid];
    if (tid < 33) ((LAS unsigned long long*)(lds + MISC_OFF + 512))[tid] = (unsigned long long)P.in[tid]; }
    __syncthreads();
#define PIN(k) pin_ptr(lds, (k))
    unsigned char* ws = P.ws;
    gu32* ctl = (gu32*)(ws + WS_CTL);
    XcdBarrier bar = xcd_barrier_post((unsigned*)(ctl + CW_BAR), MISC + 8);
#define GRID_BAR() do { xcd_barrier(bar); NEWPH(); } while (0)
    float* const xout = P.out;
    unsigned char* wsl = ws;
#define NEWPH() asm volatile("" : "+s"(wsl), "+s"(ldsb))
#define ssb ((float*)(wsl + WS_SS))
#define route ((unsigned*)(wsl + WS_ROUTE))
#define wr_all ((bf16*)(wsl + WS_WR))
#define dch ((float*)(wsl + WS_DCH))
#define lists ((int*)(wsl + WS_LISTS))
#define memn ((bf16*)(wsl + WS_MEMN))
#define kvb ((bf16*)(wsl + WS_KV))
#define xb ((bf16*)(wsl + WS_XB))
#define mix ((bf16*)(wsl + WS_MIX))
#define proj ((bf16*)(wsl + WS_PROJ))
#define xq ((bf16*)(wsl + WS_PROJ))
#define hid ((bf16*)(wsl + WS_HID))
#define w13t ((bf16*)(wsl + WS_WM))
#define w2t ((bf16*)(wsl + WS_WM + WM_W2))

    { FL
    for (int i = 0; i < 4; ++i) {
        const int j = i >> 1; unsigned char* wl = wsl + WS_W + (size_t)i * W_LAYER;
        if ((i & 1) == 0) {
            convert_matrix(PIN(9) + (size_t)j * 1024 * 3072, 1024, 3072, (bf16*)(wl + W_IN), PIN(6) + i * 1024, 1.0f, 0, gw, NGW, scr, lane, 2048);
            convert_matrix(PIN(10) + (size_t)j * 1024 * 1024, 1024, 1024, (bf16*)(wl + W_OUT), nullptr, 1.0f, 0, gw, NGW, scr, lane);
        } else {
            convert_matrix(PIN(16) + (size_t)j * 1024 * 3072, 1024, 3072, (bf16*)(wl + W_IN), PIN(6) + i * 1024, 0.125f * LOG2E, 1024, gw, NGW, scr, lane);
            convert_matrix(PIN(17) + (size_t)j * 1024 * 1024, 1024, 1024, (bf16*)(wl + W_OUT), nullptr, 1.0f, 0, gw, NGW, scr, lane);
        }
        for (int e = (gw * 64 + lane) * 8; e < 1024 * 1024; e += NGW * 64 * 8) { const int k = e >> 10, n = e & 1023; const float* src = PIN(23) + (size_t)i * 1024 * 1024 + e; const float gk = PIN(7)[i * 1024 + k] * (0.0625f * LOG2E);
            const f32x4 a = *(const GAS f32x4*)src, bq = *(const GAS f32x4*)(src + 4);
            *(GAS v4u*)((bf16*)(wl + W_XQ) + (size_t)(n >> 8) * 262144 + k * 256 + (n & 255)) = (v4u){pk2(a[0] * gk, a[1] * gk), pk2(a[2] * gk, a[3] * gk), pk2(bq[0] * gk, bq[1] * gk), pk2(bq[2] * gk, bq[3] * gk)}; }
        for (int hh = 0; hh < 4; ++hh) convert_matrix(PIN(25) + (size_t)i * 1024 * 1024 + (size_t)hh * 256 * 1024, 256, 1024, (bf16*)(wl + W_XO) + (size_t)hh * 262144, nullptr, 1.0f, 0, gw, NGW, scr, lane);
        convert_matrix(PIN(24) + (size_t)i * 1024 * 2048, 1024, 2048, (bf16*)(wsl + WS_W + W_KV) + (size_t)i * 2048 * 1024, nullptr, 1.0f, 0, gw, NGW, scr, lane);
    }
    for (int e = blk * NTHR + tid; e < 4 * 32 * 1024; e += G * NTHR) { const int l = e >> 15, jr = (e >> 10) & 31, k = e & 1023; float v = 0.f;
        if (jr < 4) v = PIN(26)[((size_t)l * 1024 + k) * 4 + jr]; else if (jr < 20) v = PIN(28)[((size_t)l * 1024 + k) * 16 + (jr - 4)];
        wr_all[e] = (bf16)f2bf(v * PIN(8)[l * 1024 + k]); }
    for (int m = gw; m < MT; m += NGW) row_norm_bf16(PIN(1) + (size_t)m * 1024, PIN(3), memn + (size_t)m * 1024, lane);
    for (int m = gw; m < T; m += 4 * NGW) rows4_to_xb(PIN(0), xb, ssb, m, NGW, lane);
    }
    GRID_BAR();
    { pg8::Gemm g{memn, (const bf16*)(wsl + WS_W + W_KV), 1024, 1024, 1024}; pg8::StaticOrder S; S.init(MT, 8192, G, blk);
      pg8::EpiBlocks256 E{kvb};
      pg8::gemm_phase<pg8::EpiBlocks256, pg8::StaticOrder, true, false>(lds, g, S, E); }
    GRID_BAR();


    for (int i = 0; i < 4; ++i) {
        const int j = i >> 1; unsigned char* wl = wsl + WS_W + (size_t)i * W_LAYER;
        const bool xuni = MISC[8 + 2] != 0u; const int pslot = xuni ? (int)(MISC[8 + 3] * 8u + bar.x) : blk, pvc = xuni ? (int)(bar.x * (unsigned)(G / 8) + MISC[8 + 3]) : blk;
#define XLOC_BAR() do { if (xuni) xcd_local_barrier(bar); else xcd_barrier(bar); NEWPH(); } while (0)
        __syncthreads();
        { FL convert_moe(PIN(30) + (size_t)i * 16 * 1024 * 512, PIN(31) + (size_t)i * 16 * 1024 * 512, PIN(32) + (size_t)i * 16 * 512 * 1024, w13t, w2t, PIN(8) + i * 1024, gw, NGW, scr, lane); }
        __syncthreads();
        {
        { pg8::Gemm g{xb, (const bf16*)(wl + W_IN), 1024, 1024, 1024}; pg8::StaticOrder S; S.init(T, 3072, G, pslot);
          const bool tb = pg8::build_rs_table(S, ssb); __syncthreads();
          pg8::EpiNormBf16 E{proj, 3072, ssb, 0, tb, (i & 1) ? (1 << 30) : 8};
          pg8::gemm_phase<pg8::EpiNormBf16, pg8::StaticOrder, true, false>(lds, g, S, E); }
        { const bf16* kvl = kvb + (size_t)i * 16 * 8 * 65536;
          for (int mode = 0; mode < 2; ++mode) {
              pg8::Gemm g{mode ? (const bf16*)(wl + W_XO) : kvl, mode ? kvl : (const bf16*)(wl + W_XQ), 256, 256, 256}; pg8::FoldOrder S{G, pvc, mode};
              pg8::EpiNormBf16 E{(bf16*)(wsl + WS_FOLD + (mode ? 32 * MiB : 0)), 1024, nullptr, 1, false, 1 << 30};
              pg8::gemm_phase<pg8::EpiNormBf16, pg8::FoldOrder, true, false>(lds, g, S, E); } }
        XLOC_BAR();
        if ((i & 1) == 0) {
            hgrn_phaseA(lds, pslot, G, proj, mix, dch, PIN(5), j, xuni);
            XLOC_BAR();
            hgrn_phaseB(proj, dch, G, pslot, xuni);
            for (int uv = pslot; uv < NB * (SEQ / CV_R); uv += G) conv_unit(lds, xuni ? (NB * (SEQ / CV_R) / 8) * (uv & 7) + (uv >> 3) : uv, proj, mix, PIN(12) + (size_t)j * 31 * 512, PIN(13) + j * 512, PIN(14) + j * 512, PIN(15) + j * 512);
            XLOC_BAR();
            hgrn_phaseC(lds, pslot, G, proj, mix, PIN(11) + j * 128, xuni);
        } else {
            float d1 = 0.f, d2 = 0.f;
            for (int k = 0; k < 64; ++k) { d1 += PIN(18)[j * 64 + k] * PIN(19)[j * 64 + k]; d2 += PIN(20)[j * 64 + k] * PIN(21)[j * 64 + k]; }
            const float lam_init = (j == 0) ? P.lam_init[0] : P.lam_init[1], lam = __expf(d1) - __expf(d2) + lam_init;
            const int vcu = (G % 8 == 0) ? (blk % 8) * (G / 8) + blk / 8 : blk;
            for (int iv = xuni ? pslot : vcu; iv < 2048; iv += G) { const int idx = xuni ? 256 * (iv & 7) + (iv >> 3) : iv;
                const int bh = idx >> 4, pr = idx & 15, b = bh >> 3, h = bh & 7;
                diffattn_unit(lds, b, h, pr, proj, mix, lam, lam_init, PIN(22) + j * 128, PIN(2), (const LAS unsigned char*)(lds + MISC_OFF + 784));
                diffattn_unit(lds, b, h, 31 - pr, proj, mix, lam, lam_init, PIN(22) + j * 128, PIN(2), (const LAS unsigned char*)(lds + MISC_OFF + 784)); }
        }
        }
        XLOC_BAR();
        { pg8::Gemm g{mix, (const bf16*)(wl + W_OUT), 1024, 1024, 1024}; pg8::StaticOrder S; S.init(T, 1024, G, pslot);
          pg8::EpiResidual E{xb, ssb};
          pg8::gemm_phase<pg8::EpiResidual, pg8::StaticOrder, true, false>(lds, g, S, E); }
        XLOC_BAR();
        { pg8::Gemm g{xb, (const bf16*)(wsl + WS_FOLD), 1024, 1024, 1024}; pg8::BatchOrder S; S.init(T, 1024, G, pslot);
          const bool tb = pg8::build_rs_table(S, ssb); __syncthreads();
          pg8::EpiSoftmaxBf16 E{xq, ssb, (LAS float*)(lds + 131072), tb, (long)(24 * MiB / 2)};
          pg8::gemm_phase<pg8::EpiSoftmaxBf16, pg8::BatchOrder, true, false>(lds, g, S, E); }
        XLOC_BAR();
        { pg8::Gemm g{xq, (const bf16*)(wsl + WS_FOLD + 32 * MiB), 1024, 1024, 1024, (long)(24 * MiB)}; pg8::BatchOrder S; S.init(T, 1024, G, pslot);
          pg8::EpiResidual E{xb, ssb};
          pg8::gemm_phase<pg8::EpiResidual, pg8::BatchOrder, true, false>(lds, g, S, E); }
        XLOC_BAR();
        for (int tile = xuni ? (int)(bar.x * (unsigned)(G / 8) + MISC[8 + 3]) : blk; tile < T / 256; tile += G)
            router_tile256(lds, tile, xb, ssb, wr_all + (size_t)i * 32 * 1024, PIN(27) + i * 4, PIN(29) + i * 16, route, lists, (unsigned*)(ctl + CW_CNT + 32 * (i * 32)));
        GRID_BAR();
        LAS int* tab = (LAS int*)(lds + MISC_OFF) + 32;
        const int mvc = (G % 8 == 0) ? (blk % 8) * (G / 8) + blk / 8 : blk;
        { FL if (tid < 32) tab[33 + tid] = (int)__hip_atomic_load(ctl + CW_CNT + 32 * (i * 32 + tid), RLX_AGENT);
        __syncthreads();
        if (tid == 0) { int a = 0; tab[0] = 0; for (int q = 0; q < 32; ++q) { a += (tab[33 + q] + 255) >> 8; tab[q + 1] = a; } } }
        __syncthreads();
        { pg8::Gemm g{xb, w13t, 1024, 1024, 1024}; pg8::MoeOrder S{G, mvc, 0, tab[32], tab, lists, (LAS unsigned short*)(lds + 131072), 8};
          pg8::EpiSwiglu E{hid, lists, (const float*)route, (LAS unsigned short*)(lds + 131072)};
          pg8::gemm_phase<pg8::EpiSwiglu, pg8::MoeOrder, true, true>(lds, g, S, E); }
        GRID_BAR();
        { pg8::Gemm g{hid, w2t, 1024, 1024, 512}; pg8::MoeOrder S{G, mvc, 0, tab[32], tab, lists, (LAS unsigned short*)(lds + 131072), 4};
          pg8::EpiMoeDown E{xb, ssb, lists};
          pg8::gemm_phase<pg8::EpiMoeDown, pg8::MoeOrder, true, false, true>(lds, g, S, E); }
        GRID_BAR();
    }
    { FL f32x4 gg[4]; { const GAS f32x4* gr = (const GAS f32x4*)PIN(4) + lane;
#pragma unroll
      for (int j = 0; j < 4; ++j) gg[j] = gr[64 * j]; }
      for (int m = gw; m < T; m += 4 * NGW) rows4_final(xb, xout, ssb, gg, m, NGW, lane); }
}

extern "C" void kernel_launch(void* const* d_in, const int* in_sizes, int n_in, void* d_out, int out_size, void* d_ws, size_t ws_size, hipStream_t stream) {
    static int grid = 0;
    if (grid == 0) {
        if (n_in != 33 || out_size != T * DM || ws_size < WS_END) { fprintf(stderr, "kernel_launch: unexpected problem (n_in %d out %d ws %zu)\n", n_in, out_size, ws_size); grid = -1; return; }
        int dev = 0, cus = 0, per_cu = 0;
        if (hipGetDevice(&dev) != hipSuccess || hipDeviceGetAttribute(&cus, hipDeviceAttributeMultiprocessorCount, dev) != hipSuccess) { grid = -1; return; }
        if (hipFuncSetAttribute((const void*)mk_fwd, hipFuncAttributeMaxDynamicSharedMemorySize, LDS_BYTES) != hipSuccess) { fprintf(stderr, "kernel_launch: hipFuncSetAttribute failed\n"); grid = -1; return; }
        if (hipOccupancyMaxActiveBlocksPerMultiprocessor(&per_cu, (const void*)mk_fwd, NTHR, LDS_BYTES) != hipSuccess || per_cu < 1) { fprintf(stderr, "kernel_launch: occupancy query says %d\n", per_cu); }
        (void)hipGetLastError();
        grid = cus;
        while (grid > 1 && (T % (32 * grid)) != 0) --grid;
    }
    if (grid < 0) return;
    if (hipMemsetAsync((char*)d_ws + WS_CTL, 0, CTL_ZERO_BYTES, stream) != hipSuccess) return;
    Params p; memset(&p, 0, sizeof(p));
    for (int i = 0; i < 33; ++i) p.in[i] = (const float*)d_in[i];
    p.out = (float*)d_out; p.ws = (unsigned char*)d_ws;
    p.lam_init[0] = (float)(0.8 - 0.6 * exp(-0.3 * 1.0)); p.lam_init[1] = (float)(0.8 - 0.6 * exp(-0.3 * 3.0));
    for (int n = 0; n < 128; ++n) { int bk; if (n < 16) bk = n; else { bk = 16 + (int)(log((double)n / 16.0) / log(8.0) * 16.0); if (bk > 31) bk = 31; if (bk < 0) bk = 0; } p.bucket[n] = (unsigned char)bk; }
    hipLaunchKernelGGL(mk_fwd, dim3(grid), dim3(NTHR), LDS_BYTES, stream, p);
}
```

```cpp
#include <hip/hip_runtime.h>
#include <cstdio>
#include <cstdint>
#include <cmath>
#include <cstring>
extern __shared__ __attribute__((aligned(16))) unsigned char lds_raw[];
constexpr int WAVE_TAB_OFF = 160 * 1024 - 1024;
__device__ __forceinline__ int hw_slot() { return (int)(__builtin_amdgcn_s_getreg((5 << 11) | 4) & 0x3f); }
__device__ __forceinline__ int otid() {
    const int wv = __builtin_amdgcn_readfirstlane(((const __attribute__((address_space(3))) int*)((const __attribute__((address_space(3))) unsigned char*)lds_raw + WAVE_TAB_OFF))[hw_slot()]);
    int t = wv * 64 + (int)__builtin_amdgcn_mbcnt_hi(~0u, __builtin_amdgcn_mbcnt_lo(~0u, 0u)); asm volatile("" : "+v"(t)); return t; }
#ifndef SHFL_SAFE
#define SHFL_SAFE 1
#endif
#if SHFL_SAFE
template <int M> __device__ __forceinline__ float xor_lt32(float v) { return __shfl_xor(v, M); }
__device__ __forceinline__ float sum_halves(float v) { return v + __shfl_xor(v, 32); }
__device__ __forceinline__ float max_halves(float v) { return __builtin_fmaxf(v, __shfl_xor(v, 32)); }
#else
template <int M> __device__ __forceinline__ float xor_lt32(float v) { return __builtin_bit_cast(float, __builtin_amdgcn_ds_swizzle(__builtin_bit_cast(int, v), 0x1f | (M << 10))); }
__device__ __forceinline__ float sum_halves(float v) { auto rr = __builtin_amdgcn_permlane32_swap(__builtin_bit_cast(unsigned, v), __builtin_bit_cast(unsigned, v), false, false); return __builtin_bit_cast(float, rr[0]) + __builtin_bit_cast(float, rr[1]); }
__device__ __forceinline__ float max_halves(float v) { auto rr = __builtin_amdgcn_permlane32_swap(__builtin_bit_cast(unsigned, v), __builtin_bit_cast(unsigned, v), false, false); return __builtin_fmaxf(__builtin_bit_cast(float, rr[0]), __builtin_bit_cast(float, rr[1])); }
#endif
namespace pg8 {
#define PG8_LAS __attribute__((address_space(3)))
#define PG8_GAS __attribute__((address_space(1)))
typedef unsigned short bf16_t;
typedef short bf16x8 __attribute__((ext_vector_type(8)));
typedef float f32x4 __attribute__((ext_vector_type(4)));
typedef float f32x2 __attribute__((ext_vector_type(2)));
typedef unsigned u32x4 __attribute__((ext_vector_type(4)));
typedef unsigned u32x2 __attribute__((ext_vector_type(2)));
constexpr int BM = 256, BK = 64, HALF = 128, HTB = HALF * BK * 2, STAGE_BYTES = 8 * HTB, NXCD = 8, WGM = 8;

__host__ __device__ __forceinline__ int lds_byte(int r, int c) { const int st = (r >> 4) * 2 + (c >> 5), rr = r & 15, cc = c & 31, ob = rr * 64 + cc * 2; return st * 1024 + (ob ^ (((ob >> 9) & 1) << 5)); }
__host__ __device__ __forceinline__ void stage_rc(int b, int& R, int& C) { const int st = b / 1024, sb = b % 1024, swz = sb ^ (((sb >> 9) & 1) << 5); R = (st >> 1) * 16 + swz / 64; C = (st & 1) * 32 + (swz % 64) / 2; }
__host__ __device__ __forceinline__ int perm32(int rho) { const int n = rho >> 4, i = rho & 15; return 8 * (i >> 2) + 4 * n + (i & 3); }

struct Unit { int pm, pn, x0, x1, x2, x3, ui; long bd; };
constexpr int RS_TAB_OFF = 131072 + 8192, RS_TAB_UNITS = 12;
struct Gemm { const bf16_t* A; const bf16_t* Bt; int K, lda, ldb; long abatch = 0; };

struct StaticOrder {
    static constexpr bool PRELOAD = false;
    int nM, nN, nwg, G, c;
    __device__ __forceinline__ void init(int M, int N, int G_, int c_) { nM = M / BM; nN = N / BM; nwg = nM * nN; G = G_; c = c_; }
    __device__ __forceinline__ bool next(int i, Unit& u) const {
        const long L = (long)i * G + c; if (L >= nwg) return false;
        int wgid = (int)L; { const int q = nwg / NXCD, r = nwg % NXCD, xcd = wgid % NXCD, off = wgid / NXCD; wgid = (xcd < r ? xcd * (q + 1) : r * (q + 1) + (xcd - r) * q) + off; }
        const int nig = WGM * nN, gid = wgid / nig, fm = gid * WGM, gsz = (nM - fm) < WGM ? (nM - fm) : WGM;
        u.pm = fm + ((wgid % nig) % gsz); u.pn = (wgid % nig) / gsz; u.x0 = u.pn; u.x1 = 0; u.x2 = 256; u.x3 = 0; u.bd = 0; return true;
    }
    __device__ __forceinline__ void preload(int) const {}
    __device__ __forceinline__ unsigned rowoff(int, int) const { return 0u; }
};

struct BatchOrder : StaticOrder {
    __device__ __forceinline__ bool next(int i, Unit& u) const { if (!StaticOrder::next(i, u)) return false; u.pn = (u.pm >> 4) * 4 + u.x0; return true; }
};
struct FoldOrder {
    static constexpr bool PRELOAD = false;
    int G, c, mode;
    __device__ __forceinline__ bool next(int i, Unit& u) const { const int L = i * G + c; if (L >= 256) return false; const int bh = L >> 2, q = L & 3, b = bh >> 2, h = bh & 3;
        if (mode == 0) { u.pm = b * 8 + h; u.pn = h * 4 + q; u.x0 = q; u.x1 = b * 4 + h; } else { u.pm = h * 4 + q; u.pn = b * 8 + 4 + h; u.x0 = h; u.x1 = b * 4 + q; }
        u.x2 = 256; u.x3 = 0; u.bd = 0; return true; }
    __device__ __forceinline__ void preload(int) const {}
    __device__ __forceinline__ unsigned rowoff(int, int) const { return 0u; }
};
struct MoeOrder {
    static constexpr bool PRELOAD = true;
    int G, c, t0, t1; const PG8_LAS int* tab; const int* lists; PG8_LAS unsigned short* tokl; int ncol;
    __device__ __forceinline__ PG8_LAS unsigned* uinfo() const { return (PG8_LAS unsigned*)(lds_raw + (160 * 1024 - 2048) + 1280); }
    __device__ __forceinline__ bool tile_of(int i, int& tile, int& col) const { const int L = i * G + c; const int sh = (ncol == 8) ? 3 : 2; tile = t0 + (L >> sh); col = L & (ncol - 1); return tile < t1; }
    __device__ __forceinline__ unsigned scan(int tile) const {
        int idx = 0;
        for (int j = 0; j < 32; ++j) { if (tab[j + 1] > tile) { idx = j; break; } }
        const int mt = tile - tab[idx]; int nv = tab[33 + idx] - mt * 256; nv = nv > 256 ? 256 : nv;
        return (unsigned)idx | ((unsigned)(nv - 1) << 8) | ((unsigned)mt << 16); }
    __device__ __forceinline__ bool next(int i, Unit& u) const {
        int tile, col; if (!tile_of(i, tile, col)) return false;
        const unsigned w = uinfo()[i]; const int idx = w & 31, nv = ((w >> 8) & 255) + 1, mt = w >> 16;
        const int gs = idx / 6, q = idx - gs * 6, lo = gs * 4 + ((0x211000 >> (4 * q)) & 15), hi = gs * 4 + ((0x332321 >> (4 * q)) & 15);
        u.pm = tile; u.x0 = idx; u.x1 = mt; u.x2 = nv; u.x3 = col;
        if (ncol == 8) { u.pn = ((col < 4) ? lo : hi) * 4 + (col & 3); u.bd = 0; }
        else { u.pn = lo * 4 + col; u.bd = (long)(hi - lo) * 4 * (256 * 512 * 2) - 8 * (BK * 2); }
        return true;
    }
    __device__ __forceinline__ void preload(int tid) const {
        { int tile, col; if (tid < 32 && tile_of(tid, tile, col)) uinfo()[tid] = scan(tile); }
        if (ncol != 8) return;
        const int half = tid >> 8, r = tid & 255;
#pragma unroll 1
        for (int i0 = 0; ; i0 += 4) { int tile, col; if (!tile_of(i0, tile, col)) break;
            unsigned w[2]; bool ok[2]; int tok[2];
#pragma unroll
            for (int j = 0; j < 2; ++j) { const int ii = i0 + 2 * j + half; ok[j] = tile_of(ii, tile, col); tok[j] = 0; w[j] = 0u;
                if (ok[j]) { w[j] = scan(tile); if (r <= (int)((w[j] >> 8) & 255)) tok[j] = ((const PG8_GAS int*)lists)[(size_t)(w[j] & 31) * 65536 + (w[j] >> 16) * 256 + r]; } }
#pragma unroll
            for (int j = 0; j < 2; ++j) { const int ii = i0 + 2 * j + half; if (ok[j]) tokl[ii * 256 + r] = (unsigned short)tok[j]; }
        } }
    __device__ __forceinline__ unsigned rowoff(int ui, int row) const { return (unsigned)tokl[ui * 256 + row]; }
};

__device__ __forceinline__ unsigned cvt_pk_bf16(float lo, float hi) { unsigned r; asm volatile("v_cvt_pk_bf16_f32 %0, %1, %2" : "=v"(r) : "v"(lo), "v"(hi)); return r; }

__device__ __forceinline__ float row_rs(const float* ss, int row) {
    const PG8_GAS f32x4* sp = (const PG8_GAS f32x4*)(ss + (size_t)row * 16); const f32x4 a = sp[0], b = sp[1], c = sp[2], d = sp[3];
    const float s = ((a[0] + a[1]) + (a[2] + a[3])) + ((b[0] + b[1]) + (b[2] + b[3])) + ((c[0] + c[1]) + (c[2] + c[3])) + ((d[0] + d[1]) + (d[2] + d[3]));
    return __builtin_amdgcn_rsqf(s * (1.0f / 1024.0f) + 1e-6f);
}
__device__ __forceinline__ void rows8_rs(const float* ss, int row0, float (&rr)[8]) {
#pragma unroll
    for (int q = 0; q < 8; q += 2) { rr[q] = row_rs(ss, row0 + (q >> 2) * HALF + (q & 3) * 16); rr[q + 1] = row_rs(ss, row0 + ((q + 1) >> 2) * HALF + ((q + 1) & 3) * 16); asm volatile("" : "+v"(rr[q]), "+v"(rr[q + 1]) :: "memory"); }
}
__device__ __forceinline__ void rows8_tab(int ui, int wr, int fr, float (&rr)[8]) {
    const PG8_LAS float* tp = (const PG8_LAS float*)(lds_raw + RS_TAB_OFF) + ui * 256 + wr * 64 + fr;
#pragma unroll
    for (int q = 0; q < 8; ++q) rr[q] = tp[(q >> 2) * HALF + (q & 3) * 16];
}
template <class Sched>
__device__ __forceinline__ bool build_rs_table(const Sched& S, const float* ss) {
    { Unit t; if (S.next(RS_TAB_UNITS, t)) return false; }
    const int tid = otid(), r = tid >> 1, hf = tid & 1; PG8_LAS float* tab = (PG8_LAS float*)(lds_raw + RS_TAB_OFF);
#pragma unroll 1
    for (int i0 = 0; i0 < RS_TAB_UNITS; i0 += 4) {
        f32x4 a[4][2]; bool ok[4];
#pragma unroll
        for (int j = 0; j < 4; ++j) { Unit u; ok[j] = S.next(i0 + j, u); if (ok[j]) { const PG8_GAS f32x4* sp = (const PG8_GAS f32x4*)(ss + ((size_t)u.pm * BM + r) * 16 + 8 * hf); a[j][0] = sp[0]; a[j][1] = sp[1]; } }
#pragma unroll
        for (int j = 0; j < 4; ++j) if (ok[j]) { float s_ = ((a[j][0][0] + a[j][0][1]) + (a[j][0][2] + a[j][0][3])) + ((a[j][1][0] + a[j][1][1]) + (a[j][1][2] + a[j][1][3])); s_ += __shfl_xor(s_, 1);
            if (hf == 0) tab[(i0 + j) * 256 + r] = __builtin_amdgcn_rsqf(s_ * (1.0f / 1024.0f) + 1e-6f); }
        if (!ok[3]) break;
    }
    return true;
}
struct EpiNormBf16 {
    static constexpr bool PERM = true; static constexpr int NSTORE = 8;
    bf16_t* O; int ldc; const float* ss; int rowsel; bool tab; int glu_from;
    __device__ __forceinline__ void operator()(const f32x4 (&acc)[2][2][4][2], const Unit& u, int wr, int wc, int fr, int fq) const {
        const int row0 = (rowsel ? u.x1 : u.pm) * BM + wr * 64 + fr, col0 = u.x0 * BM + wc * 32 + 8 * fq;
        float rr8[8];
        if (tab) rows8_tab(u.ui, wr, fr, rr8); else if (ss) rows8_rs(ss, row0, rr8); else {
#pragma unroll
            for (int q = 0; q < 8; ++q) rr8[q] = 1.0f; }
        if (u.x0 >= glu_from) {
            const int gcol = glu_from * BM + (u.x0 - glu_from) * HALF + wc * 32 + 8 * fq;
#pragma unroll
            for (int ai = 0; ai < 2; ++ai)
#pragma unroll
                for (int m = 0; m < 4; ++m) { const int row = row0 + ai * HALF + m * 16; const float rr = rr8[ai * 4 + m]; const float c1 = -1.44269504f * rr; const f32x2 c1v = {c1, c1}, rrv = {rr, rr}, one = {1.0f, 1.0f};
                    float hv[8];
#pragma unroll
                    for (int n = 0; n < 2; ++n)
#pragma unroll
                        for (int j = 0; j < 4; j += 2) { const f32x2 vv = {acc[ai][0][m][n][j], acc[ai][0][m][n][j + 1]}, gg = {acc[ai][1][m][n][j], acc[ai][1][m][n][j + 1]};
                            f32x2 e = gg * c1v; e[0] = __builtin_amdgcn_exp2f(e[0]); e[1] = __builtin_amdgcn_exp2f(e[1]); e += one;
                            f32x2 sg; sg[0] = __builtin_amdgcn_rcpf(e[0]); sg[1] = __builtin_amdgcn_rcpf(e[1]);
                            const f32x2 h2 = (vv * rrv) * sg; hv[n * 4 + j] = h2[0]; hv[n * 4 + j + 1] = h2[1]; }
                    u32x4 w; w.x = cvt_pk_bf16(hv[0], hv[1]); w.y = cvt_pk_bf16(hv[2], hv[3]); w.z = cvt_pk_bf16(hv[4], hv[5]); w.w = cvt_pk_bf16(hv[6], hv[7]);
                    *(PG8_GAS u32x4*)(O + (size_t)row * ldc + gcol) = w; }
            return; }
#pragma unroll
        for (int ai = 0; ai < 2; ++ai)
#pragma unroll
            for (int m = 0; m < 4; ++m) { const int row = row0 + ai * HALF + m * 16; const float rr = rr8[ai * 4 + m]; bf16_t* rowp = O + (size_t)row * ldc + col0;
#pragma unroll
                for (int bj = 0; bj < 2; ++bj) { const f32x4 v0 = acc[ai][bj][m][0] * rr, v1 = acc[ai][bj][m][1] * rr;
                    u32x4 w; w.x = cvt_pk_bf16(v0[0], v0[1]); w.y = cvt_pk_bf16(v0[2], v0[3]); w.z = cvt_pk_bf16(v1[0], v1[1]); w.w = cvt_pk_bf16(v1[2], v1[3]);
                    *(PG8_GAS u32x4*)(rowp + bj * HALF) = w; } }
    }
};
struct EpiBlocks256 {
    static constexpr bool PERM = true; static constexpr int NSTORE = 16;
    bf16_t* O;
    __device__ __forceinline__ void operator()(const f32x4 (&acc)[2][2][4][2], const Unit& u, int wr, int wc, int fr, int fq) const {
        bf16_t* base = O + (size_t)(((u.x0 >> 3) * 16 + u.pm) * 8 + (u.x0 & 7)) * 65536 + (wr * 64 + fr) * 256 + wc * 32 + 8 * fq;
#pragma unroll
        for (int ai = 0; ai < 2; ++ai)
#pragma unroll
            for (int m = 0; m < 4; ++m) { bf16_t* rowp = base + (ai * HALF + m * 16) * 256;
#pragma unroll
                for (int bj = 0; bj < 2; ++bj) { const f32x4 v0 = acc[ai][bj][m][0], v1 = acc[ai][bj][m][1];
                    u32x4 w; w.x = cvt_pk_bf16(v0[0], v0[1]); w.y = cvt_pk_bf16(v0[2], v0[3]); w.z = cvt_pk_bf16(v1[0], v1[1]); w.w = cvt_pk_bf16(v1[2], v1[3]);
                    *(PG8_GAS u32x4*)(rowp + bj * HALF) = w; } }
    }
};
__device__ __forceinline__ float bf_lo(unsigned w) { return __builtin_bit_cast(float, w << 16); }
__device__ __forceinline__ float bf_hi(unsigned w) { return __builtin_bit_cast(float, w & 0xffff0000u); }
struct EpiResidual {
    static constexpr bool PERM = true; static constexpr int NSTORE = 16;
    bf16_t* xb; float* ss;
    __device__ __forceinline__ void operator()(const f32x4 (&acc)[2][2][4][2], const Unit& u, int wr, int wc, int fr, int fq) const {
        const int row0 = u.pm * BM + wr * 64 + fr, col0 = u.x0 * BM + wc * 32 + 8 * fq;
#pragma unroll
        for (int ai = 0; ai < 2; ++ai) {
            u32x4 rv[4][2];
#pragma unroll
            for (int m = 0; m < 4; ++m)
#pragma unroll
                for (int bj = 0; bj < 2; ++bj) rv[m][bj] = *(const __attribute__((address_space(1))) u32x4*)(xb + (size_t)(row0 + ai * HALF + m * 16) * 1024 + col0 + bj * HALF);
#pragma unroll
            for (int m = 0; m < 4; ++m) { const int row = row0 + ai * HALF + m * 16; float q = 0.f; bf16_t* rowp = xb + (size_t)row * 1024 + col0;
#pragma unroll
                for (int bj = 0; bj < 2; ++bj) { const u32x4 r = rv[m][bj];
                    const f32x4 a0 = acc[ai][bj][m][0], a1 = acc[ai][bj][m][1];
                    const float v0 = bf_lo(r.x) + a0[0], v1 = bf_hi(r.x) + a0[1], v2 = bf_lo(r.y) + a0[2], v3 = bf_hi(r.y) + a0[3];
                    const float v4 = bf_lo(r.z) + a1[0], v5 = bf_hi(r.z) + a1[1], v6 = bf_lo(r.w) + a1[2], v7 = bf_hi(r.w) + a1[3];
                    q += ((v0 * v0 + v1 * v1) + (v2 * v2 + v3 * v3)) + ((v4 * v4 + v5 * v5) + (v6 * v6 + v7 * v7));
                    u32x4 w; w.x = cvt_pk_bf16(v0, v1); w.y = cvt_pk_bf16(v2, v3); w.z = cvt_pk_bf16(v4, v5); w.w = cvt_pk_bf16(v6, v7);
                    *(PG8_GAS u32x4*)(rowp + bj * HALF) = w; }
                q += xor_lt32<16>(q); q = sum_halves(q);
                if (fq == 0) ((PG8_GAS float*)ss)[(size_t)row * 16 + u.x0 * 4 + wc] = q; } }
    }
};
struct EpiSoftmaxBf16 {
    static constexpr bool PERM = true, MUTABLE = true; static constexpr int NSTORE = 16;
    bf16_t* O; const float* ss; PG8_LAS float* xch; bool tab; long obatch;
    __device__ __forceinline__ void operator()(f32x4 (&acc)[2][2][4][2], const Unit& u, int wr, int wc, int fr, int fq) const {
        const int row0 = u.pm * BM + wr * 64 + fr, col0 = u.x0 * BM + wc * 32 + 8 * fq;
        float mw[8], rr8[8]; if (tab) rows8_tab(u.ui, wr, fr, rr8); else rows8_rs(ss, row0, rr8);
#pragma unroll
        for (int ai = 0; ai < 2; ++ai)
#pragma unroll
            for (int m = 0; m < 4; ++m) { const float rr = rr8[ai * 4 + m]; float mx = -3.0e38f;
#pragma unroll
                for (int bj = 0; bj < 2; ++bj)
#pragma unroll
                    for (int n = 0; n < 2; ++n) { acc[ai][bj][m][n] *= rr; const f32x4 v = acc[ai][bj][m][n]; mx = __builtin_fmaxf(mx, __builtin_fmaxf(__builtin_fmaxf(v[0], v[1]), __builtin_fmaxf(v[2], v[3]))); }
                mx = __builtin_fmaxf(mx, xor_lt32<16>(mx)); mx = max_halves(mx); float sm = 0.f;
#pragma unroll
                for (int bj = 0; bj < 2; ++bj)
#pragma unroll
                    for (int n = 0; n < 2; ++n) { f32x4 v = acc[ai][bj][m][n];
#pragma unroll
                        for (int j = 0; j < 4; ++j) { v[j] = __builtin_amdgcn_exp2f(v[j] - mx); sm += v[j]; }
                        acc[ai][bj][m][n] = v; }
                sm += xor_lt32<16>(sm); sm = sum_halves(sm); mw[ai * 4 + m] = mx;
                if (fq == 0) { const int rit = ai * HALF + wr * 64 + m * 16 + fr; xch[(rit * 4 + wc) * 2] = mx; xch[(rit * 4 + wc) * 2 + 1] = sm; } }
        asm volatile("s_waitcnt lgkmcnt(0)" ::: "memory"); __builtin_amdgcn_s_barrier(); asm volatile("" ::: "memory");
#pragma unroll
        for (int ai = 0; ai < 2; ++ai)
#pragma unroll
            for (int m = 0; m < 4; ++m) { const int rit = ai * HALF + wr * 64 + m * 16 + fr; const int row = row0 + ai * HALF + m * 16;
                const f32x4 e0 = *(const PG8_LAS f32x4*)(xch + rit * 8), e1 = *(const PG8_LAS f32x4*)(xch + rit * 8 + 4);
                const float M = __builtin_fmaxf(__builtin_fmaxf(e0[0], e0[2]), __builtin_fmaxf(e1[0], e1[2]));
                const float tot = e0[1] * __builtin_amdgcn_exp2f(e0[0] - M) + e0[3] * __builtin_amdgcn_exp2f(e0[2] - M) + e1[1] * __builtin_amdgcn_exp2f(e1[0] - M) + e1[3] * __builtin_amdgcn_exp2f(e1[2] - M);
                const float f = __builtin_amdgcn_exp2f(mw[ai * 4 + m] - M) * __builtin_amdgcn_rcpf(tot); bf16_t* rowp = O + (size_t)(row >> 12) * (size_t)obatch + (size_t)(row & 4095) * 1024 + col0;
#pragma unroll
                for (int bj = 0; bj < 2; ++bj) { const f32x4 v0 = acc[ai][bj][m][0] * f, v1 = acc[ai][bj][m][1] * f;
                    u32x4 w; w.x = cvt_pk_bf16(v0[0], v0[1]); w.y = cvt_pk_bf16(v0[2], v0[3]); w.z = cvt_pk_bf16(v1[0], v1[1]); w.w = cvt_pk_bf16(v1[2], v1[3]);
                    *(PG8_GAS u32x4*)(rowp + bj * HALF) = w; } }
        asm volatile("s_waitcnt lgkmcnt(0)" ::: "memory");
    }
};
struct EpiSwiglu {
    static constexpr bool PERM = true; static constexpr int NSTORE = 0;
    bf16_t* hid; const int* lists; const float* route; const PG8_LAS unsigned short* tokl;
    __device__ __forceinline__ void operator()(const f32x4 (&acc)[2][2][4][2], const Unit& u, int wr, int wc, int fr, int fq) const {
        const int which = u.x3 >> 2, col0 = which * 512 + (u.x3 & 3) * 128 + wc * 32 + 8 * fq;
        unsigned pw[8];
#pragma unroll
        for (int q = 0; q < 8; ++q) { const int rit = (q >> 2) * HALF + wr * 64 + (q & 3) * 16 + fr; const unsigned tk = tokl[u.ui * 256 + rit]; pw[q] = ((const PG8_GAS unsigned*)route)[(size_t)tk * 4 + 1 + which]; }
#pragma unroll
        for (int ai = 0; ai < 2; ++ai)
#pragma unroll
            for (int m = 0; m < 4; ++m) { const int rit = ai * HALF + wr * 64 + m * 16 + fr; const float r1 = bf_lo(pw[ai * 4 + m]), r3 = bf_hi(pw[ai * 4 + m]);
                float hv[8];
                { typedef float f32x2 __attribute__((ext_vector_type(2))); const float c1 = -1.44269504f * r1, r13 = r1 * r3; const f32x2 c1v = {c1, c1}, r13v = {r13, r13}, one = {1.0f, 1.0f};
#pragma unroll
                  for (int n = 0; n < 2; ++n)
#pragma unroll
                      for (int j = 0; j < 4; j += 2) { const f32x2 g = {acc[ai][0][m][n][j], acc[ai][0][m][n][j + 1]}, uu = {acc[ai][1][m][n][j], acc[ai][1][m][n][j + 1]};
                          f32x2 e = g * c1v; e[0] = __builtin_amdgcn_exp2f(e[0]); e[1] = __builtin_amdgcn_exp2f(e[1]); e += one;
                          f32x2 sg; sg[0] = __builtin_amdgcn_rcpf(e[0]); sg[1] = __builtin_amdgcn_rcpf(e[1]);
                          const f32x2 h2 = (g * uu) * (sg * r13v); hv[n * 4 + j] = h2[0]; hv[n * 4 + j + 1] = h2[1]; } }
                u32x4 w; w.x = cvt_pk_bf16(hv[0], hv[1]); w.y = cvt_pk_bf16(hv[2], hv[3]); w.z = cvt_pk_bf16(hv[4], hv[5]); w.w = cvt_pk_bf16(hv[6], hv[7]);
                *(PG8_GAS u32x4*)(hid + (size_t)(u.pm * BM + rit) * 1024 + col0) = w; }
    }
};
struct EpiMoeDown {
    static constexpr bool PERM = true; static constexpr int NSTORE = 0;
    bf16_t* xb; float* ss; const int* lists;
    __device__ __forceinline__ void operator()(const f32x4 (&acc)[2][2][4][2], const Unit& u, int wr, int wc, int fr, int fq) const {
        const int pnl = u.x3, col0 = pnl * BM + wc * 32 + 8 * fq;
        const PG8_GAS int* lp = (const PG8_GAS int*)(lists + (size_t)u.x0 * 65536 + u.x1 * 256); const int last = u.x2 - 1;
        int tok[8];
#pragma unroll
        for (int q = 0; q < 8; ++q) { const int rit = (q >> 2) * HALF + wr * 64 + (q & 3) * 16 + fr; tok[q] = lp[rit < last ? rit : last]; }
#pragma unroll
        for (int ai = 0; ai < 2; ++ai) {
            u32x4 rv[4][2];
#pragma unroll
            for (int m = 0; m < 4; ++m)
#pragma unroll
                for (int bj = 0; bj < 2; ++bj) rv[m][bj] = *(const PG8_GAS u32x4*)(xb + (size_t)tok[ai * 4 + m] * 1024 + col0 + bj * HALF);
#pragma unroll
            for (int m = 0; m < 4; ++m) { const int rit = ai * HALF + wr * 64 + m * 16 + fr; const bool valid = rit <= last; float q = 0.f;
                bf16_t* rowp = xb + (size_t)tok[ai * 4 + m] * 1024 + col0;
#pragma unroll
                for (int bj = 0; bj < 2; ++bj) { const u32x4 r = rv[m][bj];
                    const f32x4 a0 = acc[ai][bj][m][0], a1 = acc[ai][bj][m][1];
                    const float v0 = bf_lo(r.x) + a0[0], v1 = bf_hi(r.x) + a0[1], v2 = bf_lo(r.y) + a0[2], v3 = bf_hi(r.y) + a0[3];
                    const float v4 = bf_lo(r.z) + a1[0], v5 = bf_hi(r.z) + a1[1], v6 = bf_lo(r.w) + a1[2], v7 = bf_hi(r.w) + a1[3];
                    q += ((v0 * v0 + v1 * v1) + (v2 * v2 + v3 * v3)) + ((v4 * v4 + v5 * v5) + (v6 * v6 + v7 * v7));
                    u32x4 w; w.x = cvt_pk_bf16(v0, v1); w.y = cvt_pk_bf16(v2, v3); w.z = cvt_pk_bf16(v4, v5); w.w = cvt_pk_bf16(v6, v7);
                    if (valid) *(PG8_GAS u32x4*)(rowp + bj * HALF) = w; }
                q += xor_lt32<16>(q); q = sum_halves(q); if (valid && fq == 0) ((PG8_GAS float*)ss)[(size_t)tok[ai * 4 + m] * 16 + pnl * 4 + wc] = q; }
        }
    }
};

template <class Epi, class Sched, bool ALIGN_EPI, bool GATHER, bool BSPLIT = false>
__device__ __forceinline__ void gemm_phase(PG8_LAS unsigned char* lds, const Gemm g, const Sched& S, const Epi& E) {
    const int tid = otid(), wid = __builtin_amdgcn_readfirstlane(tid >> 6), lane = tid & 63, wr = wid >> 2, wc = wid & 3, fr = lane & 15, fq = lane >> 4;
    const int K = g.K, nt = K / BK;
    unsigned voffA[2], voffB[2], cC2[2];
#pragma unroll
    for (int i = 0; i < 2; ++i) { int R, C; stage_rc(tid * 16 + i * 8192, R, C); const int Rb = Epi::PERM ? ((R & ~31) + perm32(R & 31)) : R;
        voffA[i] = (unsigned)(R * g.lda + C) * 2u; voffB[i] = (unsigned)(Rb * g.ldb + C) * 2u; cC2[i] = (unsigned)C * 2u; }
#define PG8_RR(i) ({ int R_, C_; stage_rc(tid * 16 + (i) * 8192, R_, C_); R_; })
    const size_t kstep = (size_t)(BK * 2);
    const size_t hstep = (size_t)HALF * g.lda * 2, hstepB = (size_t)HALF * g.ldb * 2;
    const size_t tstep = 2 * hstep, tstepB = 2 * hstepB;
    const unsigned ldsw = (unsigned)wid * 1024u;
    const int aoff = lds_byte(wr * 64 + fr, fq * 8), boff = lds_byte(wc * 32 + fr, fq * 8);
#define PG8_SA(b, h) (((b) * 2 + (h)) * HTB)
#define PG8_SB(b, h) ((4 + (b) * 2 + (h)) * HTB)
#define PG8_STAGE(bufoff, gbase, voff) do { _Pragma("unroll") for (int _i = 0; _i < 2; ++_i) \
        __builtin_amdgcn_global_load_lds((const unsigned*)((const char*)(gbase) + (voff)[_i]), (PG8_LAS unsigned*)(lds + (bufoff) + ldsw + _i * 8192), 16, 0, 0); } while (0)
#define PG8_STAGE_A(bufoff, h, kb, NX) do { if constexpr (GATHER) { const unsigned _p = (NX) ? nvA[h] : cvA[h]; unsigned _v[2]; _v[0] = (_p & 0xffffu) * (unsigned)(g.lda * 2) + cC2[0]; _v[1] = (_p >> 16) * (unsigned)(g.lda * 2) + cC2[1]; PG8_STAGE(bufoff, (const char*)g.A + (kb), _v); } \
        else { PG8_STAGE(bufoff, ((NX) ? nA : cA) + (h) * hstep + (kb), voffA); } } while (0)
#define PG8_LDA(dst, b, h) do { _Pragma("unroll") for (int m = 0; m < 4; ++m) _Pragma("unroll") for (int k = 0; k < 2; ++k) dst[m][k] = *(const PG8_LAS bf16x8*)(lds + PG8_SA(b, h) + aoff + m * 2048 + k * 1024); } while (0)
#define PG8_LDB(dst, b, h) do { _Pragma("unroll") for (int n = 0; n < 2; ++n) _Pragma("unroll") for (int k = 0; k < 2; ++k) dst[n][k] = *(const PG8_LAS bf16x8*)(lds + PG8_SB(b, h) + boff + n * 2048 + k * 1024); } while (0)
#define PG8_MMA(ai, bj, At, Bt) do { __builtin_amdgcn_s_setprio(1); _Pragma("unroll") for (int m = 0; m < 4; ++m) _Pragma("unroll") for (int n = 0; n < 2; ++n) _Pragma("unroll") for (int k = 0; k < 2; ++k) \
        acc[ai][bj][m][n] = __builtin_amdgcn_mfma_f32_16x16x32_bf16(Bt[n][k], At[m][k], acc[ai][bj][m][n], 0, 0, 0); __builtin_amdgcn_s_setprio(0); } while (0)
#define PG8_WAIT_V(n) asm volatile("s_waitcnt vmcnt(" #n ")" ::: "memory")
#define PG8_WAIT_L(n) asm volatile("s_waitcnt lgkmcnt(" #n ")" ::: "memory")
#define PG8_BAR __builtin_amdgcn_s_barrier()
#define PG8_SCHED __builtin_amdgcn_sched_barrier(0)
    Unit cur, nxt; int ui = 0;
    if constexpr (Sched::PRELOAD) { S.preload(tid); asm volatile("s_waitcnt vmcnt(0) lgkmcnt(0)" ::: "memory"); __builtin_amdgcn_s_barrier(); asm volatile("" ::: "memory"); }
    if (!S.next(0, cur)) return;
    cur.ui = 0;
    f32x4 acc[2][2][4][2];
#pragma unroll
    for (int a = 0; a < 2; ++a)
#pragma unroll
        for (int b = 0; b < 2; ++b)
#pragma unroll
            for (int m = 0; m < 4; ++m)
#pragma unroll
                for (int n = 0; n < 2; ++n) acc[a][b][m][n] = (f32x4){0.f, 0.f, 0.f, 0.f};
    bf16x8 At[4][2], B0[2][2], B1[2][2];
    unsigned cvA[2], nvA[2];
#define PG8_AOFF(pm_) (g.abatch ? (size_t)((pm_) >> 4) * (size_t)g.abatch + (size_t)((pm_) & 15) * tstep : (size_t)(pm_) * tstep)
    const char* cA = (const char*)g.A + (GATHER ? (size_t)0 : PG8_AOFF(cur.pm)); const char* cB = (const char*)g.Bt + (size_t)cur.pn * tstepB;
    const char* nA = cA;
    if constexpr (GATHER) {
#pragma unroll
        for (int h = 0; h < 2; ++h) { cvA[h] = S.rowoff(0, h * HALF + PG8_RR(0)) | (S.rowoff(0, h * HALF + PG8_RR(1)) << 16); nvA[h] = cvA[h]; }
    }
    PG8_STAGE(PG8_SB(0, 0), cB, voffB); PG8_STAGE(PG8_SB(0, 1), cB + hstepB, voffB); PG8_STAGE_A(PG8_SA(0, 0), 0, 0, false); PG8_STAGE_A(PG8_SA(0, 1), 1, 0, false);
    if (wr == 1) PG8_BAR;
    PG8_WAIT_V(2); PG8_BAR;
    PG8_STAGE(PG8_SB(1, 0), cB + kstep, voffB); PG8_STAGE_A(PG8_SA(1, 0), 0, kstep, false); PG8_STAGE(PG8_SB(1, 1), cB + hstepB + kstep, voffB);
    PG8_WAIT_V(6); PG8_BAR;
    for (;;) {
        const bool has_next = S.next(ui + 1, nxt);
        const char* nB = has_next ? (const char*)g.Bt + (size_t)nxt.pn * tstepB : cB;
        if constexpr (GATHER) {
            if (has_next) {
#pragma unroll
                for (int h = 0; h < 2; ++h) nvA[h] = S.rowoff(ui + 1, h * HALF + PG8_RR(0)) | (S.rowoff(ui + 1, h * HALF + PG8_RR(1)) << 16);
            } else { nvA[0] = cvA[0]; nvA[1] = cvA[1]; }
        } else { nA = has_next ? (const char*)g.A + PG8_AOFF(nxt.pm) : cA; }
#pragma unroll 1
        for (int t = 0; t < nt; t += 2) {
            const bool last = (t == nt - 2);
            const size_t k1 = (size_t)(t + 1) * kstep;
            const size_t k2 = last ? (size_t)0 : (size_t)(t + 2) * kstep, k3 = k2 + kstep;
            const char* b2 = last ? nB : cB + (size_t)(t + 2) * kstep; if (BSPLIT) { if (!last && 2 * (t + 2) >= nt) b2 += cur.bd; }
            const char* b3 = b2 + kstep;
            const bool rlx = (Epi::NSTORE >= 16) && (t == 0) && (ui > 0);
            PG8_LDB(B0, 0, 0); PG8_LDB(B1, 0, 1); PG8_SCHED; PG8_LDA(At, 0, 0); PG8_STAGE_A(PG8_SA(1, 1), 1, k1, false);
            if (rlx) PG8_WAIT_V(24); else PG8_WAIT_V(8); PG8_WAIT_L(0); PG8_BAR; PG8_MMA(0, 0, At, B0); PG8_MMA(0, 1, At, B1); PG8_BAR; PG8_SCHED;
            PG8_LDA(At, 0, 1); PG8_STAGE(PG8_SB(0, 0), b2, voffB); PG8_STAGE(PG8_SB(0, 1), b2 + hstepB, voffB); PG8_STAGE_A(PG8_SA(0, 0), 0, k2, last);
            if (rlx) PG8_WAIT_V(24); else PG8_WAIT_V(8); PG8_WAIT_L(0); PG8_BAR; PG8_MMA(1, 0, At, B0); PG8_MMA(1, 1, At, B1); PG8_BAR; PG8_SCHED;
            PG8_LDB(B0, 1, 0); PG8_LDB(B1, 1, 1); PG8_SCHED; PG8_LDA(At, 1, 0); PG8_STAGE_A(PG8_SA(0, 1), 1, k2, last);
            PG8_WAIT_V(8); PG8_WAIT_L(0); PG8_BAR; PG8_MMA(0, 0, At, B0); PG8_MMA(0, 1, At, B1); PG8_BAR; PG8_SCHED;
            PG8_LDA(At, 1, 1); PG8_STAGE(PG8_SB(1, 0), b3, voffB); PG8_STAGE(PG8_SB(1, 1), b3 + hstepB, voffB); PG8_STAGE_A(PG8_SA(1, 0), 0, k3, last);
            PG8_WAIT_V(8); PG8_WAIT_L(0); PG8_BAR; PG8_MMA(1, 0, At, B0); PG8_MMA(1, 1, At, B1); PG8_BAR; PG8_SCHED;
        }
        if constexpr (ALIGN_EPI) { if (wr == 0) PG8_BAR; }
        E(acc, cur, wr, wc, fr, fq);
        if (!has_next) break;
#pragma unroll
        for (int a = 0; a < 2; ++a)
#pragma unroll
            for (int b = 0; b < 2; ++b)
#pragma unroll
                for (int m = 0; m < 4; ++m)
#pragma unroll
                    for (int n = 0; n < 2; ++n) acc[a][b][m][n] = (f32x4){0.f, 0.f, 0.f, 0.f};
        cur = nxt; cA = nA; cB = nB; ++ui; cur.ui = ui;
        if constexpr (GATHER) { cvA[0] = nvA[0]; cvA[1] = nvA[1]; }
        if constexpr (ALIGN_EPI) { if (wr == 1) PG8_BAR; }
    }
    PG8_WAIT_V(0);
    if constexpr (!ALIGN_EPI) { if (wr == 0) PG8_BAR; }
    PG8_BAR;
#undef PG8_AOFF
#undef PG8_SA
#undef PG8_RR
#undef PG8_SB
#undef PG8_STAGE
#undef PG8_STAGE_A
#undef PG8_LDA
#undef PG8_LDB
#undef PG8_MMA
#undef PG8_WAIT_V
#undef PG8_WAIT_L
#undef PG8_BAR
#undef PG8_SCHED
}
}
constexpr int NB = 16, SEQ = 4096, DM = 1024, T = NB * SEQ, MEML = 256, MT = NB * MEML;
constexpr int NWAVES = 8, NTHR = 512;
constexpr float EPS = 1e-6f, LOG2E = 1.4426950408889634f;
constexpr size_t MiB = 1u << 20;
constexpr size_t WS_CTL = 0, CTL_ZERO_BYTES = 1 * MiB;
constexpr size_t WS_SS = 2 * MiB;
constexpr size_t WS_ROUTE = 6 * MiB;
constexpr size_t WS_WR = 7 * MiB;
constexpr size_t WS_DCH = 8 * MiB;
constexpr size_t WS_LISTS = 10 * MiB;
constexpr size_t WS_MEMN = 18 * MiB;
constexpr size_t WS_KV = 26 * MiB;
constexpr size_t WS_W = 90 * MiB;
constexpr size_t W_IN = 0, W_OUT = 6 * MiB, W_XQ = 8 * MiB, W_XO = 10 * MiB, W_LAYER = 12 * MiB, W_KV = 48 * MiB;
constexpr size_t WS_WM = 154 * MiB;
constexpr size_t WM_W2 = 32 * MiB;
constexpr size_t WS_XB = 202 * MiB;
constexpr size_t WS_MIX = 330 * MiB;
constexpr size_t WS_PROJ = 458 * MiB;
constexpr size_t WS_HID = WS_PROJ + 128 * MiB;
constexpr size_t WS_FOLD = 842 * MiB;
constexpr size_t WS_END = 906 * MiB;
constexpr int CW_TMO = 0, CW_BAR = 4096, CW_CNT = 8192;
constexpr int LDS_BYTES = 160 * 1024, MISC_OFF = LDS_BYTES - 2048;

#define GAS __attribute__((address_space(1)))
#define LAS __attribute__((address_space(3)))
typedef unsigned short bf16;
typedef unsigned v4u __attribute__((ext_vector_type(4)));
typedef unsigned v2u __attribute__((ext_vector_type(2)));
typedef float f32x4 __attribute__((ext_vector_type(4)));
typedef float f32x16 __attribute__((ext_vector_type(16)));
typedef short bf16x8 __attribute__((ext_vector_type(8)));
typedef short s16x4 __attribute__((ext_vector_type(4)));
typedef GAS unsigned gu32;
#define RLX_AGENT __ATOMIC_RELAXED, __HIP_MEMORY_SCOPE_AGENT
#define LDS_WAIT() asm volatile("s_waitcnt lgkmcnt(0)" ::: "memory")
#define VM_WAIT() asm volatile("s_waitcnt vmcnt(0)" ::: "memory")
#define MFMA32(a, b, c) __builtin_amdgcn_mfma_f32_32x32x16_bf16((a), (b), (c), 0, 0, 0)
#define MFMA16(a, b, c) __builtin_amdgcn_mfma_f32_16x16x32_bf16((a), (b), (c), 0, 0, 0)
typedef float f32x2_t __attribute__((ext_vector_type(2))); typedef __bf16 bf16x2_t __attribute__((ext_vector_type(2)));
__device__ __forceinline__ unsigned pk2(float lo, float hi) { f32x2_t v = {lo, hi}; bf16x2_t b = __builtin_convertvector(v, bf16x2_t); return __builtin_bit_cast(unsigned, b); }
__device__ __forceinline__ unsigned f2bf(float f) { return pk2(f, 0.f) & 0xffffu; }
__device__ __forceinline__ float bf2f(unsigned short b) { return __builtin_bit_cast(float, (unsigned)b << 16); }
__device__ __forceinline__ float bflo(unsigned w) { return __builtin_bit_cast(float, w << 16); }
__device__ __forceinline__ float bfhi(unsigned w) { return __builtin_bit_cast(float, w & 0xffff0000u); }
__device__ __forceinline__ float sigmoidf_(float x) { return __builtin_amdgcn_rcpf(1.0f + __expf(-x)); }
__device__ __forceinline__ float wave_sum(float v) {
    v += xor_lt32<1>(v); v += xor_lt32<2>(v); v += xor_lt32<4>(v); v += xor_lt32<8>(v); v += xor_lt32<16>(v);
    return sum_halves(v);
}
__device__ __forceinline__ int crow(int r, int hi) { return (r & 3) + 8 * (r >> 2) + 4 * hi; }

#define XB_TMO      128
#define XB_XCNT(j)  (256  + 64 * (j))
#define XB_XSUB(j)  (1280 + 64 * (j))
#define XB_XGEN(j)  (2304 + 64 * (j))
#define XB_TOP      3328
#define XB_TOPGEN   3392
#define XCD_BAR_WORDS 3456
#define XB_LCNT(j)  (3456 + 16 * (j))
#define XB_LGEN(j)  (3712 + 16 * (j))
#define XB_SPIN_CAP (1u << 20)
__device__ __forceinline__ unsigned xb_ld(unsigned* p)              { return __hip_atomic_load(p, __ATOMIC_RELAXED, __HIP_MEMORY_SCOPE_AGENT); }
__device__ __forceinline__ unsigned xb_add(unsigned* p, unsigned v) { return __hip_atomic_fetch_add(p, v, __ATOMIC_RELAXED, __HIP_MEMORY_SCOPE_AGENT); }
__device__ __forceinline__ unsigned xb_xcc_id() { return (unsigned)__builtin_amdgcn_s_getreg((3 << 11) | 20) & 0xFu; }
#define XB_SPIN(cond, bar) do { unsigned _sp = 0; while (cond) { __builtin_amdgcn_s_sleep(1); \
    if ((++_sp & 255u) == 0u) { if (xb_ld(&(bar)[XB_TMO])) break; if (_sp > XB_SPIN_CAP) { atomicAdd(&(bar)[XB_TMO], 1u); break; } } } } while (0)
struct XcdBarrier { unsigned* bar; unsigned x; volatile LAS unsigned* st; };
__device__ __forceinline__ XcdBarrier xcd_barrier_post(unsigned* bar, volatile LAS unsigned* st) {
    XcdBarrier b; b.bar = bar; b.x = xb_xcc_id(); b.st = st;
    if (otid() == 0) st[3] = xb_add(&bar[XB_XCNT(b.x)], 1u);
    return b;
}
__device__ __forceinline__ void xcd_barrier_complete(unsigned* bar, unsigned x, unsigned& nloc, unsigned& nx, unsigned& uni) {
    const unsigned G = gridDim.x * gridDim.y * gridDim.z;
    unsigned sum, cnt, mine, bad = 0u, sp = 0u;
    for (;;) {
        sum = 0u; cnt = 0u; mine = 0u;
        bad = 0u;
#pragma unroll 1
        for (unsigned j = 0; j < 16; ++j) { const unsigned c = xb_ld(&bar[XB_XCNT(j)]); sum += c; cnt += (c > 0u) ? 1u : 0u; mine = (j == x) ? c : mine; bad |= (c != 0u && (c * 8u != G || j >= 8u)) ? 1u : 0u; }
        if (sum == G) break;
        __builtin_amdgcn_s_sleep(1);
        if ((++sp & 255u) == 0u) { if (xb_ld(&bar[XB_TMO])) break; if (sp > XB_SPIN_CAP) { atomicAdd(&bar[XB_TMO], 1u); break; } }
    }
    nloc = mine > 0u ? mine : 1u; nx = cnt > 0u ? cnt : 1u; uni = (bad == 0u && cnt == 8u && sum == G) ? 1u : 0u;
}
__device__ __attribute__((noinline)) void xcd_barrier_impl(unsigned* bbar, unsigned bx, volatile LAS unsigned* bst, bool leader) {
    XcdBarrier b; b.bar = bbar; b.x = bx; b.st = bst;
    asm volatile("s_waitcnt vmcnt(0)" ::: "memory");
    __syncthreads();
    if (leader) {
        unsigned* bar = b.bar;
        __builtin_amdgcn_s_waitcnt(0);
        unsigned nloc = b.st[0], nx = b.st[1];
        if (nloc == 0u) { unsigned uni; xcd_barrier_complete(bar, b.x, nloc, nx, uni); b.st[0] = nloc; b.st[1] = nx; b.st[2] = uni; }
        const unsigned old = xb_add(&bar[XB_XSUB(b.x)], 1u);
        const unsigned gen = old / nloc;
        if (old + 1u == (gen + 1u) * nloc) {
            __builtin_amdgcn_fence(__ATOMIC_RELEASE, "agent");
            asm volatile("s_waitcnt vmcnt(0)" ::: "memory");
            const unsigned og = xb_add(&bar[XB_TOP], 1u);
            const unsigned tg = og / nx;
            if (og + 1u == (tg + 1u) * nx) xb_add(&bar[XB_TOPGEN], 1u);
            else XB_SPIN(xb_ld(&bar[XB_TOPGEN]) == tg, bar);
            __builtin_amdgcn_fence(__ATOMIC_ACQUIRE, "agent");
            xb_add(&bar[XB_XGEN(b.x)], 1u);
            asm volatile("s_waitcnt vmcnt(0)" ::: "memory");
        } else {
            XB_SPIN(xb_ld(&bar[XB_XGEN(b.x)]) == gen, bar);
            __builtin_amdgcn_fence(__ATOMIC_ACQUIRE, "agent");
            asm volatile("s_waitcnt vmcnt(0)" ::: "memory");
        }
    }
    __syncthreads();
}

__device__ __forceinline__ void xcd_barrier(const XcdBarrier& b) { xcd_barrier_impl(b.bar, b.x, b.st, otid() == 0); }
__device__ __attribute__((noinline)) void xcd_local_impl(unsigned* bar, unsigned x, volatile LAS unsigned* st, bool leader) {
    asm volatile("s_waitcnt vmcnt(0)" ::: "memory");
    __syncthreads();
    if (leader) {
        __builtin_amdgcn_s_waitcnt(0);
        const unsigned nloc = st[0];
        const unsigned old = xb_add(&bar[XB_LCNT(x)], 1u);
        const unsigned gen = old / nloc;
        if (old + 1u == (gen + 1u) * nloc) xb_add(&bar[XB_LGEN(x)], 1u);
        else XB_SPIN(xb_ld(&bar[XB_LGEN(x)]) == gen, bar);
        __builtin_amdgcn_fence(__ATOMIC_ACQUIRE, "agent");
        asm volatile("s_waitcnt vmcnt(0)" ::: "memory");
    }
    __syncthreads();
}
__device__ __forceinline__ void xcd_local_barrier(const XcdBarrier& b) { xcd_local_impl(b.bar, b.x, b.st, otid() == 0); }

struct Params {
    const float* in[33]; float* out; unsigned char* ws;
    float lam_init[2];
    unsigned char bucket[128];
};
__device__ __forceinline__ void transpose_item(const float* W, int N, int k0, int n0, bf16* WT, int KT, int orow0, const float* gain, float scale, LAS float* scr, int lane) {
    float wv[32];
#pragma unroll
    for (int i = 0; i < 32; ++i) wv[i] = ((const GAS float*)W)[(size_t)(k0 + 2 * i + (lane >> 5)) * N + n0 + (lane & 31)];
#pragma unroll
    for (int i = 0; i < 32; ++i) scr[(2 * i + (lane >> 5)) * 33 + (lane & 31)] = wv[i];
    LDS_WAIT(); asm volatile("" ::: "memory");
    const int c = lane & 7;
    float g[8];
#pragma unroll
    for (int j = 0; j < 8; ++j) g[j] = (gain ? ((const GAS float*)gain)[k0 + 8 * c + j] : 1.0f) * scale;
#pragma unroll
    for (int j = 0; j < 4; ++j) { const int n = (lane >> 3) + 8 * j; const LAS float* s = scr + (8 * c) * 33 + n;
        v4u o; o.x = pk2(s[0 * 33] * g[0], s[1 * 33] * g[1]); o.y = pk2(s[2 * 33] * g[2], s[3 * 33] * g[3]); o.z = pk2(s[4 * 33] * g[4], s[5 * 33] * g[5]); o.w = pk2(s[6 * 33] * g[6], s[7 * 33] * g[7]);
        *(GAS v4u*)(WT + (size_t)(orow0 + n) * KT + k0 + 8 * c) = o; }
    LDS_WAIT(); asm volatile("" ::: "memory");
}
__device__ __forceinline__ void convert_matrix(const float* W, int K, int N, bf16* WT, const float* gain, float scale_lo, int n_lo, int gw, int NGW, LAS float* scr, int lane, int glu_lo = 0) {
    const int nblk = N / 32, nit = (K / 64) * nblk;
    for (int it = gw; it < nit; it += NGW) { const int kb = it / nblk, nb = it % nblk; int orow0 = 32 * nb;
        if (glu_lo > 0 && orow0 >= glu_lo) { const int s_ = orow0 - glu_lo, c_ = s_ & 511; orow0 = glu_lo + (c_ >> 7) * 256 + (s_ >> 9) * 128 + (c_ & 127); }
        transpose_item(W, N, 64 * kb, 32 * nb, WT, K, orow0, gain, (32 * nb < n_lo) ? scale_lo : 1.0f, scr, lane); }
}
__device__ __forceinline__ void convert_moe(const float* w1, const float* w3, const float* w2, bf16* w13t, bf16* w2t, const float* gain, int gw, int NGW, LAS float* scr, int lane) {
    for (int it = gw; it < 3 * 4096; it += NGW) {
        const int which = it >> 12, r = it & 4095, e = r >> 8, q = r & 255;
        if (which < 2) { const int kb = q >> 4, nb = q & 15, n0 = 32 * nb;
            const float* W = (which == 0 ? w1 : w3) + (size_t)e * 1024 * 512;
            const int orow0 = e * 1024 + (n0 >> 7) * 256 + which * 128 + (n0 & 127);
            transpose_item(W, 512, 64 * kb, n0, w13t, 1024, orow0, gain, 1.0f, scr, lane);
        } else { const int kb = q >> 5, nb = q & 31;
            transpose_item(w2 + (size_t)e * 512 * 1024, 1024, 64 * kb, 32 * nb, w2t, 512, e * 1024 + 32 * nb, nullptr, 1.0f, scr, lane); }
    }
}
__device__ __forceinline__ void rows4_to_xb(const float* x, bf16* xbp, float* ss, int m0, int mstride, int lane) {
    f32x4 v[4][4];
#pragma unroll
    for (int q = 0; q < 4; ++q) { const GAS f32x4* xr = (const GAS f32x4*)(x + (size_t)(m0 + q * mstride) * 1024) + lane;
#pragma unroll
        for (int j = 0; j < 4; ++j) v[q][j] = xr[64 * j]; }
#pragma unroll
    for (int q = 0; q < 4; ++q) { float s = 0.f;
#pragma unroll
        for (int j = 0; j < 4; ++j) s += (v[q][j].x * v[q][j].x + v[q][j].y * v[q][j].y) + (v[q][j].z * v[q][j].z + v[q][j].w * v[q][j].w);
        s = wave_sum(s);
        GAS unsigned long long* o8 = (GAS unsigned long long*)(xbp + (size_t)(m0 + q * mstride) * 1024) + lane;
#pragma unroll
        for (int j = 0; j < 4; ++j) o8[64 * j] = (unsigned long long)pk2(v[q][j].x, v[q][j].y) | ((unsigned long long)pk2(v[q][j].z, v[q][j].w) << 32);
        if (lane < 16) ss[(size_t)(m0 + q * mstride) * 16 + lane] = (lane == 0) ? s : 0.f; }
}
__device__ __forceinline__ void row_norm_bf16(const float* xrow, const float* g, bf16* orow, int lane) {
    const GAS f32x4* xr = (const GAS f32x4*)xrow + lane; const GAS f32x4* gr = (const GAS f32x4*)g + lane;
    f32x4 v[4]; float s = 0.f;
#pragma unroll
    for (int j = 0; j < 4; ++j) { v[j] = xr[64 * j]; s += (v[j].x * v[j].x + v[j].y * v[j].y) + (v[j].z * v[j].z + v[j].w * v[j].w); }
    const float rr = __builtin_amdgcn_rsqf(wave_sum(s) * (1.0f / 1024.0f) + EPS);
    GAS unsigned long long* o8 = (GAS unsigned long long*)orow + lane;
#pragma unroll
    for (int j = 0; j < 4; ++j) { const f32x4 gg = gr[64 * j]; o8[64 * j] = (unsigned long long)pk2(v[j].x * rr * gg.x, v[j].y * rr * gg.y) | ((unsigned long long)pk2(v[j].z * rr * gg.z, v[j].w * rr * gg.w) << 32); }
}
__device__ __forceinline__ void rows4_final(const bf16* xbp, float* out, const float* ss, const f32x4 (&gg)[4], int m0, int mstride, int lane) {
    v2u w[4][4]; float rr[4];
#pragma unroll
    for (int q = 0; q < 4; ++q) { const GAS v2u* xr = (const GAS v2u*)(xbp + (size_t)(m0 + q * mstride) * 1024) + lane;
#pragma unroll
        for (int j = 0; j < 4; ++j) w[q][j] = xr[64 * j];
        rr[q] = pg8::row_rs(ss, m0 + q * mstride); }
#pragma unroll
    for (int q = 0; q < 4; ++q) { GAS f32x4* orr = (GAS f32x4*)(out + (size_t)(m0 + q * mstride) * 1024) + lane;
#pragma unroll
        for (int j = 0; j < 4; ++j) { f32x4 v; v.x = bflo(w[q][j].x) * rr[q] * gg[j].x; v.y = bfhi(w[q][j].x) * rr[q] * gg[j].y; v.z = bflo(w[q][j].y) * rr[q] * gg[j].z; v.w = bfhi(w[q][j].y) * rr[q] * gg[j].w; orr[64 * j] = v; } }
}

constexpr int HA_FS = 132, HA_Q = 0, HA_KK = 33792, HA_BL = 67584, HA_TOT = 101376, HA_KI = 103424, HA_VI = 123904, HA_AM = 144384, HA_END = 153600, HA_BS = 72, HA_IS = 160;
typedef short v4i16_t __attribute__((ext_vector_type(4)));
__device__ __forceinline__ bf16x8 tr_frag(const LAS bf16* img, int s0, int x0, int lane) {
    const LAS bf16* p = img + (s0 + ((lane & 15) >> 2)) * HA_IS + x0 + 16 * ((lane >> 4) & 1) + 4 * (lane & 3);
    const s16x4 lo = __builtin_bit_cast(s16x4, __builtin_amdgcn_ds_read_tr16_b64_v4i16((LAS v4i16_t*)p));
    const s16x4 hh = __builtin_bit_cast(s16x4, __builtin_amdgcn_ds_read_tr16_b64_v4i16((LAS v4i16_t*)(p + 4 * HA_IS)));
    return __builtin_shufflevector(lo, hh, 0, 1, 2, 3, 4, 5, 6, 7);
}
constexpr int HA_TAB = HA_END;
__device__ __forceinline__ void hgrn_phaseA(LAS unsigned char* lds, int first, int G, bf16* proj, bf16* mix, float* dch, const float* hgrn_lb, int j_even, bool xm) {
#define HG_XM(u_) (xm ? (512 * ((u_) & 7) + ((u_) >> 3)) : (u_))
    const int tid = otid(), lane = tid & 63, wid = __builtin_amdgcn_readfirstlane(tid >> 6);
    LAS float* Q = (LAS float*)(lds + HA_Q); LAS float* KK = (LAS float*)(lds + HA_KK); LAS float* BL = (LAS float*)(lds + HA_BL); LAS float* TOT = (LAS float*)(lds + HA_TOT); LAS float* TAB = (LAS float*)(lds + HA_TAB);
    LAS bf16* KI = (LAS bf16*)(lds + HA_KI); LAS bf16* VI = (LAS bf16*)(lds + HA_VI); LAS bf16* AM = (LAS bf16*)(lds + HA_AM);
    const int row = tid >> 3, cg = tid & 7, k0 = cg * 16;
    v4u zq0, zq1, zf0, zf1, zi0, zi1;
#define HA_LOAD(uv) do { const int uu = HG_XM(uv); const int b_ = (uu) >> 8, h_ = ((uu) >> 6) & 3, c_ = (uu) & 63; const bf16* pr_ = proj + ((size_t)b_ * SEQ + c_ * 64 + row) * 3072 + h_ * 128 + k0; \
        zq0 = *(const GAS v4u*)(pr_); zq1 = *(const GAS v4u*)(pr_ + 8); zf0 = *(const GAS v4u*)(pr_ + 512); zf1 = *(const GAS v4u*)(pr_ + 520); zi0 = *(const GAS v4u*)(pr_ + 1024); zi1 = *(const GAS v4u*)(pr_ + 1032); } while (0)
    if (first < 4096) HA_LOAD(first);
    float lbv[16]; int hprev = -1;
#pragma unroll
    for (int e = 0; e < 16; ++e) lbv[e] = 0.f;
    for (int uv = first; uv < 4096; uv += G) { const int u = HG_XM(uv);
        const int b = u >> 8, h = (u >> 6) & 3, c = u & 63; const size_t t0 = (size_t)b * SEQ + c * 64;
        {
            const unsigned zq[8] = {zq0.x, zq0.y, zq0.z, zq0.w, zq1.x, zq1.y, zq1.z, zq1.w};
            const unsigned zf[8] = {zf0.x, zf0.y, zf0.z, zf0.w, zf1.x, zf1.y, zf1.z, zf1.w};
            *(LAS v4u*)(VI + row * HA_IS + k0) = zi0; *(LAS v4u*)(VI + row * HA_IS + k0 + 8) = zi1;
            if (h != hprev) { hprev = h;
                const GAS f32x4* l0 = (const GAS f32x4*)(hgrn_lb + h * 128 + k0); const GAS f32x4* l1 = (const GAS f32x4*)(hgrn_lb + 512 + h * 128 + k0);
#pragma unroll
                for (int q4 = 0; q4 < 4; ++q4) { const f32x4 a = l0[q4], bq = l1[q4];
#pragma unroll
                    for (int e = 0; e < 4; ++e) lbv[4 * q4 + e] = (j_even == 1) ? sigmoidf_(bq[e] - a[e]) : 0.f; } }
#pragma unroll
            for (int q4 = 0; q4 < 4; ++q4) { f32x4 qv, kv, lv;
#pragma unroll
                for (int e = 0; e < 4; ++e) { const int jj = 4 * q4 + e; const unsigned wq = zq[jj >> 1], wf = zf[jj >> 1];
                    const float q_ = (jj & 1) ? bfhi(wq) : bflo(wq), f_ = (jj & 1) ? bfhi(wf) : bflo(wf);
                    const float lb = lbv[jj];
                    const float f = lb + (1.0f - lb) * sigmoidf_(f_);
                    qv[e] = q_ * sigmoidf_(q_); kv[e] = 1.0f - f; lv[e] = __logf(fmaxf(f, 1e-30f)); }
                *(LAS f32x4*)(Q + row * HA_FS + k0 + 4 * q4) = qv; *(LAS f32x4*)(KK + row * HA_FS + k0 + 4 * q4) = kv; *(LAS f32x4*)(BL + row * HA_FS + k0 + 4 * q4) = lv; }
        }
        if (uv + G < 4096) HA_LOAD(uv + G);
        __syncthreads();
        { const int k = tid & 127, sub = tid >> 7; float run = 0.f;
#pragma unroll
          for (int j = 0; j < 16; ++j) { const int rw = 16 * sub + j; run += BL[rw * HA_FS + k]; BL[rw * HA_FS + k] = run; }
          TOT[sub * 128 + k] = run; }
        __syncthreads();
        {
#pragma unroll
            for (int q4 = 0; q4 < 4; ++q4) { const f32x4 bl = *(const LAS f32x4*)(BL + row * HA_FS + k0 + 4 * q4); f32x4 qv = *(const LAS f32x4*)(Q + row * HA_FS + k0 + 4 * q4), kv = *(const LAS f32x4*)(KK + row * HA_FS + k0 + 4 * q4);
#pragma unroll
                for (int e = 0; e < 4; ++e) { qv[e] *= __expf(bl[e]); kv[e] *= __expf(fminf(-bl[e], 80.0f)); }
                *(LAS f32x4*)(Q + row * HA_FS + k0 + 4 * q4) = qv; *(LAS f32x4*)(KK + row * HA_FS + k0 + 4 * q4) = kv; }
            for (int e = tid; e < 1280; e += NTHR) { const int w = e >> 7, k = e & 127; const float t0_ = TOT[k], t1_ = TOT[128 + k], t2_ = TOT[256 + k], t3_ = TOT[384 + k];
                const float x = (w == 0) ? t0_ : (w == 1) ? t1_ : (w == 2) ? t2_ : (w == 3) ? t3_ : (w == 4) ? t1_ + t2_ : (w == 5) ? t0_ + t1_ : (w == 6) ? (t0_ + t1_) + t2_ : (w == 7) ? (t0_ + t1_) + (t2_ + t3_) : (w == 8) ? t1_ + (t2_ + t3_) : t2_ + t3_;
                TAB[e] = __expf(x); }
        }
        __syncthreads();
        for (int task = wid; task < 10; task += 8) {
            int it, is; int ga = -1;
            if (task < 4) { it = task; is = task; }
            else { const int pq = task - 4; it = (pq == 0) ? 1 : (pq <= 2 ? 2 : 3); is = (pq == 0) ? 0 : (pq == 1 ? 0 : (pq == 2 ? 1 : pq - 3));
                   ga = (it - is == 1) ? -1 : (it == 2 ? 1 : (is == 1 ? 2 : 4)); }
            const int r = lane & 15, quad = lane >> 4; f32x4 acc = {0.f, 0.f, 0.f, 0.f};
#pragma unroll
            for (int ks = 0; ks < 4; ++ks) { unsigned pa[4], pb[4]; const int kb = 32 * ks + 8 * quad;
#pragma unroll
                for (int q4 = 0; q4 < 2; ++q4) { f32x4 qv = *(const LAS f32x4*)(Q + (16 * it + r) * HA_FS + kb + 4 * q4), kv = *(const LAS f32x4*)(KK + (16 * is + r) * HA_FS + kb + 4 * q4);
                    if (task >= 4) { kv *= *(const LAS f32x4*)(TAB + is * 128 + kb + 4 * q4); if (ga >= 0) qv *= *(const LAS f32x4*)(TAB + ga * 128 + kb + 4 * q4); }
                    pa[2 * q4] = pk2(qv[0], qv[1]); pa[2 * q4 + 1] = pk2(qv[2], qv[3]); pb[2 * q4] = pk2(kv[0], kv[1]); pb[2 * q4 + 1] = pk2(kv[2], kv[3]); }
                const v4u va = {pa[0], pa[1], pa[2], pa[3]}, vb = {pb[0], pb[1], pb[2], pb[3]};
                acc = MFMA16(__builtin_bit_cast(bf16x8, va), __builtin_bit_cast(bf16x8, vb), acc); }
#pragma unroll
            for (int j = 0; j < 4; ++j) { const int tl = 4 * quad + j;
                if (task < 4) AM[(16 * it + tl) * HA_BS + 16 * is + r] = (r <= tl) ? (bf16)f2bf(acc[j]) : (bf16)0;
                else { AM[(16 * it + tl) * HA_BS + 16 * is + r] = (bf16)f2bf(acc[j]); AM[(16 * is + tl) * HA_BS + 16 * it + r] = (bf16)0; } }
        }
        {
            const int sc = row >> 4; unsigned qo[8], ko[8];
#pragma unroll
            for (int q4 = 0; q4 < 4; ++q4) { f32x4 qv = *(const LAS f32x4*)(Q + row * HA_FS + k0 + 4 * q4), kv = *(const LAS f32x4*)(KK + row * HA_FS + k0 + 4 * q4);
                if (sc > 0) qv *= *(const LAS f32x4*)(TAB + ((sc == 1) ? 0 : (sc == 2) ? 5 : 6) * 128 + k0 + 4 * q4);
                kv *= *(const LAS f32x4*)(TAB + ((sc == 0) ? 7 : (sc == 1) ? 8 : (sc == 2) ? 9 : 3) * 128 + k0 + 4 * q4);
                qo[2 * q4] = pk2(qv[0], qv[1]); qo[2 * q4 + 1] = pk2(qv[2], qv[3]); ko[2 * q4] = pk2(kv[0], kv[1]); ko[2 * q4 + 1] = pk2(kv[2], kv[3]); }
            bf16* pq = proj + (t0 + row) * 3072 + h * 128 + k0;
            *(GAS v4u*)(pq) = (v4u){qo[0], qo[1], qo[2], qo[3]}; *(GAS v4u*)(pq + 8) = (v4u){qo[4], qo[5], qo[6], qo[7]};
            *(LAS v4u*)(KI + row * HA_IS + k0) = (v4u){ko[0], ko[1], ko[2], ko[3]}; *(LAS v4u*)(KI + row * HA_IS + k0 + 8) = (v4u){ko[4], ko[5], ko[6], ko[7]};
            if (tid < 128) dch[(size_t)u * 128 + tid] = TAB[7 * 128 + tid];
        }
        __syncthreads();
        { const int r = lane & 31, hi = lane >> 5, tm = wid >> 2, tn = wid & 3; f32x16 acc = {};
#pragma unroll
          for (int ks = 0; ks < 4; ++ks) { const bf16x8 a = tr_frag(VI, 16 * ks + 8 * hi, 32 * tn, lane); const bf16x8 bb = *(const LAS bf16x8*)(AM + (32 * tm + r) * HA_BS + 16 * ks + 8 * hi); acc = MFMA32(a, bb, acc); }
          bf16* po = mix + (t0 + 32 * tm + r) * 1024 + h * 128 + 32 * tn + 4 * hi;
#pragma unroll
          for (int g4 = 0; g4 < 4; ++g4) { v2u w; w.x = pk2(acc[4 * g4], acc[4 * g4 + 1]); w.y = pk2(acc[4 * g4 + 2], acc[4 * g4 + 3]); *(GAS v2u*)(po + 8 * g4) = w; }
        }
        { const int r = lane & 31, hi = lane >> 5, tk = wid >> 1;
#pragma unroll
          for (int tv2 = 0; tv2 < 2; ++tv2) { const int tv = 2 * (wid & 1) + tv2; f32x16 acc = {};
#pragma unroll
              for (int ks = 0; ks < 4; ++ks) { const bf16x8 a = tr_frag(KI, 16 * ks + 8 * hi, 32 * tk, lane); const bf16x8 bb = tr_frag(VI, 16 * ks + 8 * hi, 32 * tv, lane); acc = MFMA32(a, bb, acc); }
              const int v = 32 * tv + r;
              bf16* pu = proj + (t0 + (v & 63)) * 3072 + (v < 64 ? 512 : 1024) + h * 128 + 32 * tk + 4 * hi;
#pragma unroll
              for (int g4 = 0; g4 < 4; ++g4) { v2u w; w.x = pk2(acc[4 * g4], acc[4 * g4 + 1]); w.y = pk2(acc[4 * g4 + 2], acc[4 * g4 + 3]); *(GAS v2u*)(pu + 8 * g4) = w; } }
        }
        __syncthreads();
    }
#undef HA_LOAD
}

__device__ __forceinline__ void hgrn_phaseB(bf16* proj, const float* dch, int G, int slot, bool xm) {
    const int tid = otid();
    for (int wv_ = slot; wv_ < 256; wv_ += G) { const int w_ = xm ? (32 * (wv_ & 7) + (wv_ >> 3)) : wv_; const int rid = w_ * 32 + (tid >> 4);
        const int bh = rid >> 7, v = rid & 127, b = bh >> 2, h = bh & 3, ks = (tid & 15) * 8;
        bf16* base = proj + ((size_t)b * SEQ + (v & 63)) * 3072 + (v < 64 ? 512 : 1024) + h * 128 + ks;
        const float* dbase = dch + (size_t)bh * 64 * 128 + ks;
        float st[8];
#pragma unroll
        for (int j = 0; j < 8; ++j) st[j] = 0.f;
        v4u ub[8]; f32x4 d0[8], d1[8];
#pragma unroll
        for (int j = 0; j < 8; ++j) { ub[j] = *(const GAS v4u*)(base + (size_t)j * 64 * 3072); d0[j] = *(const GAS f32x4*)(dbase + j * 128); d1[j] = *(const GAS f32x4*)(dbase + j * 128 + 4); }
        for (int c0 = 0; c0 < 64; c0 += 8) {
#pragma unroll
            for (int j = 0; j < 8; ++j) { const int c = c0 + j; bf16* p = base + (size_t)c * 64 * 3072;
                const v4u uu = ub[j]; const f32x4 da = d0[j], db = d1[j];
                v4u so; so.x = pk2(st[0], st[1]); so.y = pk2(st[2], st[3]); so.z = pk2(st[4], st[5]); so.w = pk2(st[6], st[7]);
                *(GAS v4u*)p = so;
                st[0] = da[0] * st[0] + bflo(uu.x); st[1] = da[1] * st[1] + bfhi(uu.x); st[2] = da[2] * st[2] + bflo(uu.y); st[3] = da[3] * st[3] + bfhi(uu.y);
                st[4] = db[0] * st[4] + bflo(uu.z); st[5] = db[1] * st[5] + bfhi(uu.z); st[6] = db[2] * st[6] + bflo(uu.w); st[7] = db[3] * st[7] + bfhi(uu.w);
                if (c + 8 < 64) { ub[j] = *(const GAS v4u*)(base + (size_t)(c + 8) * 64 * 3072); d0[j] = *(const GAS f32x4*)(dbase + (c + 8) * 128); d1[j] = *(const GAS f32x4*)(dbase + (c + 8) * 128 + 4); } }
        }
    }
}

__device__ __forceinline__ void hgrn_phaseC(LAS unsigned char* lds, int first, int G, const bf16* proj, bf16* mix, const float* gnorm, bool xm) {
    const int tid = otid(), lane = tid & 63, wid = __builtin_amdgcn_readfirstlane(tid >> 6);
    LAS float* OF = (LAS float*)lds;
    constexpr int CI = 136; LAS bf16* SI = (LAS bf16*)(lds + 64 * 132 * 4); LAS bf16* QI = SI + 128 * CI;
    const int r = lane & 31, hi = lane >> 5, tm = wid >> 2, tn = wid & 3;
    const int row = tid >> 3, cg = tid & 7, v0 = cg * 16;
    const int crow_ = tid >> 4, ckc = tid & 15;
    v4u sc[4], qc[2]; v2u ol[4]; v4u g0, g1;
#define HC_LOAD(uv) do { const int uu = HG_XM(uv); const int b_ = (uu) >> 8, h_ = ((uu) >> 6) & 3, c_ = (uu) & 63; const size_t t0_ = (size_t)b_ * SEQ + c_ * 64; \
        _Pragma("unroll") for (int j = 0; j < 4; ++j) { const int v_ = crow_ + 32 * j; sc[j] = *(const GAS v4u*)(proj + (t0_ + (v_ & 63)) * 3072 + (v_ < 64 ? 512 : 1024) + h_ * 128 + 8 * ckc); } \
        _Pragma("unroll") for (int j = 0; j < 2; ++j) qc[j] = *(const GAS v4u*)(proj + (t0_ + crow_ + 32 * j) * 3072 + h_ * 128 + 8 * ckc); \
        const bf16* pl_ = mix + (t0_ + 32 * tm + r) * 1024 + h_ * 128 + 32 * tn + 4 * hi; _Pragma("unroll") for (int g4 = 0; g4 < 4; ++g4) ol[g4] = *(const GAS v2u*)(pl_ + 8 * g4); \
        const bf16* pg_ = proj + (t0_ + row) * 3072 + 1536 + h_ * 128 + v0; g0 = *(const GAS v4u*)pg_; g1 = *(const GAS v4u*)(pg_ + 8); } while (0)
    if (first < 4096) HC_LOAD(first);
    float gn[16];
#pragma unroll
    for (int j = 0; j < 16; ++j) gn[j] = gnorm[v0 + j];
    for (int uv = first; uv < 4096; uv += G) { const int u = HG_XM(uv);
        const int b = u >> 8, h = (u >> 6) & 3, c = u & 63; const size_t t0 = (size_t)b * SEQ + c * 64;
#pragma unroll
        for (int j = 0; j < 4; ++j) *(LAS v4u*)(SI + (crow_ + 32 * j) * CI + 8 * ckc) = sc[j];
#pragma unroll
        for (int j = 0; j < 2; ++j) *(LAS v4u*)(QI + (crow_ + 32 * j) * CI + 8 * ckc) = qc[j];
        __syncthreads();
        { f32x16 acc = {}; bf16x8 af[8], bfr[8];
#pragma unroll
          for (int ks = 0; ks < 8; ++ks) { af[ks] = *(const LAS bf16x8*)(SI + (32 * tn + r) * CI + 16 * ks + 8 * hi); bfr[ks] = *(const LAS bf16x8*)(QI + (32 * tm + r) * CI + 16 * ks + 8 * hi); }
#pragma unroll
          for (int ks = 0; ks < 8; ++ks) acc = MFMA32(af[ks], bfr[ks], acc);
#pragma unroll
          for (int g4 = 0; g4 < 4; ++g4) { const v2u w = ol[g4];
              f32x4 o; o[0] = acc[4 * g4] + bflo(w.x); o[1] = acc[4 * g4 + 1] + bfhi(w.x); o[2] = acc[4 * g4 + 2] + bflo(w.y); o[3] = acc[4 * g4 + 3] + bfhi(w.y);
              *(LAS f32x4*)(OF + (32 * tm + r) * 132 + 32 * tn + 8 * g4 + 4 * hi) = o; }
        }
        const unsigned zg[8] = {g0.x, g0.y, g0.z, g0.w, g1.x, g1.y, g1.z, g1.w};
        if (uv + G < 4096) HC_LOAD(uv + G);
        __syncthreads();
        { float o[16]; float s2 = 0.f;
#pragma unroll
          for (int j = 0; j < 4; ++j) { const f32x4 x = *(const LAS f32x4*)(OF + row * 132 + v0 + 4 * j); o[4 * j] = x[0]; o[4 * j + 1] = x[1]; o[4 * j + 2] = x[2]; o[4 * j + 3] = x[3]; s2 += (x[0] * x[0] + x[1] * x[1]) + (x[2] * x[2] + x[3] * x[3]); }
          s2 += xor_lt32<1>(s2); s2 += xor_lt32<2>(s2); s2 += xor_lt32<4>(s2);
          const float rr = __builtin_amdgcn_rsqf(s2 * (1.0f / 128.0f) + EPS);
          unsigned w[8];
#pragma unroll
          for (int p = 0; p < 8; ++p) { const float a = o[2 * p] * rr * gn[2 * p] * sigmoidf_(bflo(zg[p])); const float bq = o[2 * p + 1] * rr * gn[2 * p + 1] * sigmoidf_(bfhi(zg[p])); w[p] = pk2(a, bq); }
          bf16* po = mix + (t0 + row) * 1024 + h * 128 + v0;
          *(GAS v4u*)po = (v4u){w[0], w[1], w[2], w[3]}; *(GAS v4u*)(po + 8) = (v4u){w[4], w[5], w[6], w[7]};
        }
        __syncthreads();
    }
#undef HC_LOAD
}

constexpr int CV_R = 64;
__device__ __forceinline__ void conv_unit(LAS unsigned char* lds, int u, const bf16* proj, bf16* mix, const float* dw, const float* db, const float* lng, const float* lnb) {
    const int tid = otid(), lane = tid & 63, wid = __builtin_amdgcn_readfirstlane(tid >> 6);
    constexpr int UPS = SEQ / CV_R;
    const int b = u / UPS, tb = u % UPS, ch = tid;
    LAS float* CB = (LAS float*)lds;
    LAS float* STAT = (LAS float*)(lds + CV_R * 516 * 4);
    float uu[CV_R + 30];
#pragma unroll
    for (int j = 0; j < CV_R + 30; ++j) { const int tt = tb * CV_R - 30 + j; float val = 0.f;
        { const int tc = tt < 0 ? 0 : tt; const GAS bf16* p = (const GAS bf16*)(proj + ((size_t)b * SEQ + tc) * 3072 + 2048 + ch); val = bf2f(p[0]); }
        uu[j] = (tt >= 0) ? val : 0.f; }
    float w[31];
#pragma unroll
    for (int j = 0; j < 31; ++j) w[j] = ((const GAS float*)dw)[j * 512 + ch];
    const float bias = db[ch];
    float cv[CV_R];
#pragma unroll
    for (int i = 0; i < CV_R; ++i) { float a = bias;
#pragma unroll
        for (int j = 0; j < 31; ++j) a += w[j] * uu[i + j];
        cv[i] = a; CB[i * 516 + ch] = a; }
    __syncthreads();
#pragma unroll
    for (int rr = 0; rr < CV_R / 8; ++rr) { const int row = wid * (CV_R / 8) + rr; float s = 0.f; float x[8];
#pragma unroll
        for (int j = 0; j < 8; ++j) { x[j] = CB[row * 516 + lane + 64 * j]; s += x[j]; }
        const float mean = wave_sum(s) * (1.0f / 512.0f); float q = 0.f;
#pragma unroll
        for (int j = 0; j < 8; ++j) { const float d = x[j] - mean; q += d * d; }
        const float var = wave_sum(q) * (1.0f / 512.0f);
        if (lane == 0) { STAT[row * 2] = mean; STAT[row * 2 + 1] = __builtin_amdgcn_rsqf(var + EPS); } }
    __syncthreads();
    const float g = lng[ch], bb = lnb[ch];
#pragma unroll
    for (int i = 0; i < CV_R; ++i) { const float y = (cv[i] - STAT[i * 2]) * STAT[i * 2 + 1] * g + bb; ((GAS bf16*)mix)[((size_t)b * SEQ + tb * CV_R + i) * 1024 + 512 + ch] = (bf16)f2bf(y * sigmoidf_(y)); }
    __syncthreads();
}

__device__ __forceinline__ void router_tile256(LAS unsigned char* lds, int tile, const bf16* xb, const float* ss, const bf16* wr, const float* b_grp, const float* b_exp,
                                               unsigned* route, int* lists, unsigned* gcnt  , bool commit = true) {
    const int tid = otid(), lane = tid & 63, wid = __builtin_amdgcn_readfirstlane(tid >> 6);
    LAS float* LG = (LAS float*)lds + wid * (32 * 33);
    LAS int* LC = (LAS int*)(lds + 8 * 32 * 33 * 4);
    if (tid < 64) LC[tid] = 0;
    __syncthreads();
    const int r = lane & 31, hi = lane >> 5; const int tok0 = tile * 256 + wid * 32;
    f32x16 acc = {};
    const bf16* pa = wr + (size_t)r * 1024 + 8 * hi;
    const bf16* pb = xb + (size_t)(tok0 + r) * 1024 + 8 * hi;
    for (int k0 = 0; k0 < 64; k0 += 16) { bf16x8 av[16], bv[16];
#pragma unroll
        for (int ks = 0; ks < 16; ++ks) { av[ks] = *(const GAS bf16x8*)(pa + 16 * (k0 + ks)); bv[ks] = *(const GAS bf16x8*)(pb + 16 * (k0 + ks)); }
#pragma unroll
        for (int ks = 0; ks < 16; ++ks) acc = MFMA32(av[ks], bv[ks], acc); }
    const float rr = pg8::row_rs(ss, tok0 + r);
#pragma unroll
    for (int i = 0; i < 16; ++i) LG[r * 33 + crow(i, hi)] = acc[i] * rr;
    LDS_WAIT(); asm volatile("" ::: "memory");
    int ea = 0, eb = 0, pa_ = 0, pb_ = 0; float wa = 0.f, wb = 0.f; const int tok = tok0 + r;
    if (hi == 0) {
        float gl[4];
#pragma unroll
        for (int j = 0; j < 4; ++j) gl[j] = LG[r * 33 + j] + b_grp[j];
        int gs = 0; float gm = gl[0];
#pragma unroll
        for (int j = 1; j < 4; ++j) if (gl[j] > gm) { gm = gl[j]; gs = j; }
        float den = 0.f;
#pragma unroll
        for (int j = 0; j < 4; ++j) den += __expf(gl[j] - gm);
        const float gw = __builtin_amdgcn_rcpf(den);
        float el[4];
#pragma unroll
        for (int j = 0; j < 4; ++j) el[j] = LG[r * 33 + 4 + gs * 4 + j] + b_exp[gs * 4 + j];
        int i1 = 0; float v1 = el[0];
#pragma unroll
        for (int j = 1; j < 4; ++j) if (el[j] > v1) { v1 = el[j]; i1 = j; }
        int i2 = -1; float v2 = 0.f;
#pragma unroll
        for (int j = 0; j < 4; ++j) if (j != i1 && (i2 < 0 || el[j] > v2)) { v2 = el[j]; i2 = j; }
        const float e2 = __expf(v2 - v1); { const float ri = __builtin_amdgcn_rcpf(1.0f + e2); wa = gw * ri; wb = gw * e2 * ri; }
        const int plo = i1 < i2 ? i1 : i2, phi = i1 < i2 ? i2 : i1;
        ea = gs * 6 + ((plo * (7 - plo)) >> 1) + (phi - plo - 1); eb = 0;
        const float wlo = (i1 < i2) ? wa : wb, whi = (i1 < i2) ? wb : wa;
        if (commit) pa_ = __hip_atomic_fetch_add(&LC[ea], 1, __ATOMIC_RELAXED, __HIP_MEMORY_SCOPE_WORKGROUP);
        *(GAS v4u*)(route + (size_t)tok * 4) = (v4u){(unsigned)((gs * 4 + plo) | ((gs * 4 + phi) << 8)), pk2(rr, rr * wlo), pk2(rr, rr * whi), __builtin_bit_cast(unsigned, rr)};
    }
    __syncthreads();
    if (tid < 32 && commit) LC[32 + tid] = (int)__hip_atomic_fetch_add(gcnt + 32 * tid, (unsigned)LC[tid], RLX_AGENT);
    __syncthreads();
    if (hi == 0 && commit) lists[(size_t)ea * 65536 + LC[32 + ea] + pa_] = tok;
    __syncthreads();
}
typedef short v4i16_att_t __attribute__((ext_vector_type(4)));
constexpr int ATT_TPS = 1;
template <int KW> struct AttnLdsR {
    static constexpr int KSTR = KW + 8, KBYTES = 64 * KSTR * 2, VBYTES = 64 * 256;
    static constexpr int K0 = 0, V0 = 2 * ATT_TPS * KBYTES, LUT = V0 + 2 * ATT_TPS * VBYTES, END = LUT + 512;
};
template <int KW, int DK, bool CAUSAL, bool PREFETCH>
__device__ __forceinline__ void attn_block_reg(LAS unsigned char* lds, const bf16* Qw  , int qpitch,
                                           const bf16* Kg, int kpitch, const bf16* Vg, int vpitch, int ntiles, int kmapoff, int qpos0  ,
                                           f32x16 (&o)[4], float& m_run, float& l_run) {
    typedef AttnLdsR<KW> L;
    const int tid = otid(), lane = tid & 63, wid = __builtin_amdgcn_readfirstlane(tid >> 6), r = lane & 31, hi = lane >> 5;
    bf16x8 qf[DK / 16];
#pragma unroll
    for (int ks = 0; ks < DK / 16; ++ks) qf[ks] = *(const GAS bf16x8*)(Qw + (size_t)r * qpitch + 16 * ks + 8 * hi);
#pragma unroll
    for (int vt = 0; vt < 4; ++vt) o[vt] = (f32x16){};
    m_run = -1e30f; l_run = 0.f;
    constexpr int KCH = KW / 64;
    const int vkey = tid >> 4, vc = tid & 15;
    v4u kreg[ATT_TPS][KCH], vreg[ATT_TPS][2];
    const LAS float* lut = (const LAS float*)(lds + L::LUT);
    unsigned koff[KCH];
#pragma unroll
    for (int i_ = 0; i_ < KCH; ++i_) { const int c_ = tid + i_ * NTHR, key_ = c_ / (KW / 8), kc_ = c_ % (KW / 8); koff[i_] = (unsigned)(key_ * kpitch + 8 * kc_) * 2u; }
    const unsigned voff0 = (unsigned)(vkey * vpitch + 8 * vc) * 2u, voff1 = voff0 + (unsigned)(32 * vpitch) * 2u;
    const int vst0 = ((vkey >> 3) * 4 + (vc >> 2)) * 512 + (vkey & 7) * 64 + (vc & 3) * 16;
    const int vbase = (4 * hi + ((lane & 15) >> 2)) * 64 + 32 * ((lane >> 4) & 1) + 8 * (lane & 3);
#define ATT_LOADK(t, sl) do { const char* kt_ = (const char*)Kg + (size_t)(t) * 64 * kpitch * 2; _Pragma("unroll") for (int i_ = 0; i_ < KCH; ++i_) kreg[sl][i_] = *(const GAS v4u*)(kt_ + koff[i_]); } while (0)
#define ATT_LOADV(t, sl) do { const char* vt2_ = (const char*)Vg + (size_t)(t) * 64 * vpitch * 2; vreg[sl][0] = *(const GAS v4u*)(vt2_ + voff0); vreg[sl][1] = *(const GAS v4u*)(vt2_ + voff1); } while (0)
#define ATT_STORE(buf, sl) do { _Pragma("unroll") for (int i_ = 0; i_ < KCH; ++i_) { const int c_ = tid + i_ * NTHR, key_ = c_ / (KW / 8), kc_ = c_ % (KW / 8); \
        *(LAS v4u*)(lds + L::K0 + (buf) * L::KBYTES + (key_ * L::KSTR + 8 * kc_) * 2) = kreg[sl][i_]; } \
        { LAS unsigned char* vt_ = lds + L::V0 + (buf) * L::VBYTES + vst0; *(LAS v4u*)vt_ = vreg[sl][0]; *(LAS v4u*)(vt_ + 8192) = vreg[sl][1]; } } while (0)
#pragma unroll
    for (int j_ = 0; j_ < ATT_TPS; ++j_) { ATT_LOADK(j_, j_); ATT_LOADV(j_, j_); }
#pragma unroll
    for (int j_ = 0; j_ < ATT_TPS; ++j_) ATT_STORE(j_, j_);
    __syncthreads();
    const int nsteps = ntiles / ATT_TPS;
    for (int st = 0; st < nsteps; ++st) {
        const int cur = st & 1;
        if (st + 1 < nsteps) {
#pragma unroll
            for (int j_ = 0; j_ < ATT_TPS; ++j_) { ATT_LOADK(ATT_TPS * (st + 1) + j_, j_); ATT_LOADV(ATT_TPS * (st + 1) + j_, j_); } }
#pragma unroll
        for (int sub = 0; sub < ATT_TPS; ++sub) {
        const int t = ATT_TPS * st + sub, buf = cur * ATT_TPS + sub;
        const bool active = !CAUSAL || (64 * t <= qpos0 + 31);
        if (active) {
            const LAS unsigned char* kb = lds + L::K0 + buf * L::KBYTES;
            const LAS unsigned char* vb = lds + L::V0 + buf * L::VBYTES;
            f32x16 s0 = {}, s1 = {};
            {
                constexpr int NG = DK / 64;
                const LAS unsigned char* ka0 = kb + ((r) * L::KSTR + kmapoff + 8 * hi) * 2;
                const LAS unsigned char* ka1 = ka0 + 32 * L::KSTR * 2;
                bf16x8 kf[2][8];
#pragma unroll
                for (int j = 0; j < 4; ++j) { kf[0][2 * j] = *(const LAS bf16x8*)(ka0 + 32 * j); kf[0][2 * j + 1] = *(const LAS bf16x8*)(ka1 + 32 * j); }
#pragma unroll
                for (int g = 0; g < NG; ++g) {
                    if (g + 1 < NG) {
#pragma unroll
                        for (int j = 0; j < 4; ++j) { kf[(g + 1) & 1][2 * j] = *(const LAS bf16x8*)(ka0 + 128 * (g + 1) + 32 * j); kf[(g + 1) & 1][2 * j + 1] = *(const LAS bf16x8*)(ka1 + 128 * (g + 1) + 32 * j); }
                    }
#pragma unroll
                    for (int j = 0; j < 4; ++j) { s0 = MFMA32(kf[g & 1][2 * j], qf[4 * g + j], s0); s1 = MFMA32(kf[g & 1][2 * j + 1], qf[4 * g + j], s1); }
                    __builtin_amdgcn_sched_barrier(0);
                }
            }
            if (CAUSAL && (qpos0 - (64 * t + 63) < 128)) {
                const int qp = qpos0 + r;
#pragma unroll
                for (int i = 0; i < 16; ++i) { const int n0 = qp - (64 * t + crow(i, hi)), n1 = n0 - 32;
                    const float b0 = lut[min(max(n0, 0), 127)], b1 = lut[min(max(n1, 0), 127)];
                    s0[i] = (n0 < 0) ? -1e30f : s0[i] + b0;
                    s1[i] = (n1 < 0) ? -1e30f : s1[i] + b1; }
            }
            float mx = fmaxf(s0[0], s1[0]);
#pragma unroll
            for (int i = 1; i < 16; ++i) mx = __builtin_fmaxf(__builtin_fmaxf(mx, s0[i]), s1[i]);
            mx = fmaxf(mx, __shfl_xor(mx, 32));
            const float mnc = fmaxf(m_run, mx);
            const bool resc = __any(mnc > m_run + 8.0f);
            const float mn = resc ? mnc : m_run;
            float ps = 0.f;
#pragma unroll
            for (int i = 0; i < 16; ++i) { s0[i] = __builtin_amdgcn_exp2f(s0[i] - mn); s1[i] = __builtin_amdgcn_exp2f(s1[i] - mn); ps += s0[i] + s1[i]; }
            if (resc) {
                const float alpha = __builtin_amdgcn_exp2f(m_run - mn); l_run *= alpha;
#pragma unroll
                for (int vt = 0; vt < 4; ++vt)
#pragma unroll
                    for (int i = 0; i < 16; ++i) o[vt][i] *= alpha;
            }
            m_run = mn; l_run += ps;
            bf16x8 pf[4];
#pragma unroll
            for (int s = 0; s < 2; ++s) {
                v4u w0, w1;
                w0.x = pk2(s0[8 * s], s0[8 * s + 1]); w0.y = pk2(s0[8 * s + 2], s0[8 * s + 3]); w0.z = pk2(s0[8 * s + 4], s0[8 * s + 5]); w0.w = pk2(s0[8 * s + 6], s0[8 * s + 7]);
                w1.x = pk2(s1[8 * s], s1[8 * s + 1]); w1.y = pk2(s1[8 * s + 2], s1[8 * s + 3]); w1.z = pk2(s1[8 * s + 4], s1[8 * s + 5]); w1.w = pk2(s1[8 * s + 6], s1[8 * s + 7]);
                pf[s] = __builtin_bit_cast(bf16x8, w0); pf[2 + s] = __builtin_bit_cast(bf16x8, w1); }
            {
                const LAS unsigned char* vp0 = vb + vbase;
                s16x4 vl[2][4], vh[2][4];
#define ATT_TR(p_) __builtin_bit_cast(s16x4, __builtin_amdgcn_ds_read_tr16_b64_v4i16((LAS v4i16_t*)(p_)))
#pragma unroll
                for (int vt = 0; vt < 4; ++vt) { vl[0][vt] = ATT_TR(vp0 + vt * 512); vh[0][vt] = ATT_TR(vp0 + vt * 512 + 2048); }
#pragma unroll
                for (int f = 0; f < 4; ++f) {
                    if (f + 1 < 4) {
#pragma unroll
                        for (int vt = 0; vt < 4; ++vt) { vl[(f + 1) & 1][vt] = ATT_TR(vp0 + ((2 * (f + 1)) * 4 + vt) * 512); vh[(f + 1) & 1][vt] = ATT_TR(vp0 + ((2 * (f + 1)) * 4 + vt) * 512 + 2048); }
                    }
                    __builtin_amdgcn_s_setprio(1);
#pragma unroll
                    for (int vt = 0; vt < 4; ++vt) { const bf16x8 a = __builtin_shufflevector(vl[f & 1][vt], vh[f & 1][vt], 0, 1, 2, 3, 4, 5, 6, 7); o[vt] = MFMA32(a, pf[f], o[vt]); }
                    __builtin_amdgcn_s_setprio(0);
                    __builtin_amdgcn_sched_barrier(0);
                }
            }
        }
        }
        if (st + 1 < nsteps) {
#pragma unroll
            for (int j_ = 0; j_ < ATT_TPS; ++j_) ATT_STORE((cur ^ 1) * ATT_TPS + j_, j_); }
        __syncthreads();
    }
#undef ATT_LOADK
#undef ATT_LOADV
#undef ATT_STORE
#undef ATT_TR
}

__device__ __forceinline__ void diffattn_unit(LAS unsigned char* lds, int b, int h, int qb, const bf16* proj, bf16* mix, float lam, float lam_init, const float* subg,
                                              const float* rel_bias, const LAS unsigned char* bucket) {
    typedef AttnLdsR<128> L;
    const int tid = otid(), lane = tid & 63, wid = __builtin_amdgcn_readfirstlane(tid >> 6), r = lane & 31, hi = lane >> 5;
    const int map = wid >> 2, wq = wid & 3, q0 = qb * 128 + wq * 32;
    if (tid < 128) { const float c31 = rel_bias[31 * 8 + h]; ((LAS float*)(lds + L::LUT))[tid] = (rel_bias[bucket[tid] * 8 + h] - c31) * LOG2E; }
    const size_t rb = (size_t)b * SEQ;
    f32x16 o[4]; float m_run, l_run;
    attn_block_reg<128, 64, true, true>(lds, proj + (rb + q0) * 3072 + h * 128 + map * 64, 3072, proj + rb * 3072 + 1024 + h * 128, 3072, proj + rb * 3072 + 2048 + h * 128, 3072,
                              (qb * 128 + 128) / 64, map * 64, q0, o, m_run, l_run);
    const float lt = sum_halves(l_run), inv = __builtin_amdgcn_rcpf(lt);
    LAS float* XO = (LAS float*)lds;
    if (map == 1) {
#pragma unroll
        for (int vt = 0; vt < 4; ++vt)
#pragma unroll
            for (int g4 = 0; g4 < 4; ++g4) { f32x4 x; x[0] = o[vt][4 * g4] * inv; x[1] = o[vt][4 * g4 + 1] * inv; x[2] = o[vt][4 * g4 + 2] * inv; x[3] = o[vt][4 * g4 + 3] * inv;
                *(LAS f32x4*)(XO + (wq * 32 + r) * 132 + 32 * vt + 8 * g4 + 4 * hi) = x; }
    }
    __syncthreads();
    if (map == 0) {
        float ssq = 0.f;
#pragma unroll
        for (int vt = 0; vt < 4; ++vt)
#pragma unroll
            for (int g4 = 0; g4 < 4; ++g4) { const f32x4 x2 = *(const LAS f32x4*)(XO + (wq * 32 + r) * 132 + 32 * vt + 8 * g4 + 4 * hi);
#pragma unroll
                for (int j = 0; j < 4; ++j) { const float v = o[vt][4 * g4 + j] * inv - lam * x2[j]; o[vt][4 * g4 + j] = v; ssq += v * v; } }
        ssq = sum_halves(ssq);
        const float sc = (1.0f - lam_init) * __builtin_amdgcn_rsqf(ssq * (1.0f / 128.0f) + EPS);
        bf16* po = mix + (rb + q0 + r) * 1024 + h * 128 + 4 * hi; const GAS float* sgp = (const GAS float*)subg;
#pragma unroll
        for (int vt = 0; vt < 4; ++vt)
#pragma unroll
            for (int g4 = 0; g4 < 4; ++g4) { const int v0 = 32 * vt + 8 * g4 + 4 * hi;
                v2u w; w.x = pk2(o[vt][4 * g4] * sc * sgp[v0], o[vt][4 * g4 + 1] * sc * sgp[v0 + 1]); w.y = pk2(o[vt][4 * g4 + 2] * sc * sgp[v0 + 2], o[vt][4 * g4 + 3] * sc * sgp[v0 + 3]);
                *(GAS v2u*)(po + 32 * vt + 8 * g4) = w; }
    }
    __syncthreads();
}

__device__ __forceinline__ const float* pin_ptr(LAS unsigned char* lds, int k) {
    int ko = k * 8; asm volatile("" : "+v"(ko));
    const unsigned long long v = *(const LAS unsigned long long*)(lds + MISC_OFF + 512 + ko);
    const unsigned lo = __builtin_amdgcn_readfirstlane((unsigned)v), hi = __builtin_amdgcn_readfirstlane((unsigned)(v >> 32));
    return (const float*)(((unsigned long long)hi << 32) | lo);
}
__global__ void __launch_bounds__(NTHR, 2) mk_fwd(Params P) {
    static_assert(WAVE_TAB_OFF == MISC_OFF + 1024 && HA_TAB + 5120 <= MISC_OFF, "LDS map");
    if ((threadIdx.x & 63) == 0) ((LAS int*)((LAS unsigned char*)lds_raw + WAVE_TAB_OFF))[hw_slot()] = (int)(threadIdx.x >> 6);
    __syncthreads();
    unsigned ldsb = (unsigned)(size_t)(LAS unsigned char*)lds_raw;
    asm volatile("" : "+s"(ldsb));
#define lds ((LAS unsigned char*)ldsb)
    volatile LAS unsigned* MISC = (volatile LAS unsigned*)(lds + MISC_OFF);
    const int G = gridDim.x, blk = blockIdx.x;
#define FL const int tid = otid(), lane = tid & 63, wave = __builtin_amdgcn_readfirstlane(tid >> 6), gw = blk * NWAVES + wave, NGW = G * NWAVES; LAS float* scr = (LAS float*)(lds + wave * 16384); (void)lane; (void)gw; (void)NGW; (void)scr;
    { FL for (int u = tid; u < 256; u += NTHR) MISC[u] = 0u; }
    __syncthreads();
    { FL if (tid < 128) ((LAS unsigned char*)(lds + MISC_OFF + 784))[tid] = P.bucket[tid];
    if (tid < 33) ((LAS unsigned long long*)(lds + MISC_OFF + 512))[tid] = (unsigned long long)P.in[tid]; }
    __syncthreads();
#define PIN(k) pin_ptr(lds, (k))
    unsigned char* ws = P.ws;
    gu32* ctl = (gu32*)(ws + WS_CTL);
    XcdBarrier bar = xcd_barrier_post((unsigned*)(ctl + CW_BAR), MISC + 8);
#define GRID_BAR() do { xcd_barrier(bar); NEWPH(); } while (0)
    float* const xout = P.out;
    unsigned char* wsl = ws;
#define NEWPH() asm volatile("" : "+s"(wsl), "+s"(ldsb))
#define ssb ((float*)(wsl + WS_SS))
#define route ((unsigned*)(wsl + WS_ROUTE))
#define wr_all ((bf16*)(wsl + WS_WR))
#define dch ((float*)(wsl + WS_DCH))
#define lists ((int*)(wsl + WS_LISTS))
#define memn ((bf16*)(wsl + WS_MEMN))
#define kvb ((bf16*)(wsl + WS_KV))
#define xb ((bf16*)(wsl + WS_XB))
#define mix ((bf16*)(wsl + WS_MIX))
#define proj ((bf16*)(wsl + WS_PROJ))
#define xq ((bf16*)(wsl + WS_PROJ))
#define hid ((bf16*)(wsl + WS_HID))
#define w13t ((bf16*)(wsl + WS_WM))
#define w2t ((bf16*)(wsl + WS_WM + WM_W2))

    { FL
    for (int i = 0; i < 4; ++i) {
        const int j = i >> 1; unsigned char* wl = wsl + WS_W + (size_t)i * W_LAYER;
        if ((i & 1) == 0) {
            convert_matrix(PIN(9) + (size_t)j * 1024 * 3072, 1024, 3072, (bf16*)(wl + W_IN), PIN(6) + i * 1024, 1.0f, 0, gw, NGW, scr, lane, 2048);
            convert_matrix(PIN(10) + (size_t)j * 1024 * 1024, 1024, 1024, (bf16*)(wl + W_OUT), nullptr, 1.0f, 0, gw, NGW, scr, lane);
        } else {
            convert_matrix(PIN(16) + (size_t)j * 1024 * 3072, 1024, 3072, (bf16*)(wl + W_IN), PIN(6) + i * 1024, 0.125f * LOG2E, 1024, gw, NGW, scr, lane);
            convert_matrix(PIN(17) + (size_t)j * 1024 * 1024, 1024, 1024, (bf16*)(wl + W_OUT), nullptr, 1.0f, 0, gw, NGW, scr, lane);
        }
        for (int e = (gw * 64 + lane) * 8; e < 1024 * 1024; e += NGW * 64 * 8) { const int k = e >> 10, n = e & 1023; const float* src = PIN(23) + (size_t)i * 1024 * 1024 + e; const float gk = PIN(7)[i * 1024 + k] * (0.0625f * LOG2E);
            const f32x4 a = *(const GAS f32x4*)src, bq = *(const GAS f32x4*)(src + 4);
            *(GAS v4u*)((bf16*)(wl + W_XQ) + (size_t)(n >> 8) * 262144 + k * 256 + (n & 255)) = (v4u){pk2(a[0] * gk, a[1] * gk), pk2(a[2] * gk, a[3] * gk), pk2(bq[0] * gk, bq[1] * gk), pk2(bq[2] * gk, bq[3] * gk)}; }
        for (int hh = 0; hh < 4; ++hh) convert_matrix(PIN(25) + (size_t)i * 1024 * 1024 + (size_t)hh * 256 * 1024, 256, 1024, (bf16*)(wl + W_XO) + (size_t)hh * 262144, nullptr, 1.0f, 0, gw, NGW, scr, lane);
        convert_matrix(PIN(24) + (size_t)i * 1024 * 2048, 1024, 2048, (bf16*)(wsl + WS_W + W_KV) + (size_t)i * 2048 * 1024, nullptr, 1.0f, 0, gw, NGW, scr, lane);
    }
    for (int e = blk * NTHR + tid; e < 4 * 32 * 1024; e += G * NTHR) { const int l = e >> 15, jr = (e >> 10) & 31, k = e & 1023; float v = 0.f;
        if (jr < 4) v = PIN(26)[((size_t)l * 1024 + k) * 4 + jr]; else if (jr < 20) v = PIN(28)[((size_t)l * 1024 + k) * 16 + (jr - 4)];
        wr_all[e] = (bf16)f2bf(v * PIN(8)[l * 1024 + k]); }
    for (int m = gw; m < MT; m += NGW) row_norm_bf16(PIN(1) + (size_t)m * 1024, PIN(3), memn + (size_t)m * 1024, lane);
    for (int m = gw; m < T; m += 4 * NGW) rows4_to_xb(PIN(0), xb, ssb, m, NGW, lane);
    }
    GRID_BAR();
    { pg8::Gemm g{memn, (const bf16*)(wsl + WS_W + W_KV), 1024, 1024, 1024}; pg8::StaticOrder S; S.init(MT, 8192, G, blk);
      pg8::EpiBlocks256 E{kvb};
      pg8::gemm_phase<pg8::EpiBlocks256, pg8::StaticOrder, true, false>(lds, g, S, E); }
    GRID_BAR();


    for (int i = 0; i < 4; ++i) {
        const int j = i >> 1; unsigned char* wl = wsl + WS_W + (size_t)i * W_LAYER;
        const bool xuni = MISC[8 + 2] != 0u; const int pslot = xuni ? (int)(MISC[8 + 3] * 8u + bar.x) : blk, pvc = xuni ? (int)(bar.x * (unsigned)(G / 8) + MISC[8 + 3]) : blk;
#define XLOC_BAR() do { if (xuni) xcd_local_barrier(bar); else xcd_barrier(bar); NEWPH(); } while (0)
        const int cstage = xuni ? (int)(bar.x >> 1) : 0;
#define MOE_CONV_AT(k_) do { if (cstage == (k_)) { __syncthreads(); { FL convert_moe(PIN(30) + (size_t)i * 16 * 1024 * 512, PIN(31) + (size_t)i * 16 * 1024 * 512, PIN(32) + (size_t)i * 16 * 512 * 1024, w13t, w2t, PIN(8) + i * 1024, gw, NGW, scr, lane); } __syncthreads(); } } while (0)
        MOE_CONV_AT(0);
        {
        { pg8::Gemm g{xb, (const bf16*)(wl + W_IN), 1024, 1024, 1024}; pg8::StaticOrder S; S.init(T, 3072, G, pslot);
          const bool tb = pg8::build_rs_table(S, ssb); __syncthreads();
          pg8::EpiNormBf16 E{proj, 3072, ssb, 0, tb, (i & 1) ? (1 << 30) : 8};
          pg8::gemm_phase<pg8::EpiNormBf16, pg8::StaticOrder, true, false>(lds, g, S, E); }
        { const bf16* kvl = kvb + (size_t)i * 16 * 8 * 65536;
          for (int mode = 0; mode < 2; ++mode) {
              pg8::Gemm g{mode ? (const bf16*)(wl + W_XO) : kvl, mode ? kvl : (const bf16*)(wl + W_XQ), 256, 256, 256}; pg8::FoldOrder S{G, pvc, mode};
              pg8::EpiNormBf16 E{(bf16*)(wsl + WS_FOLD + (mode ? 32 * MiB : 0)), 1024, nullptr, 1, false, 1 << 30};
              pg8::gemm_phase<pg8::EpiNormBf16, pg8::FoldOrder, true, false>(lds, g, S, E); } }
        MOE_CONV_AT(1);
        XLOC_BAR();
        if ((i & 1) == 0) {
            hgrn_phaseA(lds, pslot, G, proj, mix, dch, PIN(5), j, xuni);
            XLOC_BAR();
            hgrn_phaseB(proj, dch, G, pslot, xuni);
            for (int uv = pslot; uv < NB * (SEQ / CV_R); uv += G) conv_unit(lds, xuni ? (NB * (SEQ / CV_R) / 8) * (uv & 7) + (uv >> 3) : uv, proj, mix, PIN(12) + (size_t)j * 31 * 512, PIN(13) + j * 512, PIN(14) + j * 512, PIN(15) + j * 512);
            XLOC_BAR();
            hgrn_phaseC(lds, pslot, G, proj, mix, PIN(11) + j * 128, xuni);
        } else {
            float d1 = 0.f, d2 = 0.f;
            for (int k = 0; k < 64; ++k) { d1 += PIN(18)[j * 64 + k] * PIN(19)[j * 64 + k]; d2 += PIN(20)[j * 64 + k] * PIN(21)[j * 64 + k]; }
            const float lam_init = (j == 0) ? P.lam_init[0] : P.lam_init[1], lam = __expf(d1) - __expf(d2) + lam_init;
            const int vcu = (G % 8 == 0) ? (blk % 8) * (G / 8) + blk / 8 : blk;
            for (int iv = xuni ? pslot : vcu; iv < 2048; iv += G) { const int idx = xuni ? 256 * (iv & 7) + (iv >> 3) : iv;
                const int bh = idx >> 4, pr = idx & 15, b = bh >> 3, h = bh & 7;
                diffattn_unit(lds, b, h, pr, proj, mix, lam, lam_init, PIN(22) + j * 128, PIN(2), (const LAS unsigned char*)(lds + MISC_OFF + 784));
                diffattn_unit(lds, b, h, 31 - pr, proj, mix, lam, lam_init, PIN(22) + j * 128, PIN(2), (const LAS unsigned char*)(lds + MISC_OFF + 784)); }
        }
        }
        MOE_CONV_AT(2);
        XLOC_BAR();
        { pg8::Gemm g{mix, (const bf16*)(wl + W_OUT), 1024, 1024, 1024}; pg8::StaticOrder S; S.init(T, 1024, G, pslot);
          pg8::EpiResidual E{xb, ssb};
          pg8::gemm_phase<pg8::EpiResidual, pg8::StaticOrder, true, false>(lds, g, S, E); }
        MOE_CONV_AT(3);
        XLOC_BAR();
        { pg8::Gemm g{xb, (const bf16*)(wsl + WS_FOLD), 1024, 1024, 1024}; pg8::BatchOrder S; S.init(T, 1024, G, pslot);
          const bool tb = pg8::build_rs_table(S, ssb); __syncthreads();
          pg8::EpiSoftmaxBf16 E{xq, ssb, (LAS float*)(lds + 131072), tb, (long)(24 * MiB / 2)};
          pg8::gemm_phase<pg8::EpiSoftmaxBf16, pg8::BatchOrder, true, false>(lds, g, S, E); }
        XLOC_BAR();
        { pg8::Gemm g{xq, (const bf16*)(wsl + WS_FOLD + 32 * MiB), 1024, 1024, 1024, (long)(24 * MiB)}; pg8::BatchOrder S; S.init(T, 1024, G, pslot);
          pg8::EpiResidual E{xb, ssb};
          pg8::gemm_phase<pg8::EpiResidual, pg8::BatchOrder, true, false>(lds, g, S, E); }
        XLOC_BAR();
        for (int tile = xuni ? (int)(bar.x * (unsigned)(G / 8) + MISC[8 + 3]) : blk; tile < T / 256; tile += G)
            router_tile256(lds, tile, xb, ssb, wr_all + (size_t)i * 32 * 1024, PIN(27) + i * 4, PIN(29) + i * 16, route, lists, (unsigned*)(ctl + CW_CNT + 32 * (i * 32)));
        GRID_BAR();
        LAS int* tab = (LAS int*)(lds + MISC_OFF) + 32;
        const int mvc = (G % 8 == 0) ? (blk % 8) * (G / 8) + blk / 8 : blk;
        { FL if (tid < 32) tab[33 + tid] = (int)__hip_atomic_load(ctl + CW_CNT + 32 * (i * 32 + tid), RLX_AGENT);
        __syncthreads();
        if (tid == 0) { int a = 0; tab[0] = 0; for (int q = 0; q < 32; ++q) { a += (tab[33 + q] + 255) >> 8; tab[q + 1] = a; } } }
        __syncthreads();
        { pg8::Gemm g{xb, w13t, 1024, 1024, 1024}; pg8::MoeOrder S{G, mvc, 0, tab[32], tab, lists, (LAS unsigned short*)(lds + 131072), 8};
          pg8::EpiSwiglu E{hid, lists, (const float*)route, (LAS unsigned short*)(lds + 131072)};
          pg8::gemm_phase<pg8::EpiSwiglu, pg8::MoeOrder, true, true>(lds, g, S, E); }
        GRID_BAR();
        { pg8::Gemm g{hid, w2t, 1024, 1024, 512}; pg8::MoeOrder S{G, mvc, 0, tab[32], tab, lists, (LAS unsigned short*)(lds + 131072), 4};
          pg8::EpiMoeDown E{xb, ssb, lists};
          pg8::gemm_phase<pg8::EpiMoeDown, pg8::MoeOrder, true, false, true>(lds, g, S, E); }
        GRID_BAR();
    }
    { FL f32x4 gg[4]; { const GAS f32x4* gr = (const GAS f32x4*)PIN(4) + lane;
#pragma unroll
      for (int j = 0; j < 4; ++j) gg[j] = gr[64 * j]; }
      for (int m = gw; m < T; m += 4 * NGW) rows4_final(xb, xout, ssb, gg, m, NGW, lane); }
}

extern "C" void kernel_launch(void* const* d_in, const int* in_sizes, int n_in, void* d_out, int out_size, void* d_ws, size_t ws_size, hipStream_t stream) {
    static int grid = 0;
    if (grid == 0) {
        if (n_in != 33 || out_size != T * DM || ws_size < WS_END) { fprintf(stderr, "kernel_launch: unexpected problem (n_in %d out %d ws %zu)\n", n_in, out_size, ws_size); grid = -1; return; }
        int dev = 0, cus = 0, per_cu = 0;
        if (hipGetDevice(&dev) != hipSuccess || hipDeviceGetAttribute(&cus, hipDeviceAttributeMultiprocessorCount, dev) != hipSuccess) { grid = -1; return; }
        if (hipFuncSetAttribute((const void*)mk_fwd, hipFuncAttributeMaxDynamicSharedMemorySize, LDS_BYTES) != hipSuccess) { fprintf(stderr, "kernel_launch: hipFuncSetAttribute failed\n"); grid = -1; return; }
        if (hipOccupancyMaxActiveBlocksPerMultiprocessor(&per_cu, (const void*)mk_fwd, NTHR, LDS_BYTES) != hipSuccess || per_cu < 1) { fprintf(stderr, "kernel_launch: occupancy query says %d\n", per_cu); }
        (void)hipGetLastError();
        grid = cus;
        while (grid > 1 && (T % (32 * grid)) != 0) --grid;
    }
    if (grid < 0) return;
    if (hipMemsetAsync((char*)d_ws + WS_CTL, 0, CTL_ZERO_BYTES, stream) != hipSuccess) return;
    Params p; memset(&p, 0, sizeof(p));
    for (int i = 0; i < 33; ++i) p.in[i] = (const float*)d_in[i];
    p.out = (float*)d_out; p.ws = (unsigned char*)d_ws;
    p.lam_init[0] = (float)(0.8 - 0.6 * exp(-0.3 * 1.0)); p.lam_init[1] = (float)(0.8 - 0.6 * exp(-0.3 * 3.0));
    for (int n = 0; n < 128; ++n) { int bk; if (n < 16) bk = n; else { bk = 16 + (int)(log((double)n / 16.0) / log(8.0) * 16.0); if (bk > 31) bk = 31; if (bk < 0) bk = 0; } p.bucket[n] = (unsigned char)bk; }
    hipLaunchKernelGGL(mk_fwd, dim3(grid), dim3(NTHR), LDS_BYTES, stream, p);
}
```
